# Optimizing an MI355X kernel written in HIP

```python
import jax, jax.numpy as jnp
from jax import lax
import numpy as np

D_MODEL = 1024
BATCH = 8
SEQ = 4096
DEPTH = 4
DEC_BATCH = 16
DEC_SEQ = 32
PAST_LEN = 4096

CHUNK = 64
EPS = 1e-6
D_FF = 2816
PLE_DIM = 256
N_BRANCH = 4
BRANCH_WIDTH = D_MODEL // 2
POOL_WINDOWS = (2, 4, 8, 16)
POOL_GROUPS = len(POOL_WINDOWS)
POOL_GROUP_DIM = BRANCH_WIDTH // POOL_GROUPS
POOL_HIST = max(POOL_WINDOWS) - 1
SB_HEAD_DIM = 64
SB_HEADS = BRANCH_WIDTH // SB_HEAD_DIM
SB_WIDTH = SB_HEADS * SB_HEAD_DIM
SB_BLOCK = 128
GMLP_CHUNK = 128
GMLP_GROUPS = 4
GMLP_GROUP_DIM = BRANCH_WIDTH // GMLP_GROUPS
GLA_HEADS = 4
GLA_DK = BRANCH_WIDTH // (2 * GLA_HEADS)
GLA_DV = BRANCH_WIDTH // GLA_HEADS
GLA_GATE_RANK = 16
GLA_GATE_NORMALIZER = 16.0
IN_SPLITS = (BRANCH_WIDTH,
             SB_WIDTH, SB_WIDTH, SB_WIDTH,
             BRANCH_WIDTH, BRANCH_WIDTH,
             GLA_HEADS * GLA_DK, GLA_HEADS * GLA_DK,
             GLA_HEADS * GLA_DV, GLA_GATE_RANK,
             GLA_HEADS * GLA_DV,
             N_BRANCH * D_MODEL)
IN_COLS = sum(IN_SPLITS)

kernel_name = "hybrid_streaming_encoder_step"


def rms_norm(x, g):
    xf = x.astype(jnp.float32)
    y = xf * lax.rsqrt(jnp.mean(xf * xf, axis=-1, keepdims=True) + EPS)
    return (y * g.astype(jnp.float32)).astype(x.dtype)


def swiglu(x, w1, w3, w2):
    return (jax.nn.silu(x @ w1) * (x @ w3)) @ w2


def split_columns(z):
    idx = np.cumsum(IN_SPLITS)[:-1].tolist()
    return jnp.split(z, idx, axis=-1)


def pool_mixer(xp, hist, pos0, pool_w, pool_scale):
    B, L, W = xp.shape
    ext_in = jnp.concatenate([hist, xp], axis=1)
    ext = ext_in.astype(jnp.float32)
    cs = jnp.concatenate([jnp.zeros((B, 1, W), jnp.float32), jnp.cumsum(ext, axis=1)], axis=1)
    end = cs[:, POOL_HIST + 1:]
    pos = pos0 + jnp.arange(L)
    means = []
    for g, w in enumerate(POOL_WINDOWS):
        sl = slice(g * POOL_GROUP_DIM, (g + 1) * POOL_GROUP_DIM)
        start = cs[:, POOL_HIST + 1 - w:POOL_HIST + 1 - w + L, sl]
        cnt = jnp.minimum(w, pos + 1).astype(jnp.float32)[None, :, None]
        means.append((end[..., sl] - start) / cnt)
    d = jnp.concatenate(means, axis=-1) - ext[:, POOL_HIST:]
    d = d.reshape(B, L, POOL_GROUPS, POOL_GROUP_DIM)
    y = jnp.einsum('blgc,gcd->blgd', d, pool_w.astype(jnp.float32)).reshape(B, L, W)
    y = (y * pool_scale.astype(jnp.float32)).astype(xp.dtype)
    return y, ext_in[:, -POOL_HIST:]


def sb_block(qb, qpos, k, v, kpos):
    z = jnp.einsum('bqhd,bkhd->bhqk', qb, k) * (SB_HEAD_DIM ** -0.5)
    mask = kpos[None, :] < qpos[:, None]
    l = jnp.where(mask, jax.nn.log_sigmoid(-z), 0.0)
    after = lax.cumsum(l, axis=3, reverse=True) - l
    a = jnp.where(mask, jnp.exp(jax.nn.log_sigmoid(z) + after), 0.0)
    return jnp.einsum('bhqk,bkhd->bqhd', a, v)


def stick_breaking_attention(q, k_all, v_all):
    B, L, H, d = q.shape
    Lk = k_all.shape[1]
    kpos = jnp.arange(Lk)
    qpos = (Lk - L) + jnp.arange(L)
    qf, kf, vf = q.astype(jnp.float32), k_all.astype(jnp.float32), v_all.astype(jnp.float32)
    if L <= SB_BLOCK:
        o = sb_block(qf, qpos, kf, vf, kpos)
    else:
        nb = L // SB_BLOCK
        qb = qf.reshape(B, nb, SB_BLOCK, H, d).transpose(1, 0, 2, 3, 4)
        pb = qpos.reshape(nb, SB_BLOCK)
        o = lax.map(lambda a: sb_block(a[0], a[1], kf, vf, kpos), (qb, pb))
        o = o.transpose(1, 0, 2, 3, 4).reshape(B, L, H, d)
    return o.astype(q.dtype)


def spatial_gating(u, v, ws, bs):
    B, L, W = u.shape
    c = min(L, GMLP_CHUNK)
    n = L // c
    idx = jnp.arange(c)
    mask = (idx[None, :] // CHUNK) <= (idx[:, None] // CHUNK)
    wm = jnp.where(mask[None], ws[:, :c, :c], 0.0)
    vc = v.reshape(B, n, c, GMLP_GROUPS, GMLP_GROUP_DIM)
    s = jnp.einsum('gij,bnjgc->bnigc', wm, vc) + bs[:, :c].T[None, None, :, :, None]
    return u * s.reshape(B, L, W)


def gla_chunk(S, q, k, v, g):
    c = q.shape[1]
    b = jnp.cumsum(g, axis=1)
    inter = jnp.einsum('bthk,bhkv->bthv', q * jnp.exp(b), S)
    mask = jnp.tril(jnp.ones((c, c), bool))[None, :, :, None, None]
    diff = b[:, :, None] - b[:, None, :]
    decay = jnp.where(mask, jnp.exp(jnp.where(mask, diff, 0.0)), 0.0)
    att = jnp.einsum('bthk,bshk,btshk->bhts', q, k, decay)
    intra = jnp.einsum('bhts,bshv->bthv', att, v)
    b_last = b[:, -1]
    S_new = jnp.exp(b_last)[..., None] * S + jnp.einsum('bshk,bshv->bhkv', k * jnp.exp(b_last[:, None] - b), v)
    return S_new, inter + intra


def gla_recurrence(q, k, v, g, s0):
    B, L, H, _ = q.shape
    qf, kf, vf, gf = (a.astype(jnp.float32) for a in (q, k, v, g))
    S0 = s0.astype(jnp.float32)
    c = min(L, CHUNK)
    n = L // c
    if n == 1:
        S, o = gla_chunk(S0, qf, kf, vf, gf)
    else:
        def to_chunks(a):
            return a.reshape(B, n, c, *a.shape[2:]).swapaxes(0, 1)
        S, o = lax.scan(lambda s, xs: gla_chunk(s, *xs), S0,
                        (to_chunks(qf), to_chunks(kf), to_chunks(vf), to_chunks(gf)))
        o = o.swapaxes(0, 1).reshape(B, L, H, GLA_DV)
    return S.astype(s0.dtype), o.astype(v.dtype)


def token_mixing(h, pool_hist, k_past, v_past, s0, w_in, pool_w, pool_scale, sb_qn, sb_kn,
                 gmlp_ws, gmlp_b, gla_wa2, gla_ba, gla_on, w_branch, w_out):
    B, L, _ = h.shape
    pos0 = k_past.shape[1]
    (xp, q, k, v, gu, gv, lq, lk, lv, la, lr, gates) = split_columns(h @ w_in)
    y_pool, pool_new = pool_mixer(xp, pool_hist, pos0, pool_w, pool_scale)
    q = rms_norm(q.reshape(B, L, SB_HEADS, SB_HEAD_DIM), sb_qn)
    k = rms_norm(k.reshape(B, L, SB_HEADS, SB_HEAD_DIM), sb_kn)
    v = v.reshape(B, L, SB_HEADS, SB_HEAD_DIM)
    y_sb = stick_breaking_attention(q, jnp.concatenate([k_past, k], axis=1),
                                    jnp.concatenate([v_past, v], axis=1)).reshape(B, L, SB_WIDTH)
    gu, gv = jax.nn.gelu(gu), jax.nn.gelu(gv)
    y_gmlp = spatial_gating(gu, gv, gmlp_ws, gmlp_b)
    log_a = jax.nn.log_sigmoid((la @ gla_wa2 + gla_ba).astype(jnp.float32)) / GLA_GATE_NORMALIZER
    s_new, o = gla_recurrence(lq.reshape(B, L, GLA_HEADS, GLA_DK) * (GLA_DK ** -0.5),
                              lk.reshape(B, L, GLA_HEADS, GLA_DK),
                              lv.reshape(B, L, GLA_HEADS, GLA_DV),
                              log_a.reshape(B, L, GLA_HEADS, GLA_DK), s0)
    y_gla = rms_norm(o, gla_on).reshape(B, L, BRANCH_WIDTH) * jax.nn.silu(lr)
    gates = jax.nn.sigmoid(gates.reshape(B, L, N_BRANCH, D_MODEL))
    merged = gates[:, :, 0] * (y_pool @ w_branch[0])
    merged = merged + gates[:, :, 1] * (y_sb @ w_branch[1])
    merged = merged + gates[:, :, 2] * (y_gmlp @ w_branch[2])
    merged = merged + gates[:, :, 3] * (y_gla @ w_branch[3])
    return merged @ w_out, pool_new, k, v, s_new, gv


def layer(x, p_i, pool_hist, k_past, v_past, s0, lw):
    (n1, f1a, f1b, f1c, nm, w_in, pool_w, pool_scale, qn, kn, ws, bs, wa2, ba, on,
     w_branch, w_out, n2, f2a, f2b, f2c, npl, wpg, wpp) = lw
    x = x + 0.5 * swiglu(rms_norm(x, n1), f1a, f1b, f1c)
    m, pool_new, k, v, s_new, gv = token_mixing(rms_norm(x, nm), pool_hist, k_past, v_past, s0, w_in,
                                                pool_w, pool_scale, qn, kn, ws, bs, wa2, ba, on,
                                                w_branch, w_out)
    x = x + m
    x = x + 0.5 * swiglu(rms_norm(x, n2), f2a, f2b, f2c)
    x = x + jax.nn.sigmoid(rms_norm(x, npl) @ wpg) * (p_i @ wpp)
    return x, pool_new, k, v, s_new, gv


def setup_inputs(seed: int = 0) -> dict:
    key = jax.random.key(seed)
    ks = iter(list(jax.random.split(key, 40)))

    def nrm(shape, scale):
        return jax.random.normal(next(ks), shape, jnp.float32) * scale

    def gain(shape):
        return 1.0 + 0.05 * jax.random.normal(next(ks), shape, jnp.float32)

    return {
        'x_prompt': nrm((BATCH, SEQ, D_MODEL), 1.0),
        'x_sample': nrm((DEC_BATCH, DEC_SEQ, D_MODEL), 1.0),
        'p_prompt': nrm((DEPTH, BATCH, SEQ, PLE_DIM), 1.0),
        'p_sample': nrm((DEPTH, DEC_BATCH, DEC_SEQ, PLE_DIM), 1.0),
        'cache_sb_k': nrm((DEPTH, DEC_BATCH, PAST_LEN, SB_HEADS, SB_HEAD_DIM), 1.0),
        'cache_sb_v': nrm((DEPTH, DEC_BATCH, PAST_LEN, SB_HEADS, SB_HEAD_DIM), 1.0),
        'state_pool': nrm((DEPTH, DEC_BATCH, POOL_HIST, BRANCH_WIDTH), 1.0),
        'state_gla': nrm((DEPTH, DEC_BATCH, GLA_HEADS, GLA_DK, GLA_DV), 0.3),
        'norm_ffn1': gain((DEPTH, D_MODEL)),
        'ffn1_w1': nrm((DEPTH, D_MODEL, D_FF), D_MODEL ** -0.5),
        'ffn1_w3': nrm((DEPTH, D_MODEL, D_FF), D_MODEL ** -0.5),
        'ffn1_w2': nrm((DEPTH, D_FF, D_MODEL), D_FF ** -0.5),
        'norm_mix': gain((DEPTH, D_MODEL)),
        'w_in': nrm((DEPTH, D_MODEL, IN_COLS), D_MODEL ** -0.5),
        'pool_w': nrm((DEPTH, POOL_GROUPS, POOL_GROUP_DIM, POOL_GROUP_DIM), POOL_GROUP_DIM ** -0.5),
        'pool_scale': gain((DEPTH, BRANCH_WIDTH)),
        'sb_q_norm': gain((DEPTH, SB_HEAD_DIM)),
        'sb_k_norm': gain((DEPTH, SB_HEAD_DIM)),
        'gmlp_ws': nrm((DEPTH, GMLP_GROUPS, GMLP_CHUNK, GMLP_CHUNK), GMLP_CHUNK ** -0.5),
        'gmlp_b': gain((DEPTH, GMLP_GROUPS, GMLP_CHUNK)),
        'gla_wa2': nrm((DEPTH, GLA_GATE_RANK, GLA_HEADS * GLA_DK), GLA_GATE_RANK ** -0.5),
        'gla_ba': nrm((DEPTH, GLA_HEADS * GLA_DK), 0.01),
        'gla_out_norm': gain((DEPTH, GLA_DV)),
        'w_branch': nrm((DEPTH, N_BRANCH, BRANCH_WIDTH, D_MODEL), BRANCH_WIDTH ** -0.5),
        'w_out': nrm((DEPTH, D_MODEL, D_MODEL), D_MODEL ** -0.5),
        'norm_ffn2': gain((DEPTH, D_MODEL)),
        'ffn2_w1': nrm((DEPTH, D_MODEL, D_FF), D_MODEL ** -0.5),
        'ffn2_w3': nrm((DEPTH, D_MODEL, D_FF), D_MODEL ** -0.5),
        'ffn2_w2': nrm((DEPTH, D_FF, D_MODEL), D_FF ** -0.5),
        'norm_ple': gain((DEPTH, D_MODEL)),
        'ple_w_gate': nrm((DEPTH, D_MODEL, D_MODEL), D_MODEL ** -0.5),
        'ple_w_proj': nrm((DEPTH, PLE_DIM, D_MODEL), PLE_DIM ** -0.5),
    }


def reference(x_prompt, x_sample, p_prompt, p_sample, cache_sb_k, cache_sb_v, state_pool, state_gla,
              norm_ffn1, ffn1_w1, ffn1_w3, ffn1_w2, norm_mix, w_in, pool_w, pool_scale,
              sb_q_norm, sb_k_norm, gmlp_ws, gmlp_b, gla_wa2, gla_ba, gla_out_norm,
              w_branch, w_out, norm_ffn2, ffn2_w1, ffn2_w3, ffn2_w2, norm_ple, ple_w_gate, ple_w_proj):
    lw_all = (norm_ffn1, ffn1_w1, ffn1_w3, ffn1_w2, norm_mix, w_in, pool_w, pool_scale,
              sb_q_norm, sb_k_norm, gmlp_ws, gmlp_b, gla_wa2, gla_ba, gla_out_norm,
              w_branch, w_out, norm_ffn2, ffn2_w1, ffn2_w3, ffn2_w2, norm_ple, ple_w_gate, ple_w_proj)
    B, S, _ = x_prompt.shape
    dt = x_prompt.dtype
    pool_hist0 = jnp.zeros((B, POOL_HIST, BRANCH_WIDTH), dt)
    kv_past0 = jnp.zeros((B, 0, SB_HEADS, SB_HEAD_DIM), dt)
    gla0 = jnp.zeros((B, GLA_HEADS, GLA_DK, GLA_DV), dt)
    yp, ys = x_prompt, x_sample
    pk, pv, ppool, pgla = [], [], [], []
    sk, sv, spool, sgla, sgmlp = [], [], [], [], []
    for i in range(DEPTH):
        lw = tuple(w[i] for w in lw_all)
        yp, pool_p, k_p, v_p, s_p, _ = layer(yp, p_prompt[i], pool_hist0, kv_past0, kv_past0, gla0, lw)
        ys, pool_s, k_s, v_s, s_s, gv_s = layer(ys, p_sample[i], state_pool[i], cache_sb_k[i],
                                                cache_sb_v[i], state_gla[i], lw)
        pk.append(k_p); pv.append(v_p); ppool.append(pool_p); pgla.append(s_p)
        sk.append(k_s); sv.append(v_s); spool.append(pool_s); sgla.append(s_s); sgmlp.append(gv_s)
    return (yp, ys,
            jnp.stack(pk), jnp.stack(pv), jnp.stack(ppool), jnp.stack(pgla),
            jnp.stack(sk), jnp.stack(sv), jnp.stack(spool), jnp.stack(sgla), jnp.stack(sgmlp))
```

```cpp
#include <hip/hip_runtime.h>
#include <cstdio>
#include <cstdint>
#define GAS __attribute__((address_space(1)))
#define LAS __attribute__((address_space(3)))
typedef unsigned short bf16;

constexpr int NWAVES = 8;
constexpr int DM = 1024, MP = 32768, MS = 512, M = MP + MS, NL = 4, DFF = 2816, NIN = 8960;
constexpr int NCHUNK = 2048 + 64;
constexpr int NSEQ = 32 + 64;
constexpr size_t O_X = 0, O_KP = (size_t)M * DM, O_VP = O_KP + (size_t)NL * MP * 512, O_POOLP = O_VP + (size_t)NL * MP * 512, O_GLAP = O_POOLP + (size_t)NL * 8 * 15 * 512,
    O_KS = O_GLAP + (size_t)NL * 8 * 4 * 64 * 128, O_VS = O_KS + (size_t)NL * MS * 512, O_POOLS = O_VS + (size_t)NL * MS * 512, O_GLAS = O_POOLS + (size_t)NL * 16 * 15 * 512,
    O_GVS = O_GLAS + (size_t)NL * 16 * 4 * 64 * 128, O_END = O_GVS + (size_t)NL * MS * 512;
constexpr size_t MiB = 1u << 20;
constexpr size_t WS_CTL = 0, CTL_ZERO_BYTES = 1 * MiB;
constexpr size_t WS_W = 2 * MiB, LW = 60 * MiB;
constexpr size_t OW13A = 0, OW2A = 11 * MiB, OW13B = 16 * MiB + MiB / 2, OW2B = 27 * MiB + MiB / 2, OWIN = 33 * MiB, OWBR = 50 * MiB + MiB / 2, OWOUT = 54 * MiB + MiB / 2, OWPG = 56 * MiB + MiB / 2,
    OWPP = 58 * MiB + MiB / 2, OWM = 59 * MiB;
constexpr size_t WS_XB0 = 242 * MiB, WS_XB1 = 307 * MiB, WS_SSQ0 = 372 * MiB, WS_SSQ1 = 375 * MiB, WS_HB = 378 * MiB;
constexpr size_t WS_XPB = 557 * MiB, WS_QB = 590 * MiB, WS_KB = 623 * MiB, WS_VB = 656 * MiB, WS_GUB = 689 * MiB, WS_GVB = 722 * MiB, WS_LVB = 755 * MiB, WS_LRB = 788 * MiB;
constexpr size_t WS_LQB = 821 * MiB, WS_LKB = 838 * MiB, WS_LAB = 855 * MiB, WS_GB = 872 * MiB, WS_AB = 1132 * MiB, WS_MB = 1262 * MiB, WS_PPB = 1327 * MiB, WS_PB = 1392 * MiB;
constexpr size_t WS_QT = 1457 * MiB, WS_KT = 1490 * MiB, WS_DS = 1523 * MiB, WS_SC = 1589 * MiB, WS_LAM = 1655 * MiB, WS_END = 1656 * MiB;
static_assert(OW13A + (size_t)5632 * 1024 * 2 <= OW2A && OW2A + (size_t)1024 * 2816 * 2 <= OW13B && OW13B + (size_t)5632 * 1024 * 2 <= OW2B && OW2B + (size_t)1024 * 2816 * 2 <= OWIN &&
              OWIN + (size_t)NIN * 1024 * 2 <= OWBR && OWBR + (size_t)4 * 1024 * 512 * 2 <= OWOUT && OWOUT + 2 * MiB <= OWPG && OWPG + 2 * MiB <= OWPP && OWPP + MiB / 2 <= OWM && OWM + 131072 <= LW, "weight map");
static_assert(WS_W + NL * LW <= WS_XB0 && WS_XB0 + (size_t)M * DM * 2 <= WS_XB1 && WS_XB1 + (size_t)M * DM * 2 <= WS_SSQ0 && WS_SSQ0 + (size_t)M * 64 <= WS_SSQ1 && WS_SSQ1 + (size_t)M * 64 <= WS_HB &&
              WS_HB + (size_t)M * DFF * 2 <= WS_XPB && WS_XPB + (size_t)M * 1024 <= WS_QB && WS_LRB + (size_t)M * 1024 <= WS_LQB && WS_LQB + (size_t)M * 512 <= WS_LKB && WS_LAB + (size_t)M * 512 <= WS_GB &&
              WS_GB + (size_t)M * 8192 <= WS_AB && WS_AB + (size_t)4 * M * 1024 <= WS_MB && WS_MB + (size_t)M * 2048 <= WS_PPB && WS_PPB + (size_t)M * 2048 <= WS_PB && WS_PB + (size_t)4 * M * 512 <= WS_QT &&
              WS_QT + (size_t)M * 1024 <= WS_KT && WS_KT + (size_t)M * 1024 <= WS_DS && WS_DS + (size_t)NCHUNK * 32768 <= WS_SC && WS_SC + (size_t)NCHUNK * 32768 <= WS_LAM && WS_LAM + (size_t)NCHUNK * 256 <= WS_END, "ws map");
constexpr int CW_BAR = 4096;
constexpr int RING_BYTES = 131072, MISC_OFF = RING_BYTES + 320, LDS_BYTES = 147456;

typedef float f32x16 __attribute__((ext_vector_type(16)));
typedef short s16x4 __attribute__((ext_vector_type(4)));
typedef short v4i16_t __attribute__((ext_vector_type(4)));
typedef unsigned u32x2 __attribute__((ext_vector_type(2)));

struct Params { const float* in[32]; float* out; unsigned char* ws; };
enum { I_XP = 0, I_XS, I_PP, I_PS, I_CK, I_CV, I_SPOOL, I_SGLA, I_N1, I_F1W1, I_F1W3, I_F1W2, I_NM, I_WIN, I_POOLW, I_POOLS, I_QN, I_KN, I_GWS, I_GB, I_WA2, I_BA, I_GON, I_WBR, I_WOUT, I_N2, I_F2W1,
       I_F2W3, I_F2W2, I_NPL, I_WPG, I_WPP };


typedef const __attribute__((address_space(4))) Params* KParams;
__device__ __forceinline__ KParams params_ptr() { KParams p = (KParams)__builtin_amdgcn_kernarg_segment_ptr(); asm volatile("" : "+s"(p)); return p; }
namespace pg8 {
#define PG8_LAS __attribute__((address_space(3)))
typedef unsigned short bf16_t;
typedef short bf16x8 __attribute__((ext_vector_type(8)));
typedef float f32x4 __attribute__((ext_vector_type(4)));
typedef unsigned u32x4 __attribute__((ext_vector_type(4)));
constexpr int BM = 256, BK = 64, HALF = 128, HTB = HALF * BK * 2  , STAGE_BYTES = 8 * HTB, NXCD = 8, WGM = 8;

__host__ __device__ __forceinline__ int lds_byte(int r, int c) { const int st = (r >> 4) * 2 + (c >> 5), rr = r & 15, cc = c & 31, ob = rr * 64 + cc * 2; return st * 1024 + (ob ^ (((ob >> 9) & 1) << 5)); }
__host__ __device__ __forceinline__ void stage_rc(int b, int& R, int& C) { const int st = b / 1024, sb = b % 1024, swz = sb ^ (((sb >> 9) & 1) << 5); R = (st >> 1) * 16 + swz / 64; C = (st & 1) * 32 + (swz % 64) / 2; }
__host__ __device__ __forceinline__ int perm32(int rho) { const int n = rho >> 4, i = rho & 15; return 8 * (i >> 2) + 4 * n + (i & 3); }

struct Unit { int pm, pn; };
struct Gemm { const bf16_t* A; const bf16_t* Bt; int M, N, K; };

struct StaticOrder {
    int nM, nN, nwg, G, c;
    __host__ __device__ void init(int M, int N, int G_, int c_) { nM = M / BM; nN = N / BM; nwg = nM * nN; G = G_; c = c_; }
    __host__ __device__ bool next(int i, Unit& u) const {
        const long L = (long)i * G + c; if (L >= nwg) return false;
        int wgid = (int)L; { const int q = nwg / NXCD, r = nwg % NXCD, xcd = wgid % NXCD, off = wgid / NXCD; wgid = (xcd < r ? xcd * (q + 1) : r * (q + 1) + (xcd - r) * q) + off; }
        const int nig = WGM * nN, gid = wgid / nig, fm = gid * WGM, gsz = (nM - fm) < WGM ? (nM - fm) : WGM;
        u.pm = fm + ((wgid % nig) % gsz); u.pn = (wgid % nig) / gsz; return true;
    }
    __device__ __forceinline__ void a_ready(const Unit&) const {}
    __device__ __forceinline__ void done(const Unit&) const {}
};

__device__ __forceinline__ unsigned cvt_pk_bf16(float lo, float hi) { unsigned r; asm volatile("v_cvt_pk_bf16_f32 %0, %1, %2" : "=v"(r) : "v"(lo), "v"(hi)); return r; }
typedef float f32x2 __attribute__((ext_vector_type(2)));
__device__ __forceinline__ float sigm(float t) { return __builtin_amdgcn_rcpf(1.0f + __builtin_amdgcn_exp2f(-1.4426950408889634f * t)); }
__device__ __forceinline__ float silu_f(float t) { return t * sigm(t); }
__device__ __forceinline__ float gelu_tanh_f(float t) { return t * sigm(1.5957691216057308f * (t + 0.044715f * t * t * t)); }
__device__ __forceinline__ float bf_lo(unsigned w) { return __uint_as_float(w << 16); }
__device__ __forceinline__ float bf_hi(unsigned w) { return __uint_as_float(w & 0xffff0000u); }
__device__ __forceinline__ float row_rstd(const float* ssq, int row) {
    const f32x4* p = (const f32x4*)(ssq + (size_t)row * 16); const f32x4 a = p[0], b = p[1], c = p[2], d = p[3];
    const float s = (((a[0] + a[1]) + (a[2] + a[3])) + ((b[0] + b[1]) + (b[2] + b[3]))) + (((c[0] + c[1]) + (c[2] + c[3])) + ((d[0] + d[1]) + (d[2] + d[3])));
    return __builtin_amdgcn_rsqf(s * (1.0f / 1024.0f) + 1e-6f);
}
__device__ __forceinline__ u32x4 pack8(const f32x4 a, const f32x4 b) { u32x4 w; w.x = cvt_pk_bf16(a[0], a[1]); w.y = cvt_pk_bf16(a[2], a[3]); w.z = cvt_pk_bf16(b[0], b[1]); w.w = cvt_pk_bf16(b[2], b[3]); return w; }

struct EpiSwiGLU {
    static constexpr bool PERM = true, AFTER_DRAIN = false;
    KParams kp; int sq;
    __device__ __forceinline__ void operator()(const f32x4 (&acc)[2][2][4][2], const Unit& u, int wr, int wc, int fr, int fq) const {
        KParams q = kp; asm volatile("" : "+s"(q)); unsigned char* ws = q->ws;
        bf16_t* H = (bf16_t*)(ws + WS_HB); const float* ssq = (const float*)(ws + (sq ? WS_SSQ1 : WS_SSQ0));
        const int col0 = u.pn * 128 + wc * 32 + 8 * fq;
#pragma unroll
        for (int ai = 0; ai < 2; ++ai)
#pragma unroll
            for (int m = 0; m < 4; ++m) {
                const int row = u.pm * BM + ai * HALF + wr * 64 + m * 16 + fr; const float rs = row_rstd(ssq, row);
                f32x4 h0, h1;
#pragma unroll
                for (int j = 0; j < 4; ++j) { h0[j] = silu_f(acc[ai][0][m][0][j] * rs) * (acc[ai][1][m][0][j] * rs); h1[j] = silu_f(acc[ai][0][m][1][j] * rs) * (acc[ai][1][m][1][j] * rs); }
                *(u32x4*)(H + (size_t)row * 2816 + col0) = pack8(h0, h1);
                if (m & 1) asm volatile("" ::: "memory");
            }
    }
};

template <bool PLE> struct EpiX {
    static constexpr bool PERM = true, AFTER_DRAIN = false;
    KParams kp; int xc_out, sq_out; float alpha;
    __device__ __forceinline__ void operator()(const f32x4 (&acc)[2][2][4][2], const Unit& u, int wr, int wc, int fr, int fq) const {
        KParams q = kp; asm volatile("" : "+s"(q)); unsigned char* ws = q->ws; float* X = q->out + O_X;
        bf16_t* XB = (bf16_t*)(ws + (xc_out ? WS_XB1 : WS_XB0)); float* ssq_out = (float*)(ws + (sq_out ? WS_SSQ1 : WS_SSQ0)); const float* ssq_in = (const float*)(ws + (sq_out ? WS_SSQ0 : WS_SSQ1));
        const bf16_t* PP = (const bf16_t*)(ws + WS_PPB);
#pragma unroll
        for (int ai = 0; ai < 2; ++ai)
#pragma unroll
            for (int m = 0; m < 4; ++m) {
                const int row = u.pm * BM + ai * HALF + wr * 64 + m * 16 + fr; float s = 0.f; float rs = 0.f; if (PLE) rs = row_rstd(ssq_in, row);
#pragma unroll
                for (int bj = 0; bj < 2; ++bj) {
                    const size_t off = (size_t)row * 1024 + u.pn * BM + bj * HALF + wc * 32 + 8 * fq;
                    f32x4 a0 = acc[ai][bj][m][0], a1 = acc[ai][bj][m][1];
                    if (PLE) { const u32x4 pw = *(const u32x4*)(PP + off);
                        a0[0] = sigm(a0[0] * rs) * bf_lo(pw.x); a0[1] = sigm(a0[1] * rs) * bf_hi(pw.x); a0[2] = sigm(a0[2] * rs) * bf_lo(pw.y); a0[3] = sigm(a0[3] * rs) * bf_hi(pw.y);
                        a1[0] = sigm(a1[0] * rs) * bf_lo(pw.z); a1[1] = sigm(a1[1] * rs) * bf_hi(pw.z); a1[2] = sigm(a1[2] * rs) * bf_lo(pw.w); a1[3] = sigm(a1[3] * rs) * bf_hi(pw.w);
                    } else { a0 = a0 * alpha; a1 = a1 * alpha; }
                    f32x4 x0 = *(const f32x4*)(X + off), x1 = *(const f32x4*)(X + off + 4);
                    x0 = x0 + a0; x1 = x1 + a1;
                    *(f32x4*)(X + off) = x0; *(f32x4*)(X + off + 4) = x1;
                    *(u32x4*)(XB + off) = pack8(x0, x1);
                    s += ((x0[0] * x0[0] + x0[1] * x0[1]) + (x0[2] * x0[2] + x0[3] * x0[3])) + ((x1[0] * x1[0] + x1[1] * x1[1]) + (x1[2] * x1[2] + x1[3] * x1[3]));
                }
                s += __shfl_xor(s, 16); s += __shfl_xor(s, 32);
                if (fq == 0) ssq_out[(size_t)row * 16 + u.pn * 4 + wc] = s;
                asm volatile("" ::: "memory");
            }
    }
};

struct EpiIn {
    static constexpr bool PERM = true, AFTER_DRAIN = false;
    KParams kp; int L, sq;
    __device__ __forceinline__ void operator()(const f32x4 (&acc)[2][2][4][2], const Unit& u, int wr, int wc, int fr, int fq) const {
        KParams q = kp; asm volatile("" : "+s"(q)); unsigned char* ws = q->ws; float* out = q->out;
        const float* ssq = (const float*)(ws + (sq ? WS_SSQ1 : WS_SSQ0));
        const int t = u.pn; const bool samp = u.pm >= 128;
        if (t >= 2 && t < 6) {
            const bool isk = t >= 4; const float* gn = q->in[isk ? I_KN : I_QN] + L * 64; bf16_t* dst = (bf16_t*)(ws + (isk ? WS_KB : WS_QB));
            float* fo = isk ? (samp ? out + O_KS + (size_t)L * MS * 512 - (size_t)32768 * 512 : out + O_KP + (size_t)L * MP * 512) : nullptr;
            const float sc = isk ? 1.0f : 0.125f * 1.4426950408889634f;
            f32x4 g[2][2];
#pragma unroll
            for (int bj = 0; bj < 2; ++bj)
#pragma unroll
                for (int n = 0; n < 2; ++n) g[bj][n] = *(const f32x4*)(gn + 32 * bj + 8 * fq + 4 * n) * sc;
            const int hcol = (4 * (t & 1) + wc) * 64 + 8 * fq;
#pragma unroll
            for (int ai = 0; ai < 2; ++ai)
#pragma unroll
                for (int m = 0; m < 4; ++m) {
                    const int row = u.pm * BM + ai * HALF + wr * 64 + m * 16 + fr; const float rs = row_rstd(ssq, row);
                    f32x4 v[2][2]; float ss = 0.f;
#pragma unroll
                    for (int bj = 0; bj < 2; ++bj)
#pragma unroll
                        for (int n = 0; n < 2; ++n) { v[bj][n] = acc[ai][bj][m][n] * rs; ss += (v[bj][n][0] * v[bj][n][0] + v[bj][n][1] * v[bj][n][1]) + (v[bj][n][2] * v[bj][n][2] + v[bj][n][3] * v[bj][n][3]); }
                    ss += __shfl_xor(ss, 16); ss += __shfl_xor(ss, 32);
                    const float hr = __builtin_amdgcn_rsqf(ss * (1.0f / 64.0f) + 1e-6f);
#pragma unroll
                    for (int bj = 0; bj < 2; ++bj) { const f32x4 o0 = v[bj][0] * hr * g[bj][0], o1 = v[bj][1] * hr * g[bj][1];
                        const size_t off = (size_t)row * 512 + hcol + 32 * bj;
                        *(u32x4*)(dst + off) = pack8(o0, o1);
                        if (fo) { *(f32x4*)(fo + off) = o0; *(f32x4*)(fo + off + 4) = o1; } }
                    asm volatile("" ::: "memory");
                }
            return;
        }
        bf16_t* dst; int ld, dcol, act = 0; float* fo = nullptr;
        size_t wo;
        if (t < 2) { wo = WS_XPB; ld = 512; dcol = 256 * t; }
        else if (t < 8) { wo = WS_VB; ld = 512; dcol = 256 * (t - 6); fo = samp ? out + O_VS + (size_t)L * MS * 512 - (size_t)32768 * 512 : out + O_VP + (size_t)L * MP * 512; }
        else if (t < 10) { wo = WS_GUB; ld = 512; dcol = 256 * (t - 8); act = 1; }
        else if (t < 12) { wo = WS_GVB; ld = 512; dcol = 256 * (t - 10); act = 1; fo = samp ? out + O_GVS + (size_t)L * MS * 512 - (size_t)32768 * 512 : nullptr; }
        else if (t == 12) { wo = WS_LQB; ld = 256; dcol = 0; }
        else if (t == 13) { wo = WS_LKB; ld = 256; dcol = 0; }
        else if (t < 16) { wo = WS_LVB; ld = 512; dcol = 256 * (t - 14); }
        else if (t < 18) { wo = WS_LRB; ld = 512; dcol = 256 * (t - 16); act = 2; }
        else if (t < 34) { wo = WS_GB; ld = 4096; dcol = 256 * (t - 18); act = 3; }
        else { wo = WS_LAB; ld = 256; dcol = 0; }
        dst = (bf16_t*)(ws + wo);
#pragma unroll
        for (int ai = 0; ai < 2; ++ai)
#pragma unroll
            for (int m = 0; m < 4; ++m) {
                const int row = u.pm * BM + ai * HALF + wr * 64 + m * 16 + fr; const float rs = row_rstd(ssq, row);
#pragma unroll
                for (int bj = 0; bj < 2; ++bj) {
                    f32x4 v0 = acc[ai][bj][m][0] * rs, v1 = acc[ai][bj][m][1] * rs;
                    if (act == 1) {
#pragma unroll
                        for (int j = 0; j < 4; ++j) { v0[j] = gelu_tanh_f(v0[j]); v1[j] = gelu_tanh_f(v1[j]); }
                    } else if (act == 2) {
#pragma unroll
                        for (int j = 0; j < 4; ++j) { v0[j] = silu_f(v0[j]); v1[j] = silu_f(v1[j]); }
                    } else if (act == 3) {
#pragma unroll
                        for (int j = 0; j < 4; ++j) { v0[j] = sigm(v0[j]); v1[j] = sigm(v1[j]); }
                    }
                    const int col = dcol + bj * HALF + wc * 32 + 8 * fq;
                    *(u32x4*)(dst + (size_t)row * ld + col) = pack8(v0, v1);
                    if (fo) { float* f = fo + (size_t)row * 512 + col; *(f32x4*)f = v0; *(f32x4*)(f + 4) = v1; }
                }
                if (m & 1) asm volatile("" ::: "memory");
            }
    }
};

struct EpiBranch {
    static constexpr bool PERM = true, AFTER_DRAIN = false;
    KParams kp;
    __device__ __forceinline__ void operator()(const f32x4 (&acc)[2][2][4][2], const Unit& u, int wr, int wc, int fr, int fq) const {
        KParams q = kp; asm volatile("" : "+s"(q)); unsigned char* ws = q->ws; const bf16_t* G = (const bf16_t*)(ws + WS_GB); bf16_t* MB = (bf16_t*)(ws + WS_MB);
        const int b = u.pm / 130, pm = u.pm - b * 130, pn = u.pn & 3;
#pragma unroll
        for (int ai = 0; ai < 2; ++ai)
#pragma unroll
            for (int m = 0; m < 4; ++m) {
                const int row = pm * BM + ai * HALF + wr * 64 + m * 16 + fr;
#pragma unroll
                for (int bj = 0; bj < 2; ++bj) {
                    const int col = pn * BM + bj * HALF + wc * 32 + 8 * fq;
                    const u32x4 gw = *(const u32x4*)(G + (size_t)row * 4096 + b * 1024 + col);
                    f32x4 v0 = acc[ai][bj][m][0], v1 = acc[ai][bj][m][1];
                    v0[0] *= bf_lo(gw.x); v0[1] *= bf_hi(gw.x); v0[2] *= bf_lo(gw.y); v0[3] *= bf_hi(gw.y);
                    v1[0] *= bf_lo(gw.z); v1[1] *= bf_hi(gw.z); v1[2] *= bf_lo(gw.w); v1[3] *= bf_hi(gw.w);
                    bf16_t* mp = MB + (size_t)row * 1024 + col;
                    if (b > 0) { const u32x4 mw = *(const u32x4*)mp;
                        v0[0] += bf_lo(mw.x); v0[1] += bf_hi(mw.x); v0[2] += bf_lo(mw.y); v0[3] += bf_hi(mw.y);
                        v1[0] += bf_lo(mw.z); v1[1] += bf_hi(mw.z); v1[2] += bf_lo(mw.w); v1[3] += bf_hi(mw.w); }
                    *(u32x4*)mp = pack8(v0, v1);
                }
                if (m & 1) asm volatile("" ::: "memory");
            }
    }
};
struct BranchOrder {
    int G, c;
    __device__ __forceinline__ bool next(int i, Unit& u) const { const int tl = (i >> 2) * G + c; if (tl >= 520) return false; const int b = i & 3; u.pm = b * 130 + (tl >> 2); u.pn = b * 4 + (tl & 3); return true; }
    __device__ __forceinline__ void a_ready(const Unit&) const {}
    __device__ __forceinline__ void done(const Unit&) const {}
};
struct EpiPlain {
    static constexpr bool PERM = true, AFTER_DRAIN = false;
    KParams kp;
    __device__ __forceinline__ void operator()(const f32x4 (&acc)[2][2][4][2], const Unit& u, int wr, int wc, int fr, int fq) const {
        KParams q = kp; asm volatile("" : "+s"(q)); bf16_t* O = (bf16_t*)(q->ws + WS_PPB); const int ldc = 1024;
#pragma unroll
        for (int ai = 0; ai < 2; ++ai)
#pragma unroll
            for (int m = 0; m < 4; ++m) {
                const int row = u.pm * BM + ai * HALF + wr * 64 + m * 16 + fr;
#pragma unroll
                for (int bj = 0; bj < 2; ++bj) *(u32x4*)(O + (size_t)row * ldc + u.pn * BM + bj * HALF + wc * 32 + 8 * fq) = pack8(acc[ai][bj][m][0], acc[ai][bj][m][1]);
            }
    }
};
template <class Epi, class Sched, bool ALIGN_EPI = false, bool SP2 = false>
__device__ __forceinline__ void gemm_phase(PG8_LAS unsigned char* lds, const Gemm g, const Sched& S, const Epi& E) {
    int tid = threadIdx.x; asm volatile("" : "+v"(tid));
    const int wid = __builtin_amdgcn_readfirstlane(tid >> 6), lane = tid & 63, wr = wid >> 2, wc = wid & 3, fr = lane & 15, fq = lane >> 4;
    int K = g.K; asm volatile("" : "+s"(K)); const int nt = K / BK;
    unsigned voffA[2], voffB[2];
#pragma unroll
    for (int i = 0; i < 2; ++i) { int R, C; stage_rc(tid * 16 + i * 8192, R, C); const int Rb = Epi::PERM ? ((R & ~31) + perm32(R & 31)) : R;
        voffA[i] = (unsigned)(R * K + C) * 2u; voffB[i] = (unsigned)(Rb * K + C) * 2u; }
    const size_t kstep = (size_t)(BK * 2);
    const size_t hstep = (size_t)HALF * K * 2;
    const size_t tstep = 2 * hstep;
    const unsigned ldsw = (unsigned)wid * 1024u;
    const int aoff = lds_byte(wr * 64 + fr, fq * 8), boff = lds_byte(wc * 32 + fr, fq * 8);
#define PG8_SA(b, h) (((b) * 2 + (h)) * HTB)
#define PG8_SB(b, h) ((4 + (b) * 2 + (h)) * HTB)
#define PG8_STAGE(bufoff, gbase, voff) do { _Pragma("unroll") for (int _i = 0; _i < 2; ++_i) \
        __builtin_amdgcn_global_load_lds((const unsigned*)((const char*)(gbase) + (voff)[_i]), (PG8_LAS unsigned*)(lds + (bufoff) + ldsw + _i * 8192), 16, 0, 0); } while (0)
#define PG8_LDA(dst, b, h) do { _Pragma("unroll") for (int m = 0; m < 4; ++m) _Pragma("unroll") for (int k = 0; k < 2; ++k) dst[m][k] = *(const PG8_LAS bf16x8*)(lds + PG8_SA(b, h) + aoff + m * 2048 + k * 1024); } while (0)
#define PG8_LDB(dst, b, h) do { _Pragma("unroll") for (int n = 0; n < 2; ++n) _Pragma("unroll") for (int k = 0; k < 2; ++k) dst[n][k] = *(const PG8_LAS bf16x8*)(lds + PG8_SB(b, h) + boff + n * 2048 + k * 1024); } while (0)
#define PG8_MMA(ai, bj, At, Bt) do { __builtin_amdgcn_s_setprio(1); _Pragma("unroll") for (int m = 0; m < 4; ++m) _Pragma("unroll") for (int n = 0; n < 2; ++n) _Pragma("unroll") for (int k = 0; k < 2; ++k) \
        acc[ai][bj][m][n] = __builtin_amdgcn_mfma_f32_16x16x32_bf16(Bt[n][k], At[m][k], acc[ai][bj][m][n], 0, 0, 0); __builtin_amdgcn_s_setprio(0); } while (0)
#define PG8_WAIT_V(n) asm volatile("s_waitcnt vmcnt(" #n ")" ::: "memory")
#define PG8_WAIT_L(n) asm volatile("s_waitcnt lgkmcnt(" #n ")" ::: "memory")
#define PG8_BAR __builtin_amdgcn_s_barrier()
#define PG8_SCHED __builtin_amdgcn_sched_barrier(0)
    Unit cur, nxt; int ui = 0;
    if (!S.next(0, cur)) return;
    f32x4 acc[2][2][4][2];
#pragma unroll
    for (int a = 0; a < 2; ++a)
#pragma unroll
        for (int b = 0; b < 2; ++b)
#pragma unroll
            for (int m = 0; m < 4; ++m)
#pragma unroll
                for (int n = 0; n < 2; ++n) acc[a][b][m][n] = (f32x4){0.f, 0.f, 0.f, 0.f};
    bf16x8 At[4][2], B0[2][2], B1[2][2];
    const char* cA = (const char*)g.A + (size_t)cur.pm * tstep; const char* cB = (const char*)g.Bt + (size_t)cur.pn * tstep;
    S.a_ready(cur);
    if constexpr (SP2) {
        PG8_STAGE(PG8_SB(0, 0), cB, voffB); PG8_STAGE(PG8_SB(0, 1), cB + hstep, voffB); PG8_STAGE(PG8_SA(0, 0), cA, voffA); PG8_STAGE(PG8_SA(0, 1), cA + hstep, voffA);
        if (wr == 1) PG8_BAR;
        PG8_WAIT_V(2); PG8_BAR;
        PG8_STAGE(PG8_SB(1, 0), cB + kstep, voffB); PG8_STAGE(PG8_SA(1, 0), cA + kstep, voffA); PG8_STAGE(PG8_SB(1, 1), cB + hstep + kstep, voffB);
        PG8_WAIT_V(6); PG8_BAR;
    } else {
        PG8_STAGE(PG8_SB(0, 0), cB, voffB); PG8_STAGE(PG8_SA(0, 0), cA, voffA); PG8_STAGE(PG8_SB(0, 1), cB + hstep, voffB); PG8_STAGE(PG8_SA(0, 1), cA + hstep, voffA);
        if (wr == 1) PG8_BAR;
        PG8_WAIT_V(4); PG8_BAR;
        PG8_STAGE(PG8_SB(1, 0), cB + kstep, voffB); PG8_STAGE(PG8_SA(1, 0), cA + kstep, voffA); PG8_STAGE(PG8_SB(1, 1), cB + hstep + kstep, voffB);
        PG8_WAIT_V(6); PG8_BAR;
    }
    for (;;) {
        const bool has_next = S.next(ui + 1, nxt);
        const char* nA = has_next ? (const char*)g.A + (size_t)nxt.pm * tstep : cA; const char* nB = has_next ? (const char*)g.Bt + (size_t)nxt.pn * tstep : cB;
        for (int t = 0; t < nt; t += 2) {
            const bool last = (t == nt - 2);
            const char* a1 = cA + (size_t)(t + 1) * kstep;
            const char* a2 = last ? nA : cA + (size_t)(t + 2) * kstep; const char* b2 = last ? nB : cB + (size_t)(t + 2) * kstep;
            const char* a3 = a2 + kstep; const char* b3 = b2 + kstep;
            if (last && has_next) S.a_ready(nxt);
            if constexpr (SP2) {
            PG8_LDB(B0, 0, 0); PG8_LDB(B1, 0, 1); PG8_SCHED; PG8_LDA(At, 0, 0); PG8_STAGE(PG8_SA(1, 1), a1 + hstep, voffA);
            PG8_WAIT_V(8); PG8_WAIT_L(0); PG8_BAR; PG8_MMA(0, 0, At, B0); PG8_MMA(0, 1, At, B1); PG8_BAR; PG8_SCHED;
            PG8_LDA(At, 0, 1); PG8_STAGE(PG8_SB(0, 0), b2, voffB); PG8_STAGE(PG8_SB(0, 1), b2 + hstep, voffB); PG8_STAGE(PG8_SA(0, 0), a2, voffA);
            PG8_WAIT_V(8); PG8_WAIT_L(0); PG8_BAR; PG8_MMA(1, 0, At, B0); PG8_MMA(1, 1, At, B1); PG8_BAR; PG8_SCHED;
            PG8_LDB(B0, 1, 0); PG8_LDB(B1, 1, 1); PG8_SCHED; PG8_LDA(At, 1, 0); PG8_STAGE(PG8_SA(0, 1), a2 + hstep, voffA);
            PG8_WAIT_V(8); PG8_WAIT_L(0); PG8_BAR; PG8_MMA(0, 0, At, B0); PG8_MMA(0, 1, At, B1); PG8_BAR; PG8_SCHED;
            PG8_LDA(At, 1, 1); PG8_STAGE(PG8_SB(1, 0), b3, voffB); PG8_STAGE(PG8_SB(1, 1), b3 + hstep, voffB); PG8_STAGE(PG8_SA(1, 0), a3, voffA);
            PG8_WAIT_V(8); PG8_WAIT_L(0); PG8_BAR; PG8_MMA(1, 0, At, B0); PG8_MMA(1, 1, At, B1); PG8_BAR; PG8_SCHED;
            } else {
            PG8_LDB(B0, 0, 0); PG8_SCHED; PG8_LDA(At, 0, 0); PG8_STAGE(PG8_SA(1, 1), a1 + hstep, voffA);
            PG8_WAIT_L(8); PG8_BAR; PG8_WAIT_L(0); PG8_MMA(0, 0, At, B0); PG8_BAR; PG8_SCHED;
            PG8_LDB(B1, 0, 1); PG8_STAGE(PG8_SB(0, 0), b2, voffB);
            PG8_BAR; PG8_WAIT_L(0); PG8_MMA(0, 1, At, B1); PG8_BAR;
            PG8_LDA(At, 0, 1); PG8_STAGE(PG8_SA(0, 0), a2, voffA);
            PG8_BAR; PG8_WAIT_L(0); PG8_MMA(1, 0, At, B0); PG8_BAR; PG8_SCHED;
            PG8_STAGE(PG8_SB(0, 1), b2 + hstep, voffB);
            PG8_WAIT_V(6); PG8_BAR; PG8_MMA(1, 1, At, B1); PG8_BAR;
            PG8_LDB(B0, 1, 0); PG8_SCHED; PG8_LDA(At, 1, 0); PG8_STAGE(PG8_SA(0, 1), a2 + hstep, voffA);
            PG8_WAIT_L(8); PG8_BAR; PG8_WAIT_L(0); PG8_MMA(0, 0, At, B0); PG8_BAR; PG8_SCHED;
            PG8_LDB(B1, 1, 1); PG8_STAGE(PG8_SB(1, 0), b3, voffB);
            PG8_BAR; PG8_WAIT_L(0); PG8_MMA(0, 1, At, B1); PG8_BAR;
            PG8_LDA(At, 1, 1); PG8_STAGE(PG8_SA(1, 0), a3, voffA);
            PG8_BAR; PG8_WAIT_L(0); PG8_MMA(1, 0, At, B0); PG8_BAR; PG8_SCHED;
            PG8_STAGE(PG8_SB(1, 1), b3 + hstep, voffB);
            PG8_WAIT_V(6); PG8_BAR; PG8_MMA(1, 1, At, B1); PG8_BAR;
            }
        }
        if constexpr (ALIGN_EPI) { if (wr == 0) PG8_BAR; }
        if constexpr (!Epi::AFTER_DRAIN) { E(acc, cur, wr, wc, fr, fq); S.done(cur); }
        if (!has_next) break;
#pragma unroll
        for (int a = 0; a < 2; ++a)
#pragma unroll
            for (int b = 0; b < 2; ++b)
#pragma unroll
                for (int m = 0; m < 4; ++m)
#pragma unroll
                    for (int n = 0; n < 2; ++n) acc[a][b][m][n] = (f32x4){0.f, 0.f, 0.f, 0.f};
        cur = nxt; cA = nA; cB = nB; ++ui;
        if constexpr (ALIGN_EPI) { if (wr == 1) PG8_BAR; }
    }
    PG8_WAIT_V(0);
    if constexpr (!ALIGN_EPI) { if (wr == 0) PG8_BAR; }
    PG8_BAR;
    if constexpr (Epi::AFTER_DRAIN) { E.fused(acc, cur, wr, wc, fr, fq, lds, wid, lane); S.done(cur); }
#undef PG8_SA
#undef PG8_SB
#undef PG8_STAGE
#undef PG8_LDA
#undef PG8_LDB
#undef PG8_MMA
#undef PG8_WAIT_V
#undef PG8_WAIT_L
#undef PG8_BAR
#undef PG8_SCHED
}
}
typedef unsigned v4u __attribute__((ext_vector_type(4)));
typedef float f32x4 __attribute__((ext_vector_type(4)));
typedef short bf16x8 __attribute__((ext_vector_type(8)));
typedef GAS unsigned gu32;
typedef GAS unsigned long long gu64;
#define RLX_AGENT __ATOMIC_RELAXED, __HIP_MEMORY_SCOPE_AGENT
#define LDS_WAIT() asm volatile("s_waitcnt lgkmcnt(0)" ::: "memory")
#define VM_WAIT() asm volatile("s_waitcnt vmcnt(0)" ::: "memory")
__device__ __forceinline__ unsigned long long rt() { return __builtin_amdgcn_s_memrealtime(); }
__device__ __forceinline__ unsigned f2bf(float f) { unsigned u = __builtin_bit_cast(unsigned, f); return (u + 0x7fffu + ((u >> 16) & 1u)) >> 16; }
__device__ __forceinline__ unsigned pk2(float lo, float hi) { return f2bf(lo) | (f2bf(hi) << 16); }

#define XB_TMO      128
#define XB_XCNT(j)  (256  + 64 * (j))
#define XB_XSUB(j)  (1280 + 64 * (j))
#define XB_XGEN(j)  (2304 + 64 * (j))
#define XB_TOP      3328
#define XB_TOPGEN   3392
#define XCD_BAR_WORDS 3456
#define XB_SPIN_CAP (1u << 18)

__device__ __forceinline__ unsigned xb_ld(unsigned* p)              { return __hip_atomic_load(p, __ATOMIC_RELAXED, __HIP_MEMORY_SCOPE_AGENT); }
__device__ __forceinline__ unsigned xb_add(unsigned* p, unsigned v) { return __hip_atomic_fetch_add(p, v, __ATOMIC_RELAXED, __HIP_MEMORY_SCOPE_AGENT); }
__device__ __forceinline__ unsigned xb_xcc_id() { return (unsigned)__builtin_amdgcn_s_getreg((3 << 11) | 20) & 0xFu; }
#define XB_SPIN(cond, bar) do { unsigned _sp = 0; while (cond) { __builtin_amdgcn_s_sleep(1); \
    if ((++_sp & 255u) == 0u) { if (xb_ld(&(bar)[XB_TMO])) break; if (_sp > XB_SPIN_CAP) { atomicAdd(&(bar)[XB_TMO], 1u); break; } } } } while (0)

struct XcdBarrier {
    unsigned* bar; unsigned x;
    volatile LAS unsigned* st;
};

__device__ __forceinline__ XcdBarrier xcd_barrier_post(unsigned* bar, volatile LAS unsigned* st) {
    XcdBarrier b; b.bar = bar; b.x = xb_xcc_id(); b.st = st;
    if (threadIdx.x == 0) (void)xb_add(&bar[XB_XCNT(b.x)], 1u);
    return b;
}
__device__ __forceinline__ void xcd_barrier_complete(unsigned* bar, unsigned x, unsigned& nloc, unsigned& nx) {
    const unsigned G = gridDim.x * gridDim.y * gridDim.z;
    unsigned sum, cnt, mine, sp = 0u;
    for (;;) {
        sum = 0u; cnt = 0u; mine = 0u;
#pragma unroll
        for (unsigned j = 0; j < 16; ++j) { const unsigned c = xb_ld(&bar[XB_XCNT(j)]); sum += c; cnt += (c > 0u) ? 1u : 0u; mine = (j == x) ? c : mine; }
        if (sum == G) break;
        __builtin_amdgcn_s_sleep(1);
        if ((++sp & 255u) == 0u) { if (xb_ld(&bar[XB_TMO])) break; if (sp > XB_SPIN_CAP) { atomicAdd(&bar[XB_TMO], 1u); break; } }
    }
    nloc = mine > 0u ? mine : 1u; nx = cnt > 0u ? cnt : 1u;
}

__device__ __forceinline__ void xcd_barrier(const XcdBarrier& b) {
    asm volatile("s_waitcnt vmcnt(0)" ::: "memory");
    __syncthreads();
    if (threadIdx.x == 0) {
        unsigned* bar = b.bar;
        __builtin_amdgcn_s_waitcnt(0);
        unsigned nloc = b.st[0], nx = b.st[1];
        if (nloc == 0u) { xcd_barrier_complete(bar, b.x, nloc, nx); b.st[0] = nloc; b.st[1] = nx; }
        const unsigned old = xb_add(&bar[XB_XSUB(b.x)], 1u);
        const unsigned gen = old / nloc;
        if (old + 1u == (gen + 1u) * nloc) {
            __builtin_amdgcn_fence(__ATOMIC_RELEASE, "agent");
            asm volatile("s_waitcnt vmcnt(0)" ::: "memory");
            const unsigned og = xb_add(&bar[XB_TOP], 1u);
            const unsigned tg = og / nx;
            if (og + 1u == (tg + 1u) * nx) xb_add(&bar[XB_TOPGEN], 1u);
            else XB_SPIN(xb_ld(&bar[XB_TOPGEN]) == tg, bar);
            __builtin_amdgcn_fence(__ATOMIC_ACQUIRE, "agent");
            xb_add(&bar[XB_XGEN(b.x)], 1u);
            asm volatile("s_waitcnt vmcnt(0)" ::: "memory");
        } else {
            XB_SPIN(xb_ld(&bar[XB_XGEN(b.x)]) == gen, bar);
            __builtin_amdgcn_fence(__ATOMIC_ACQUIRE, "agent");
            asm volatile("s_waitcnt vmcnt(0)" ::: "memory");
        }
    }
    __syncthreads();
}
__device__ __forceinline__ float wave_sum(float v) {
#pragma unroll
    for (int o = 1; o < 64; o <<= 1) v += __shfl_xor(v, o);
    return v;
}
__device__ __forceinline__ int crow(int r, int hi) { return (r & 3) + 8 * (r >> 2) + 4 * hi; }
__device__ __forceinline__ s16x4 vtr(const LAS unsigned char* p) { return __builtin_bit_cast(s16x4, __builtin_amdgcn_ds_read_tr16_b64_v4i16((LAS v4i16_t*)p)); }
__device__ __forceinline__ unsigned cvtpk(float lo, float hi) { return pg8::cvt_pk_bf16(lo, hi); }
__device__ __forceinline__ float bflo(unsigned w) { return __uint_as_float(w << 16); }
__device__ __forceinline__ float bfhi(unsigned w) { return __uint_as_float(w & 0xffff0000u); }
__device__ __forceinline__ float bf1(bf16 h) { return __uint_as_float((unsigned)h << 16); }

__device__ __forceinline__ void tr_item(const float* W, int ldsrc, int col0, int nvalid, const float* gain, int K, bf16* dest, int n0, int kb, LAS float* scr, int lane) {
    const int k0 = 64 * kb; const bool ok = (lane & 31) < nvalid;
#pragma unroll 8
    for (int i = 0; i < 32; ++i) { const int kk = 2 * i + (lane >> 5); float v = 0.f; if (ok) { v = W[(size_t)(k0 + kk) * ldsrc + col0 + (lane & 31)]; if (gain) v *= gain[k0 + kk]; } scr[kk * 33 + (lane & 31)] = v; }
    LDS_WAIT(); asm volatile("" ::: "memory");
    const int c = lane & 7;
#pragma unroll
    for (int j = 0; j < 4; ++j) { const int n = (lane >> 3) + 8 * j; const LAS float* s = scr + (8 * c) * 33 + n;
        v4u o; o.x = cvtpk(s[0 * 33], s[1 * 33]); o.y = cvtpk(s[2 * 33], s[3 * 33]); o.z = cvtpk(s[4 * 33], s[5 * 33]); o.w = cvtpk(s[6 * 33], s[7 * 33]);
        *(GAS v4u*)(dest + (size_t)(n0 + n) * K + k0 + 8 * c) = o; }
    LDS_WAIT(); asm volatile("" ::: "memory");
}
__device__ __forceinline__ int win_src_col(int n0, int& nvalid) {
    const int t = n0 >> 8, j0 = n0 & 255; nvalid = 32;
    if (t < 2) return 256 * t + j0;
    if (t < 6) { const int base = t < 4 ? 512 : 1024, wc = (j0 & 127) >> 5, bj = j0 >> 7; return base + (4 * (t & 1) + wc) * 64 + 32 * bj; }
    if (t < 8) return 1536 + 256 * (t - 6) + j0;
    if (t < 10) return 2048 + 256 * (t - 8) + j0;
    if (t < 12) return 2560 + 256 * (t - 10) + j0;
    if (t == 12) return 3072 + j0;
    if (t == 13) return 3328 + j0;
    if (t < 16) return 3584 + 256 * (t - 14) + j0;
    if (t < 18) return 4112 + 256 * (t - 16) + j0;
    if (t < 34) return 4624 + 256 * (t - 18) + j0;
    nvalid = (j0 == 0) ? 16 : 0; return 4096;
}
__device__ __forceinline__ void prologue(LAS unsigned char* lds, int gw, int NGW, int wave, int lane) {
    asm volatile("" : "+v"(lane));
    LAS float* scr = (LAS float*)(lds + wave * 16384);
    constexpr int I13 = 16 * 176, I2 = 44 * 32, IIN = 16 * 280, IBR = 3 * 8 * 32, IOUT = 16 * 32, IPG = 16 * 32, IPP = 4 * 32, IL = 2 * I13 + 2 * I2 + IIN + IBR + IOUT + IPG + IPP;
    for (int it = gw; it < NL * IL; it += NGW) {
        KParams P = params_ptr(); const int L = it / IL; int r = it - L * IL; unsigned char* wl = P->ws + WS_W + (size_t)L * LW;
        if (r < 2 * I13) { const int which = r / I13; r -= which * I13; const int kb = r / 176, nb = r % 176, n0 = 32 * nb, tile = n0 >> 8, j0 = n0 & 255;
            const float* w1 = P->in[which ? I_F2W1 : I_F1W1] + (size_t)L * DM * DFF; const float* w3 = P->in[which ? I_F2W3 : I_F1W3] + (size_t)L * DM * DFF; const float* gn = P->in[which ? I_N2 : I_N1] + L * DM;
            tr_item(j0 < 128 ? w1 : w3, DFF, 128 * tile + (j0 & 127), 32, gn, DM, (bf16*)(wl + (which ? OW13B : OW13A)), n0, kb, scr, lane); continue; }
        r -= 2 * I13;
        if (r < 2 * I2) { const int which = r / I2; r -= which * I2; const int kb = r / 32, nb = r % 32;
            tr_item(P->in[which ? I_F2W2 : I_F1W2] + (size_t)L * DFF * DM, DM, 32 * nb, 32, nullptr, DFF, (bf16*)(wl + (which ? OW2B : OW2A)), 32 * nb, kb, scr, lane); continue; }
        r -= 2 * I2;
        if (r < IIN) { const int kb = r / 280, nb = r % 280; int nv; const int sc = win_src_col(32 * nb, nv);
            tr_item(P->in[I_WIN] + (size_t)L * DM * 8720, 8720, sc, nv, P->in[I_NM] + L * DM, DM, (bf16*)(wl + OWIN), 32 * nb, kb, scr, lane); continue; }
        r -= IIN;
        if (r < IBR) { const int b = 1 + r / 256; r &= 255; const int kb = r / 32, nb = r % 32;
            tr_item(P->in[I_WBR] + ((size_t)L * 4 + b) * 512 * 1024, 1024, 32 * nb, 32, nullptr, 512, (bf16*)(wl + OWBR) + (size_t)b * 1024 * 512, 32 * nb, kb, scr, lane); continue; }
        r -= IBR;
        if (r < IOUT) { const int kb = r / 32, nb = r % 32; tr_item(P->in[I_WOUT] + (size_t)L * DM * DM, DM, 32 * nb, 32, nullptr, DM, (bf16*)(wl + OWOUT), 32 * nb, kb, scr, lane); continue; }
        r -= IOUT;
        if (r < IPG) { const int kb = r / 32, nb = r % 32; tr_item(P->in[I_WPG] + (size_t)L * DM * DM, DM, 32 * nb, 32, P->in[I_NPL] + L * DM, DM, (bf16*)(wl + OWPG), 32 * nb, kb, scr, lane); continue; }
        r -= IPG;
        { const int kb = r / 32, nb = r % 32; tr_item(P->in[I_WPP] + (size_t)L * 256 * DM, DM, 32 * nb, 32, nullptr, 256, (bf16*)(wl + OWPP), 32 * nb, kb, scr, lane); }
    }
    for (int it = gw; it < NL * 512 * 16; it += NGW) {
        KParams P = params_ptr(); unsigned char* ws = P->ws; const int L = it / (512 * 16); const int r = it - L * 512 * 16; const int k = r >> 4, n = (r & 15) * 64 + lane, g = k >> 7;
        const float* pw = P->in[I_POOLW] + ((size_t)L * 512 + k) * 128; const float* sc = P->in[I_POOLS] + L * 512 + g * 128; const float* wb = P->in[I_WBR] + ((size_t)L * 4) * 512 * 1024 + (size_t)(g * 128) * 1024 + n;
        float a = 0.f;
#pragma unroll 8
        for (int d = 0; d < 128; ++d) a += pw[d] * sc[d] * wb[(size_t)d * 1024];
        ((bf16*)(ws + WS_W + (size_t)L * LW + OWBR))[(size_t)n * 512 + k] = (bf16)(cvtpk(a, 0.f) & 0xffffu);
    }
    for (int it = gw * 64 + lane; it < NL * 4 * 128 * 128; it += NGW * 64) {
        KParams P = params_ptr(); unsigned char* ws = P->ws; const int L = it >> 16, r = it & 65535, i = (r >> 7) & 127, j = r & 127;
        const float v = ((j >> 6) <= (i >> 6)) ? P->in[I_GWS][it] : 0.f;
        ((bf16*)(ws + WS_W + (size_t)L * LW + OWM))[r] = (bf16)(cvtpk(v, 0.f) & 0xffffu);
    }
    for (int m = gw; m < M; m += NGW) {
        KParams P = params_ptr(); unsigned char* ws = P->ws;
        const float* src = m < MP ? P->in[I_XP] + (size_t)m * DM : P->in[I_XS] + (size_t)(m - MP) * DM;
        const GAS f32x4* xr = (const GAS f32x4*)src + lane; f32x4 v[4]; float s = 0.f;
#pragma unroll
        for (int j = 0; j < 4; ++j) { v[j] = xr[64 * j]; s += (v[j].x * v[j].x + v[j].y * v[j].y) + (v[j].z * v[j].z + v[j].w * v[j].w); }
        s = wave_sum(s);
        GAS f32x4* xo = (GAS f32x4*)(P->out + O_X + (size_t)m * DM) + lane; GAS u32x2* bo = (GAS u32x2*)((bf16*)(ws + WS_XB0) + (size_t)m * DM) + lane;
#pragma unroll
        for (int j = 0; j < 4; ++j) { xo[64 * j] = v[j]; u32x2 w; w.x = cvtpk(v[j].x, v[j].y); w.y = cvtpk(v[j].z, v[j].w); bo[64 * j] = w; }
        if (lane < 16) ((float*)(ws + WS_SSQ0))[(size_t)m * 16 + lane] = lane == 0 ? s : 0.f;
    }
    for (int it = gw; it < NL * M; it += NGW) {
        KParams P = params_ptr(); unsigned char* ws = P->ws; const int L = it / M, m = it - L * M;
        const float* src = m < MP ? P->in[I_PP] + ((size_t)L * MP + m) * 256 : P->in[I_PS] + ((size_t)L * MS + (m - MP)) * 256;
        const f32x4 v = ((const GAS f32x4*)src)[lane]; u32x2 w; w.x = cvtpk(v.x, v.y); w.y = cvtpk(v.z, v.w);
        ((GAS u32x2*)((bf16*)(ws + WS_PB) + (size_t)it * 256))[lane] = w;
    }
}

__device__ __forceinline__ void pool_load(f32x4& a, f32x4& b, const bf16* xpb, const float* hist, int rowbase, int t, int c0) {
    if (t >= 0) { const v4u w = *(const GAS v4u*)(xpb + (size_t)(rowbase + t) * 512 + c0); a = (f32x4){bflo(w.x), bfhi(w.x), bflo(w.y), bfhi(w.y)}; b = (f32x4){bflo(w.z), bfhi(w.z), bflo(w.w), bfhi(w.w)}; }
    else if (hist) { const float* h = hist + (size_t)(15 + t) * 512 + c0; a = *(const f32x4*)h; b = *(const f32x4*)(h + 4); }
    else { a = (f32x4){0.f, 0.f, 0.f, 0.f}; b = a; }
}
__device__ __forceinline__ void pool_unit(int L, int unit, int lane) {
    KParams P = params_ptr(); asm volatile("" : "+v"(lane));
    const bf16* xpb = (const bf16*)(P->ws + WS_XPB); bf16* D = (bf16*)(P->ws + WS_AB);
    const int row0 = unit * 16; const bool prompt = row0 < MP;
    int rowbase, t0; const float* hist = nullptr; float* pout; int pfirst;
    if (prompt) { const int b = row0 >> 12; rowbase = b << 12; t0 = row0 & 4095; pout = P->out + O_POOLP + ((size_t)L * 8 + b) * 15 * 512; pfirst = 4081; }
    else { const int b = (row0 - MP) >> 5; rowbase = MP + (b << 5); t0 = (row0 - MP) & 31; hist = P->in[I_SPOOL] + ((size_t)L * 16 + b) * 15 * 512; pout = P->out + O_POOLS + ((size_t)L * 16 + b) * 15 * 512; pfirst = 17; }
    const int c0 = lane * 8, w = 2 << (lane >> 4);
    f32x4 s0 = (f32x4){0.f, 0.f, 0.f, 0.f}, s1 = s0, a, b;
    for (int d = w - 1; d >= 1; --d) { pool_load(a, b, xpb, hist, rowbase, t0 - d, c0); s0 = s0 + a; s1 = s1 + b; }
    for (int i = 0; i < 16; ++i) {
        const int t = t0 + i; pool_load(a, b, xpb, hist, rowbase, t, c0); s0 = s0 + a; s1 = s1 + b;
        const int cnt = prompt ? (t + 1 < w ? t + 1 : w) : w; const float inv = 1.0f / (float)cnt;
        const f32x4 d0 = s0 * inv - a, d1 = s1 * inv - b;
        *(GAS v4u*)(D + (size_t)(rowbase + t) * 512 + c0) = pg8::pack8(d0, d1);
        if (t >= pfirst) { float* po = pout + (size_t)(t - pfirst) * 512 + c0; *(f32x4*)po = a; *(f32x4*)(po + 4) = b; }
        pool_load(a, b, xpb, hist, rowbase, t - w + 1, c0); s0 = s0 - a; s1 = s1 - b;
    }
}

__device__ __forceinline__ void sb_unit(LAS unsigned char* wl, int lane, int L, int unit) {
    KParams P = params_ptr(); asm volatile("" : "+v"(lane));
    const bf16* Qb = (const bf16*)(P->ws + WS_QB); const bf16* Kb = (const bf16*)(P->ws + WS_KB); const bf16* Vb = (const bf16*)(P->ws + WS_VB); bf16* Y = (bf16*)(P->ws + WS_AB) + (size_t)M * 512;
    int newrow0, nnew, npast, qidx0, h; const float* ck = nullptr; const float* cv = nullptr;
    if (unit < 8192) { const int b = unit >> 10, r = unit & 1023; h = r >> 7; qidx0 = (r & 127) * 32; newrow0 = b << 12; nnew = 4096; npast = 0; }
    else { const int r = unit - 8192, b = r >> 3; h = r & 7; qidx0 = 0; newrow0 = MP + (b << 5); nnew = 32; npast = 4096;
        ck = P->in[I_CK] + ((size_t)L * 16 + b) * 4096 * 512; cv = P->in[I_CV] + ((size_t)L * 16 + b) * 4096 * 512; }
    const int r32 = lane & 31, hi = lane >> 5; const int qrow0 = newrow0 + qidx0;
    pg8::bf16x8 qf[4];
    { const bf16* qp = Qb + (size_t)(qrow0 + r32) * 512 + h * 64 + hi * 8;
#pragma unroll
      for (int d0 = 0; d0 < 4; ++d0) qf[d0] = *(const GAS pg8::bf16x8*)(qp + d0 * 16); }
    f32x16 o0, o1;
#pragma unroll
    for (int r = 0; r < 16; ++r) { o0[r] = 0.f; o1[r] = 0.f; }
    float R2 = 0.f;
    const int qpos0 = npast + qidx0, jd = qpos0 >> 6;
    for (int j = jd; j >= 0; --j) {
        if (__all(R2 >= 128.f)) break;
        const int p0 = 64 * j;
        if (p0 >= npast) {
            v4u kv[8], vv[8];
#pragma unroll
            for (int i = 0; i < 8; ++i) { const int r = (lane >> 3) + 8 * i; int idx = p0 - npast + r; idx = idx < nnew ? idx : nnew - 1;
                const size_t off = (size_t)(newrow0 + idx) * 512 + h * 64 + (lane & 7) * 8; kv[i] = *(const GAS v4u*)(Kb + off); vv[i] = *(const GAS v4u*)(Vb + off); }
#pragma unroll
            for (int i = 0; i < 8; ++i) { const int r = (lane >> 3) + 8 * i;
                *(LAS v4u*)(wl + r * 128 + (((lane & 7) ^ (r & 7)) * 16)) = kv[i]; *(LAS v4u*)(wl + 8192 + r * 128 + (lane & 7) * 16) = vv[i]; }
        } else {
#pragma unroll
            for (int hf = 0; hf < 2; ++hf) {
                f32x4 kk[8], vv[8];
#pragma unroll
                for (int i = 0; i < 8; ++i) { const int r = (lane >> 4) + 4 * (8 * hf + i); const size_t off = ((size_t)(p0 + r) * 8 + h) * 64 + (lane & 15) * 4; kk[i] = *(const GAS f32x4*)(ck + off); vv[i] = *(const GAS f32x4*)(cv + off); }
#pragma unroll
                for (int i = 0; i < 8; ++i) { const int r = (lane >> 4) + 4 * (8 * hf + i); u32x2 a, b; a.x = cvtpk(kk[i].x, kk[i].y); a.y = cvtpk(kk[i].z, kk[i].w); b.x = cvtpk(vv[i].x, vv[i].y); b.y = cvtpk(vv[i].z, vv[i].w);
                    *(LAS u32x2*)(wl + r * 128 + ((((lane & 15) >> 1) ^ (r & 7)) * 16) + (lane & 1) * 8) = a; *(LAS u32x2*)(wl + 8192 + r * 128 + (lane & 15) * 8) = b; }
            }
        }
        asm volatile("" ::: "memory");
        f32x16 p[2];
#pragma unroll
        for (int kh = 0; kh < 2; ++kh) {
#pragma unroll
            for (int r = 0; r < 16; ++r) p[kh][r] = 0.f;
#pragma unroll
            for (int d0 = 0; d0 < 4; ++d0) { const int row = 32 * kh + r32; const pg8::bf16x8 kf = *(const LAS pg8::bf16x8*)(wl + row * 128 + (((2 * d0 + hi) ^ (row & 7)) * 16));
                p[kh] = __builtin_amdgcn_mfma_f32_32x32x16_bf16(kf, qf[d0], p[kh], 0, 0, 0); }
        }
        const float f = __builtin_amdgcn_exp2f(-R2);
        f32x16 w[2];
        const bool diag = (j == jd);
#pragma unroll
        for (int kh = 0; kh < 2; ++kh)
#pragma unroll
            for (int r = 0; r < 16; ++r) { float s = p[kh][r]; s = s < 60.f ? s : 60.f; float u = __builtin_amdgcn_exp2f(s); float ww = 1.0f + u;
                if (diag) { const bool valid = (p0 + 32 * kh + crow(r, hi)) < (qpos0 + r32); u = valid ? u : 0.f; ww = valid ? ww : 1.0f; }
                p[kh][r] = u; w[kh][r] = ww; }
        float gp[16];
#pragma unroll
        for (int kh = 0; kh < 2; ++kh)
#pragma unroll
            for (int a = 0; a < 4; ++a) { const float g = (w[kh][4 * a] * w[kh][4 * a + 1]) * (w[kh][4 * a + 2] * w[kh][4 * a + 3]); const float og = __shfl_xor(g, 32);
                gp[8 * kh + 2 * a] = hi ? og : g; gp[8 * kh + 2 * a + 1] = hi ? g : og; }
        float E[16]; E[15] = 1.0f;
#pragma unroll
        for (int G = 14; G >= 0; --G) E[G] = E[G + 1] * gp[G + 1];
        const float T = E[0] * gp[0];
#pragma unroll
        for (int kh = 0; kh < 2; ++kh)
#pragma unroll
            for (int a = 0; a < 4; ++a) { const float e = hi ? E[8 * kh + 2 * a + 1] : E[8 * kh + 2 * a];
                const float D3 = e * w[kh][4 * a + 3], D2 = D3 * w[kh][4 * a + 2], D1 = D2 * w[kh][4 * a + 1], D0 = D1 * w[kh][4 * a];
                p[kh][4 * a + 3] = p[kh][4 * a + 3] * __builtin_amdgcn_rcpf(D3) * f; p[kh][4 * a + 2] = p[kh][4 * a + 2] * __builtin_amdgcn_rcpf(D2) * f;
                p[kh][4 * a + 1] = p[kh][4 * a + 1] * __builtin_amdgcn_rcpf(D1) * f; p[kh][4 * a] = p[kh][4 * a] * __builtin_amdgcn_rcpf(D0) * f; }
        R2 += __builtin_amdgcn_logf(T);
#pragma unroll
        for (int s = 0; s < 4; ++s) {
            const int kh = s >> 1, rb = 8 * (s & 1);
            v4u pw; pw.x = cvtpk(p[kh][rb], p[kh][rb + 1]); pw.y = cvtpk(p[kh][rb + 2], p[kh][rb + 3]); pw.z = cvtpk(p[kh][rb + 4], p[kh][rb + 5]); pw.w = cvtpk(p[kh][rb + 6], p[kh][rb + 7]);
            const pg8::bf16x8 pf = __builtin_bit_cast(pg8::bf16x8, pw);
            const LAS unsigned char* vbase = wl + 8192 + (16 * s + 4 * hi + ((lane & 15) >> 2)) * 128 + ((lane >> 4) & 1) * 32 + (lane & 3) * 8;
#pragma unroll
            for (int dh = 0; dh < 2; ++dh) { const s16x4 lo = vtr(vbase + dh * 64), h4 = vtr(vbase + dh * 64 + 8 * 128);
                const pg8::bf16x8 vf = (pg8::bf16x8){lo[0], lo[1], lo[2], lo[3], h4[0], h4[1], h4[2], h4[3]};
                if (dh == 0) o0 = __builtin_amdgcn_mfma_f32_32x32x16_bf16(pf, vf, o0, 0, 0, 0); else o1 = __builtin_amdgcn_mfma_f32_32x32x16_bf16(pf, vf, o1, 0, 0, 0); }
        }
        asm volatile("" ::: "memory");
    }
    bf16* yp = Y + (size_t)qrow0 * 512 + h * 64 + r32;
#pragma unroll
    for (int r = 0; r < 16; ++r) { bf16* q = yp + (size_t)crow(r, hi) * 512; q[0] = (bf16)(cvtpk(o0[r], 0.f) & 0xffffu); q[32] = (bf16)(cvtpk(o1[r], 0.f) & 0xffffu); }
}

__device__ __forceinline__ void gmlp_unit(LAS unsigned char* wl, int lane, int L, int unit) {
    KParams P = params_ptr(); asm volatile("" : "+v"(lane));
    const bf16* gub = (const bf16*)(P->ws + WS_GUB); const bf16* gvb = (const bf16*)(P->ws + WS_GVB); bf16* Y = (bf16*)(P->ws + WS_AB) + (size_t)2 * M * 512;
    int row0, ntok, g, cb;
    if (unit < 4096) { const int ch = unit >> 4; g = (unit >> 2) & 3; cb = unit & 3; row0 = ch * 128; ntok = 128; }
    else { const int r = unit - 4096, b = r >> 4; g = (r >> 2) & 3; cb = r & 3; row0 = MP + b * 32; ntok = 32; }
    const bf16* wm = (const bf16*)(P->ws + WS_W + (size_t)L * LW + OWM) + (size_t)g * 128 * 128; const float* bs = P->in[I_GB] + ((size_t)L * 4 + g) * 128;
    const int r32 = lane & 31, hi = lane >> 5; const int colb = g * 128 + cb * 32;
    for (int i = 0; i < ntok / 16; ++i) { const int r = (lane >> 2) + 16 * i; *(LAS v4u*)(wl + r * 80 + (lane & 3) * 16) = *(const GAS v4u*)(gvb + (size_t)(row0 + r) * 512 + colb + (lane & 3) * 8); }
    asm volatile("" ::: "memory");
    const int nib = ntok / 32;
    for (int ib = 0; ib < nib; ++ib) {
        f32x16 acc;
#pragma unroll
        for (int r = 0; r < 16; ++r) acc[r] = 0.f;
        const int ns = ntok == 32 ? 2 : (ib < 2 ? 4 : 8);
        for (int s = 0; s < ns; ++s) {
            const pg8::bf16x8 af = *(const GAS pg8::bf16x8*)(wm + (size_t)(32 * ib + r32) * 128 + 16 * s + 8 * hi);
            const LAS unsigned char* bb = wl + (16 * s + 8 * hi + ((lane & 15) >> 2)) * 80 + ((lane >> 4) & 1) * 32 + (lane & 3) * 8;
            const s16x4 lo = vtr(bb), h4 = vtr(bb + 4 * 80);
            const pg8::bf16x8 bfr = (pg8::bf16x8){lo[0], lo[1], lo[2], lo[3], h4[0], h4[1], h4[2], h4[3]};
            acc = __builtin_amdgcn_mfma_f32_32x32x16_bf16(af, bfr, acc, 0, 0, 0);
        }
#pragma unroll
        for (int r = 0; r < 16; ++r) { const int i = 32 * ib + crow(r, hi); const size_t off = (size_t)(row0 + i) * 512 + colb + r32;
            const float sv = acc[r] + bs[i]; Y[off] = (bf16)(cvtpk(bf1(gub[off]) * sv, 0.f) & 0xffffu); }
    }
    asm volatile("" ::: "memory");
}

__device__ __forceinline__ void gla_ids(int cid, int& row0, int& ntok, int& h) {
    if (cid < 2048) { const int sq = cid >> 6, c = cid & 63; h = sq & 3; row0 = (sq >> 2) * 4096 + c * 64; ntok = 64; }
    else { const int sq = cid - 2048; h = sq & 3; row0 = MP + (sq >> 2) * 32; ntok = 32; }
}
__device__ __forceinline__ void gla_pass_a(LAS unsigned char* lds, int L, int cid, int tid, int wave, int lane) {
    KParams P = params_ptr(); asm volatile("" : "+v"(tid)); lane = tid & 63;
    LAS float* LA = (LAS float*)lds;
    LAS float* WA = LA + 64 * 17;
    LAS float* BA = WA + 16 * 64;
    LAS float* G = BA + 64;
    LAS float* QT = G + 64 * 65;
    LAS float* KT = QT + 64 * 65;
    LAS float* V = KT + 64 * 65;
    int row0, ntok, h; gla_ids(cid, row0, ntok, h);
    const bf16* lab = (const bf16*)(P->ws + WS_LAB); const bf16* lqb = (const bf16*)(P->ws + WS_LQB); const bf16* lkb = (const bf16*)(P->ws + WS_LKB); const bf16* lvb = (const bf16*)(P->ws + WS_LVB);
    const int t = tid >> 3, q8 = tid & 7; const bool live = t < ntok;
    { unsigned w = 0u; if (live) w = *(const GAS unsigned*)(lab + (size_t)(row0 + t) * 256 + 2 * q8); LA[t * 17 + 2 * q8] = bflo(w); LA[t * 17 + 2 * q8 + 1] = bfhi(w); }
    { const int e = 2 * tid; const int r = e >> 6, k = e & 63; const float* wa = P->in[I_WA2] + ((size_t)L * 16 + r) * 256 + h * 64 + k; WA[r * 64 + k] = wa[0]; WA[r * 64 + k + 1] = wa[1]; }
    if (tid < 64) BA[tid] = P->in[I_BA][L * 256 + h * 64 + tid];
    { v4u a = (v4u){0u, 0u, 0u, 0u}, b = a, c = a, d = a;
      if (live) { a = *(const GAS v4u*)(lqb + (size_t)(row0 + t) * 256 + h * 64 + 8 * q8); b = *(const GAS v4u*)(lkb + (size_t)(row0 + t) * 256 + h * 64 + 8 * q8);
                  c = *(const GAS v4u*)(lvb + (size_t)(row0 + t) * 512 + h * 128 + 16 * q8); d = *(const GAS v4u*)(lvb + (size_t)(row0 + t) * 512 + h * 128 + 16 * q8 + 8); }
      LAS float* qd = QT + t * 65 + 8 * q8; qd[0] = bflo(a.x); qd[1] = bfhi(a.x); qd[2] = bflo(a.y); qd[3] = bfhi(a.y); qd[4] = bflo(a.z); qd[5] = bfhi(a.z); qd[6] = bflo(a.w); qd[7] = bfhi(a.w);
      LAS float* kd = KT + t * 65 + 8 * q8; kd[0] = bflo(b.x); kd[1] = bfhi(b.x); kd[2] = bflo(b.y); kd[3] = bfhi(b.y); kd[4] = bflo(b.z); kd[5] = bfhi(b.z); kd[6] = bflo(b.w); kd[7] = bfhi(b.w);
      LAS float* vd = V + t * 128 + 16 * q8; vd[0] = bflo(c.x); vd[1] = bfhi(c.x); vd[2] = bflo(c.y); vd[3] = bfhi(c.y); vd[4] = bflo(c.z); vd[5] = bfhi(c.z); vd[6] = bflo(c.w); vd[7] = bfhi(c.w);
      vd[8] = bflo(d.x); vd[9] = bfhi(d.x); vd[10] = bflo(d.y); vd[11] = bfhi(d.y); vd[12] = bflo(d.z); vd[13] = bfhi(d.z); vd[14] = bflo(d.w); vd[15] = bfhi(d.w); }
    __syncthreads();
#pragma unroll
    for (int kk = 0; kk < 8; ++kk) { const int k = 8 * q8 + kk; float x = BA[k];
#pragma unroll
        for (int r = 0; r < 16; ++r) x += LA[t * 17 + r] * WA[r * 64 + k];
        const float ax = __builtin_fabsf(x); const float l2 = 1.4426950408889634f * (x < 0.f ? x : 0.f) - __builtin_amdgcn_logf(1.0f + __builtin_amdgcn_exp2f(-1.4426950408889634f * ax));
        G[t * 65 + k] = live ? l2 * (1.0f / 16.0f) : 0.f; }
    __syncthreads();
    if (tid < 64) { float b2 = 0.f; for (int s = 0; s < 64; ++s) { b2 += G[s * 65 + tid]; G[s * 65 + tid] = b2; } }
    __syncthreads();
    float* qt = (float*)(P->ws + WS_QT); float* kt = (float*)(P->ws + WS_KT);
    { f32x4 qo[2], ko[2];
#pragma unroll
      for (int kk = 0; kk < 8; ++kk) { const int k = 8 * q8 + kk; float b2 = G[t * 65 + k]; b2 = b2 > -120.f ? b2 : -120.f;
          const float qv = QT[t * 65 + k] * __builtin_amdgcn_exp2f(b2) * 0.125f, kv = KT[t * 65 + k] * __builtin_amdgcn_exp2f(-b2); QT[t * 65 + k] = qv; KT[t * 65 + k] = kv; qo[kk >> 2][kk & 3] = qv; ko[kk >> 2][kk & 3] = kv; }
      if (live) { float* qg = qt + (size_t)(row0 + t) * 256 + h * 64 + 8 * q8; *(f32x4*)qg = qo[0]; *(f32x4*)(qg + 4) = qo[1]; float* kg = kt + (size_t)(row0 + t) * 256 + h * 64 + 8 * q8; *(f32x4*)kg = ko[0]; *(f32x4*)(kg + 4) = ko[1]; } }
    if (tid < 64) { float b2 = G[63 * 65 + tid]; b2 = b2 > -120.f ? b2 : -120.f; ((float*)(P->ws + WS_LAM))[(size_t)cid * 64 + tid] = __builtin_amdgcn_exp2f(b2); }
    __syncthreads();
    { const int kb = wave & 1, vb = wave >> 1, r32 = lane & 31, hi = lane >> 5;
      f32x16 acc;
#pragma unroll
      for (int r = 0; r < 16; ++r) acc[r] = 0.f;
      for (int s2 = 0; s2 < 32; ++s2) { const float a = KT[(2 * s2 + hi) * 65 + 32 * kb + r32], b = V[(2 * s2 + hi) * 128 + 32 * vb + r32]; acc = __builtin_amdgcn_mfma_f32_32x32x2f32(a, b, acc, 0, 0, 0); }
      float* ds = (float*)(P->ws + WS_DS) + (size_t)cid * 8192;
#pragma unroll
      for (int r = 0; r < 16; ++r) ds[(32 * kb + crow(r, hi)) * 128 + 32 * vb + r32] = acc[r]; }
    __syncthreads();
}
__device__ __forceinline__ void gla_scan(int L, int gtid, int ngt) {
    KParams P = params_ptr(); asm volatile("" : "+v"(gtid));
    const float* ds = (const float*)(P->ws + WS_DS); const float* lam = (const float*)(P->ws + WS_LAM); float* sc = (float*)(P->ws + WS_SC);
    for (int it = gtid; it < NSEQ * 8192; it += ngt) {
        const int sq = it >> 13, e = it & 8191, k = e >> 7;
        float S; int cid0, nch; float* outp;
        if (sq < 32) { S = 0.f; cid0 = sq * 64; nch = 64; outp = P->out + O_GLAP + ((size_t)L * 32 + sq) * 8192 + e; }
        else { const int s2 = sq - 32; S = P->in[I_SGLA][((size_t)L * 64 + s2) * 8192 + e]; cid0 = 2048 + s2; nch = 1; outp = P->out + O_GLAS + ((size_t)L * 64 + s2) * 8192 + e; }
        for (int c = 0; c < nch; ++c) { const size_t o = (size_t)(cid0 + c) * 8192 + e; sc[o] = S; S = lam[(size_t)(cid0 + c) * 64 + k] * (S + ds[o]); }
        *outp = S;
    }
}
__device__ __forceinline__ void gla_pass_c(LAS unsigned char* lds, int L, int cid, int tid, int wave, int lane) {
    KParams P = params_ptr(); asm volatile("" : "+v"(tid)); lane = tid & 63;
    LAS float* QT = (LAS float*)lds;
    LAS float* KT = QT + 64 * 65;
    LAS float* V = KT + 64 * 65;
    LAS float* S = V + 64 * 128;
    LAS float* AT = S + 64 * 128;
    int row0, ntok, h; gla_ids(cid, row0, ntok, h);
    const float* qt = (const float*)(P->ws + WS_QT); const float* kt = (const float*)(P->ws + WS_KT); const bf16* lvb = (const bf16*)(P->ws + WS_LVB); const float* sc = (const float*)(P->ws + WS_SC) + (size_t)cid * 8192;
    const int t = tid >> 3, q8 = tid & 7; const bool live = t < ntok; const int r32 = lane & 31, hi = lane >> 5;
    { f32x4 z4 = (f32x4){0.f, 0.f, 0.f, 0.f}; f32x4 a0 = z4, a1 = z4, b0 = z4, b1 = z4; v4u c = (v4u){0u, 0u, 0u, 0u}, d = c;
      if (live) { const float* qg = qt + (size_t)(row0 + t) * 256 + h * 64 + 8 * q8; a0 = *(const f32x4*)qg; a1 = *(const f32x4*)(qg + 4); const float* kg = kt + (size_t)(row0 + t) * 256 + h * 64 + 8 * q8; b0 = *(const f32x4*)kg; b1 = *(const f32x4*)(kg + 4);
                  c = *(const GAS v4u*)(lvb + (size_t)(row0 + t) * 512 + h * 128 + 16 * q8); d = *(const GAS v4u*)(lvb + (size_t)(row0 + t) * 512 + h * 128 + 16 * q8 + 8); }
      LAS float* qd = QT + t * 65 + 8 * q8; LAS float* kd = KT + t * 65 + 8 * q8;
#pragma unroll
      for (int j = 0; j < 4; ++j) { qd[j] = a0[j]; qd[4 + j] = a1[j]; kd[j] = b0[j]; kd[4 + j] = b1[j]; }
      LAS float* vd = V + t * 128 + 16 * q8; vd[0] = bflo(c.x); vd[1] = bfhi(c.x); vd[2] = bflo(c.y); vd[3] = bfhi(c.y); vd[4] = bflo(c.z); vd[5] = bfhi(c.z); vd[6] = bflo(c.w); vd[7] = bfhi(c.w);
      vd[8] = bflo(d.x); vd[9] = bfhi(d.x); vd[10] = bflo(d.y); vd[11] = bfhi(d.y); vd[12] = bflo(d.z); vd[13] = bfhi(d.z); vd[14] = bflo(d.w); vd[15] = bfhi(d.w);
#pragma unroll
      for (int j = 0; j < 4; ++j) *(LAS f32x4*)(S + tid * 16 + 4 * j) = *(const f32x4*)(sc + tid * 16 + 4 * j); }
    __syncthreads();
    if (wave < 3) {
        const int sb = wave == 2 ? 1 : 0, tb = wave == 0 ? 0 : 1;
        f32x16 acc;
#pragma unroll
        for (int r = 0; r < 16; ++r) acc[r] = 0.f;
        for (int k2 = 0; k2 < 32; ++k2) { const float a = KT[(32 * sb + r32) * 65 + 2 * k2 + hi], b = QT[(32 * tb + r32) * 65 + 2 * k2 + hi]; acc = __builtin_amdgcn_mfma_f32_32x32x2f32(a, b, acc, 0, 0, 0); }
#pragma unroll
        for (int r = 0; r < 16; ++r) { const int s = 32 * sb + crow(r, hi), tt = 32 * tb + r32; AT[s * 64 + tt] = s <= tt ? acc[r] : 0.f; }
    }
    __syncthreads();
    f32x16 o;
    { const int tb = wave & 1, vb = wave >> 1;
#pragma unroll
      for (int r = 0; r < 16; ++r) o[r] = 0.f;
      for (int k2 = 0; k2 < 32; ++k2) { const float a = QT[(32 * tb + r32) * 65 + 2 * k2 + hi], b = S[(2 * k2 + hi) * 128 + 32 * vb + r32]; o = __builtin_amdgcn_mfma_f32_32x32x2f32(a, b, o, 0, 0, 0); }
      const int ns = 16 * (tb + 1);
      for (int s2 = 0; s2 < ns; ++s2) { const float a = AT[(2 * s2 + hi) * 64 + 32 * tb + r32], b = V[(2 * s2 + hi) * 128 + 32 * vb + r32]; o = __builtin_amdgcn_mfma_f32_32x32x2f32(a, b, o, 0, 0, 0); } }
    __syncthreads();
    { const int tb = wave & 1, vb = wave >> 1;
#pragma unroll
      for (int r = 0; r < 16; ++r) S[(32 * tb + crow(r, hi)) * 128 + 32 * vb + r32] = o[r]; }
    __syncthreads();
    { float v[16]; float ss = 0.f;
#pragma unroll
      for (int j = 0; j < 16; ++j) { v[j] = S[t * 128 + 16 * q8 + j]; ss += v[j] * v[j]; }
      ss += __shfl_xor(ss, 1); ss += __shfl_xor(ss, 2); ss += __shfl_xor(ss, 4);
      const float rs = __builtin_amdgcn_rsqf(ss * (1.0f / 128.0f) + 1e-6f);
      if (live) { const bf16* lrb = (const bf16*)(P->ws + WS_LRB) + (size_t)(row0 + t) * 512 + h * 128 + 16 * q8; const float* gon = P->in[I_GON] + L * 128 + 16 * q8;
          const v4u l0 = *(const GAS v4u*)lrb, l1 = *(const GAS v4u*)(lrb + 8);
          const float lr[16] = {bflo(l0.x), bfhi(l0.x), bflo(l0.y), bfhi(l0.y), bflo(l0.z), bfhi(l0.z), bflo(l0.w), bfhi(l0.w), bflo(l1.x), bfhi(l1.x), bflo(l1.y), bfhi(l1.y), bflo(l1.z), bfhi(l1.z), bflo(l1.w), bfhi(l1.w)};
          float y[16];
#pragma unroll
          for (int j = 0; j < 16; ++j) y[j] = v[j] * rs * gon[j] * lr[j];
          bf16* yo = (bf16*)(P->ws + WS_AB) + (size_t)3 * M * 512 + (size_t)(row0 + t) * 512 + h * 128 + 16 * q8;
          v4u w0, w1; w0.x = cvtpk(y[0], y[1]); w0.y = cvtpk(y[2], y[3]); w0.z = cvtpk(y[4], y[5]); w0.w = cvtpk(y[6], y[7]); w1.x = cvtpk(y[8], y[9]); w1.y = cvtpk(y[10], y[11]); w1.z = cvtpk(y[12], y[13]); w1.w = cvtpk(y[14], y[15]);
          *(GAS v4u*)yo = w0; *(GAS v4u*)(yo + 8) = w1; } }
    __syncthreads();
}

__global__ void __launch_bounds__(NWAVES * 64, 2) hybrid_fwd(Params Pargs) {
    extern __shared__ __attribute__((aligned(16))) unsigned char lds_raw[];
    LAS unsigned char* lds = (LAS unsigned char*)lds_raw;
    const int tid = threadIdx.x, lane = tid & 63, wave = __builtin_amdgcn_readfirstlane(tid >> 6);
    const int G = gridDim.x, bx = blockIdx.x;
    const int vcu = (G % 8 == 0) ? (bx % 8) * (G / 8) + bx / 8 : bx;
    const int gw = vcu * NWAVES + wave, NGW = G * NWAVES;
    for (int u = tid; u < (LDS_BYTES - RING_BYTES) / 4; u += NWAVES * 64) ((LAS unsigned*)(lds + RING_BYTES))[u] = 0u;
    __syncthreads();
    (void)xcd_barrier_post((unsigned*)(params_ptr()->ws + WS_CTL) + CW_BAR, (volatile LAS unsigned*)(lds + MISC_OFF) + 8);
#define GRID_BAR() do { XcdBarrier b_; b_.bar = (unsigned*)(params_ptr()->ws + WS_CTL) + CW_BAR; b_.x = xb_xcc_id(); b_.st = (volatile LAS unsigned*)(lds + MISC_OFF) + 8; xcd_barrier(b_); } while (0)

    prologue(lds, gw, NGW, wave, lane);
    GRID_BAR();

    for (int hl = 0; hl < 2 * NL; ++hl) {
        const int L = hl >> 1, second = hl & 1, xc = L & 1;
        { KParams P = params_ptr(); unsigned char* ws = P->ws; unsigned char* wl = ws + WS_W + (size_t)L * LW;
          pg8::Gemm g{(const bf16*)(ws + (xc ? WS_XB1 : WS_XB0)), (const bf16*)(wl + (second ? OW13B : OW13A)), M, 5632, DM}; pg8::StaticOrder S; S.init(M, 5632, G, bx);
          pg8::EpiSwiGLU E{P, 0};
          pg8::gemm_phase<pg8::EpiSwiGLU, pg8::StaticOrder, true, true>(lds, g, S, E); }
        GRID_BAR();
        { KParams P = params_ptr(); unsigned char* ws = P->ws; unsigned char* wl = ws + WS_W + (size_t)L * LW;
          pg8::Gemm g{(const bf16*)(ws + WS_HB), (const bf16*)(wl + (second ? OW2B : OW2A)), M, DM, DFF}; pg8::StaticOrder S; S.init(M, DM, G, bx);
          pg8::EpiX<false> E{P, xc, 1, 0.5f};
          pg8::gemm_phase<pg8::EpiX<false>, pg8::StaticOrder, true, true>(lds, g, S, E); }
        GRID_BAR();
        if (!second) {
            { KParams P = params_ptr(); unsigned char* ws = P->ws; unsigned char* wl = ws + WS_W + (size_t)L * LW;
              pg8::Gemm g{(const bf16*)(ws + (xc ? WS_XB1 : WS_XB0)), (const bf16*)(wl + OWIN), M, NIN, DM}; pg8::StaticOrder S; S.init(M, NIN, G, bx);
              pg8::EpiIn E{P, L, 1};
              pg8::gemm_phase<pg8::EpiIn, pg8::StaticOrder, true, true>(lds, g, S, E); }
            GRID_BAR();
            for (int c = vcu; c < NCHUNK; c += G) gla_pass_a(lds, L, c, tid, wave, lane);
            for (int u = gw; u < 8192 + 128; u += NGW) sb_unit(lds + wave * 16384, lane, L, u);
            GRID_BAR();
            gla_scan(L, gw * 64 + lane, NGW * 64);
            for (int u = gw; u < M / 16; u += NGW) pool_unit(L, u, lane);
            GRID_BAR();
            for (int c = vcu; c < NCHUNK; c += G) gla_pass_c(lds, L, c, tid, wave, lane);
            for (int u = gw; u < 4096 + 256; u += NGW) gmlp_unit(lds + wave * 16384, lane, L, u);
            GRID_BAR();
            { KParams P = params_ptr(); unsigned char* ws = P->ws; unsigned char* wl = ws + WS_W + (size_t)L * LW;
              pg8::Gemm g{(const bf16*)(ws + WS_AB), (const bf16*)(wl + OWBR), 4 * M, 4 * DM, 512}; pg8::BranchOrder S{G, vcu};
              pg8::EpiBranch E{P};
              pg8::gemm_phase<pg8::EpiBranch, pg8::BranchOrder, true, true>(lds, g, S, E); }
            GRID_BAR();
            { KParams P = params_ptr(); unsigned char* ws = P->ws; unsigned char* wl = ws + WS_W + (size_t)L * LW;
              pg8::Gemm g{(const bf16*)(ws + WS_MB), (const bf16*)(wl + OWOUT), M, DM, DM}; pg8::StaticOrder S; S.init(M, DM, G, bx);
              pg8::EpiX<false> E{P, xc, 0, 1.0f};
              pg8::gemm_phase<pg8::EpiX<false>, pg8::StaticOrder, true, true>(lds, g, S, E); }
            { KParams P = params_ptr(); unsigned char* ws = P->ws; unsigned char* wl = ws + WS_W + (size_t)L * LW;
              pg8::Gemm g{(const bf16*)(ws + WS_PB) + (size_t)L * M * 256, (const bf16*)(wl + OWPP), M, DM, 256}; pg8::StaticOrder S; S.init(M, DM, G, bx);
              pg8::EpiPlain E{P};
              pg8::gemm_phase<pg8::EpiPlain, pg8::StaticOrder, true, true>(lds, g, S, E); }
            GRID_BAR();
        } else {
            { KParams P = params_ptr(); unsigned char* ws = P->ws; unsigned char* wl = ws + WS_W + (size_t)L * LW;
              pg8::Gemm g{(const bf16*)(ws + (xc ? WS_XB1 : WS_XB0)), (const bf16*)(wl + OWPG), M, DM, DM}; pg8::StaticOrder S; S.init(M, DM, G, bx);
              pg8::EpiX<true> E{P, xc ^ 1, 0, 1.0f};
              pg8::gemm_phase<pg8::EpiX<true>, pg8::StaticOrder, true, true>(lds, g, S, E); }
            GRID_BAR();
        }
    }
#undef GRID_BAR
}

extern "C" void kernel_launch(void* const* d_in, const int* in_sizes, int n_in, void* d_out, int out_size, void* d_ws, size_t ws_size, hipStream_t stream) {
    static int grid = 0;
    if (grid == 0) {
        if (n_in != 32 || (size_t)out_size != O_END || ws_size < WS_END) { fprintf(stderr, "kernel_launch: unexpected shapes: n_in %d out %d ws %zu (want 32, %zu, >= %zu)\n", n_in, out_size, ws_size, (size_t)O_END, (size_t)WS_END); grid = -1; return; }
        int dev = 0, cus = 0, per_cu = 0;
        if (hipGetDevice(&dev) != hipSuccess || hipDeviceGetAttribute(&cus, hipDeviceAttributeMultiprocessorCount, dev) != hipSuccess) { grid = -1; return; }
        if (hipFuncSetAttribute((const void*)hybrid_fwd, hipFuncAttributeMaxDynamicSharedMemorySize, LDS_BYTES) != hipSuccess) { fprintf(stderr, "kernel_launch: hipFuncSetAttribute failed\n"); grid = -1; return; }
        if (hipOccupancyMaxActiveBlocksPerMultiprocessor(&per_cu, (const void*)hybrid_fwd, NWAVES * 64, LDS_BYTES) != hipSuccess || per_cu < 1) fprintf(stderr, "kernel_launch: occupancy query reports %d\n", per_cu);
        (void)hipGetLastError();
        grid = cus;
    }
    if (grid < 0) return;
    if (hipMemsetAsync((char*)d_ws + WS_CTL, 0, CTL_ZERO_BYTES, stream) != hipSuccess) return;
    Params p{};
    for (int i = 0; i < 32; ++i) p.in[i] = (const float*)d_in[i];
    p.out = (float*)d_out; p.ws = (unsigned char*)d_ws;
    hipLaunchKernelGGL(hybrid_fwd, dim3(grid), dim3(NWAVES * 64), LDS_BYTES, stream, p);
    const hipError_t le = hipPeekAtLastError();
    if (le != hipSuccess) fprintf(stderr, "kernel_launch: launch failed: %s\n", hipGetErrorName(le));
}
```

```cpp
#include <hip/hip_runtime.h>
#include <cstdio>
#include <cstdint>
#define GAS __attribute__((address_space(1)))
#define LAS __attribute__((address_space(3)))
typedef unsigned short bf16;
#ifndef PROBE_DUP
#define PROBE_DUP 0
#endif

constexpr int NWAVES = 8;
constexpr int DM = 1024, MP = 32768, MS = 512, M = MP + MS, NL = 4, DFF = 2816, NIN = 8960;
constexpr int NCHUNK = 2048 + 64;
constexpr int NSEQ = 32 + 64;
constexpr int NSEG = 256 + 64;
constexpr size_t O_X = 0, O_KP = (size_t)M * DM, O_VP = O_KP + (size_t)NL * MP * 512, O_POOLP = O_VP + (size_t)NL * MP * 512, O_GLAP = O_POOLP + (size_t)NL * 8 * 15 * 512,
    O_KS = O_GLAP + (size_t)NL * 8 * 4 * 64 * 128, O_VS = O_KS + (size_t)NL * MS * 512, O_POOLS = O_VS + (size_t)NL * MS * 512, O_GLAS = O_POOLS + (size_t)NL * 16 * 15 * 512,
    O_GVS = O_GLAS + (size_t)NL * 16 * 4 * 64 * 128, O_END = O_GVS + (size_t)NL * MS * 512;
constexpr size_t MiB = 1u << 20;
constexpr size_t WS_CTL = 0, CTL_ZERO_BYTES = 1 * MiB;
constexpr size_t WS_W = 2 * MiB, LW = 60 * MiB;
constexpr size_t OW13A = 0, OW2A = 11 * MiB, OW13B = 16 * MiB + MiB / 2, OW2B = 27 * MiB + MiB / 2, OWIN = 33 * MiB, OWBR = 50 * MiB + MiB / 2, OWOUT = 54 * MiB + MiB / 2, OWPG = 56 * MiB + MiB / 2,
    OWPP = 58 * MiB + MiB / 2, OWM = 59 * MiB;
constexpr size_t WS_XB0 = 242 * MiB, WS_XB1 = 307 * MiB, WS_SSQ0 = 372 * MiB, WS_SSQ1 = 375 * MiB, WS_HB = 378 * MiB;
constexpr size_t WS_XPB = 557 * MiB, WS_QB = 590 * MiB, WS_KB = 623 * MiB, WS_VB = 656 * MiB, WS_GUB = 689 * MiB, WS_GVB = 722 * MiB, WS_LVB = 755 * MiB, WS_LRB = 788 * MiB;
constexpr size_t WS_LQB = 821 * MiB, WS_LKB = 838 * MiB, WS_LAB = 855 * MiB, WS_GB = 872 * MiB, WS_AB = 1132 * MiB, WS_MB = 1262 * MiB, WS_PPB = 1327 * MiB, WS_PB = 1392 * MiB;
constexpr size_t WS_QT = 1457 * MiB, WS_KT = 1490 * MiB, WS_DS = 1523 * MiB, WS_SC = 1589 * MiB, WS_LAM = 1655 * MiB, WS_XL = 1656 * MiB, WS_END = 1721 * MiB;
static_assert(OW13A + (size_t)5632 * 1024 * 2 <= OW2A && OW2A + (size_t)1024 * 2816 * 2 <= OW13B && OW13B + (size_t)5632 * 1024 * 2 <= OW2B && OW2B + (size_t)1024 * 2816 * 2 <= OWIN &&
              OWIN + (size_t)NIN * 1024 * 2 <= OWBR && OWBR + (size_t)4 * 1024 * 512 * 2 <= OWOUT && OWOUT + 2 * MiB <= OWPG && OWPG + 2 * MiB <= OWPP && OWPP + MiB / 2 <= OWM && OWM + 131072 <= LW, "weight map");
static_assert(WS_W + NL * LW <= WS_XB0 && WS_XB0 + (size_t)M * DM * 2 <= WS_XB1 && WS_XB1 + (size_t)M * DM * 2 <= WS_SSQ0 && WS_SSQ0 + (size_t)M * 64 <= WS_SSQ1 && WS_SSQ1 + (size_t)M * 64 <= WS_HB &&
              WS_HB + (size_t)M * DFF * 2 <= WS_XPB && WS_XPB + (size_t)M * 1024 <= WS_QB && WS_LRB + (size_t)M * 1024 <= WS_LQB && WS_LQB + (size_t)M * 512 <= WS_LKB && WS_LAB + (size_t)M * 512 <= WS_GB &&
              WS_GB + (size_t)M * 8192 <= WS_AB && WS_AB + (size_t)4 * M * 1024 <= WS_MB && WS_MB + (size_t)M * 2048 <= WS_PPB && WS_PPB + (size_t)M * 2048 <= WS_PB && WS_PB + (size_t)4 * M * 512 <= WS_QT &&
              WS_QT + (size_t)M * 1024 <= WS_KT && WS_KT + (size_t)M * 1024 <= WS_DS && WS_DS + (size_t)NCHUNK * 32768 <= WS_SC && WS_SC + (size_t)NCHUNK * 32768 <= WS_LAM && WS_LAM + (size_t)NCHUNK * 256 <= WS_XL && WS_XL + (size_t)M * DM * 2 <= WS_END, "ws map");
constexpr int WGM_UP = 8, WGM_IN = 8, WGM_X = 8;
constexpr float SB_CUT = 48.f;
constexpr bool USE_XL = false;
constexpr int CW_BAR = 4096;
constexpr int CW_Q = 8192;
constexpr int RING_BYTES = 131072, MISC_OFF = RING_BYTES + 320, RSTD_OFF = RING_BYTES + 2048  , LDS_BYTES = 147456;

typedef float f32x16 __attribute__((ext_vector_type(16)));
typedef short s16x4 __attribute__((ext_vector_type(4)));
typedef short v4i16_t __attribute__((ext_vector_type(4)));
typedef unsigned u32x2 __attribute__((ext_vector_type(2)));

struct Params { const float* in[32]; float* out; unsigned char* ws; };
enum { I_XP = 0, I_XS, I_PP, I_PS, I_CK, I_CV, I_SPOOL, I_SGLA, I_N1, I_F1W1, I_F1W3, I_F1W2, I_NM, I_WIN, I_POOLW, I_POOLS, I_QN, I_KN, I_GWS, I_GB, I_WA2, I_BA, I_GON, I_WBR, I_WOUT, I_N2, I_F2W1,
       I_F2W3, I_F2W2, I_NPL, I_WPG, I_WPP };


typedef const __attribute__((address_space(4))) Params* KParams;
__device__ __forceinline__ KParams params_ptr() { KParams p = (KParams)__builtin_amdgcn_kernarg_segment_ptr(); asm volatile("" : "+s"(p)); return p; }
namespace pg8 {
#define PG8_LAS __attribute__((address_space(3)))
typedef unsigned short bf16_t;
typedef short bf16x8 __attribute__((ext_vector_type(8)));
typedef float f32x4 __attribute__((ext_vector_type(4)));
typedef unsigned u32x4 __attribute__((ext_vector_type(4)));
constexpr int BM = 256, BK = 64, HALF = 128, HTB = HALF * BK * 2  , STAGE_BYTES = 8 * HTB, NXCD = 8, WGM = 8;

__host__ __device__ __forceinline__ int lds_byte(int r, int c) { const int st = (r >> 4) * 2 + (c >> 5), rr = r & 15, cc = c & 31, ob = rr * 64 + cc * 2; return st * 1024 + (ob ^ (((ob >> 9) & 1) << 5)); }
__host__ __device__ __forceinline__ void stage_rc(int b, int& R, int& C) { const int st = b / 1024, sb = b % 1024, swz = sb ^ (((sb >> 9) & 1) << 5); R = (st >> 1) * 16 + swz / 64; C = (st & 1) * 32 + (swz % 64) / 2; }
__host__ __device__ __forceinline__ int perm32(int rho) { const int n = rho >> 4, i = rho & 15; return 8 * (i >> 2) + 4 * n + (i & 3); }

struct Unit { int pm, pn, slot; };
struct Gemm { const bf16_t* A; const bf16_t* Bt; int M, N, K; };

struct StaticOrder {
    int nM, nN, nwg, G, c, wgm;
    __host__ __device__ void init(int M, int N, int G_, int c_, int wgm_ = WGM) { nM = M / BM; nN = N / BM; nwg = nM * nN; G = G_; c = c_; wgm = wgm_; }
    __host__ __device__ bool next(int i, Unit& u) const {
        const long L = (long)i * G + c; if (L >= nwg) return false;
        int wgid = (int)L; { const int q = nwg / NXCD, r = nwg % NXCD, xcd = wgid % NXCD, off = wgid / NXCD; wgid = (xcd < r ? xcd * (q + 1) : r * (q + 1) + (xcd - r) * q) + off; }
        const int nig = wgm * nN, gid = wgid / nig, fm = gid * wgm, gsz = (nM - fm) < wgm ? (nM - fm) : wgm;
        u.pm = fm + ((wgid % nig) % gsz); u.pn = (wgid % nig) / gsz; u.slot = i & 1; return true;
    }
    __device__ __forceinline__ void a_ready(const Unit&) const {}
    __device__ __forceinline__ void done(const Unit&) const {}
};

typedef float f32x2 __attribute__((ext_vector_type(2)));
typedef __bf16 bf16x2_t __attribute__((ext_vector_type(2)));
__device__ __forceinline__ unsigned cvt_pk_bf16(float lo, float hi) { const bf16x2_t r = __builtin_convertvector((f32x2){lo, hi}, bf16x2_t); return __builtin_bit_cast(unsigned, r); }
__device__ __forceinline__ float sigm(float t) { return __builtin_amdgcn_rcpf(1.0f + __builtin_amdgcn_exp2f(-1.4426950408889634f * t)); }
__device__ __forceinline__ float silu_f(float t) { return t * sigm(t); }
__device__ __forceinline__ float gelu_tanh_f(float t) { return t * sigm(1.5957691216057308f * (t + 0.044715f * t * t * t)); }
__device__ __forceinline__ f32x2 sigm_arg2(f32x2 a) { const f32x2 d = (f32x2){__builtin_amdgcn_exp2f(a[0]), __builtin_amdgcn_exp2f(a[1])} + (f32x2){1.0f, 1.0f}; return (f32x2){__builtin_amdgcn_rcpf(d[0]), __builtin_amdgcn_rcpf(d[1])}; }
__device__ __forceinline__ f32x2 silu2(f32x2 t) { return t * sigm_arg2(t * (f32x2){-1.4426950408889634f, -1.4426950408889634f}); }
__device__ __forceinline__ f32x2 gelu_tanh2(f32x2 t) { constexpr float k0 = -1.4426950408889634f * 1.5957691216057308f, k1 = k0 * 0.044715f;
    return t * sigm_arg2(t * ((t * t) * (f32x2){k1, k1} + (f32x2){k0, k0})); }
__device__ __forceinline__ float bf_lo(unsigned w) { return __uint_as_float(w << 16); }
__device__ __forceinline__ float bf_hi(unsigned w) { return __uint_as_float(w & 0xffff0000u); }
__device__ __forceinline__ float row_rstd(const float* ssq, int row) {
    const f32x4* p = (const f32x4*)(ssq + (size_t)row * 16); const f32x4 a = p[0], b = p[1], c = p[2], d = p[3];
    const float s = (((a[0] + a[1]) + (a[2] + a[3])) + ((b[0] + b[1]) + (b[2] + b[3]))) + (((c[0] + c[1]) + (c[2] + c[3])) + ((d[0] + d[1]) + (d[2] + d[3])));
    return __builtin_amdgcn_rsqf(s * (1.0f / 1024.0f) + 1e-6f);
}
struct RstdOrder : StaticOrder {
    KParams kp; int sq; PG8_LAS float* rl; mutable int nd; mutable bool started;
    __device__ __forceinline__ bool next(int i, Unit& u) const { return StaticOrder::next(i, u); }
    __device__ __forceinline__ void fill(const Unit& u) const {
        int t = threadIdx.x; asm volatile("" : "+v"(t));
        if (t < 256) { KParams q = kp; asm volatile("" : "+s"(q)); rl[u.slot * 256 + t] = row_rstd((const float*)(q->ws + (sq ? WS_SSQ1 : WS_SSQ0)), u.pm * BM + t); }
    }
    __device__ __forceinline__ void a_ready(const Unit& u) const { if (!started) { started = true; fill(u); } }
    __device__ __forceinline__ void done(const Unit&) const { ++nd; Unit n; if (next(nd, n)) fill(n); }
};
__device__ __forceinline__ u32x4 pack8(const f32x4 a, const f32x4 b) { u32x4 w; w.x = cvt_pk_bf16(a[0], a[1]); w.y = cvt_pk_bf16(a[2], a[3]); w.z = cvt_pk_bf16(b[0], b[1]); w.w = cvt_pk_bf16(b[2], b[3]); return w; }

struct EpiSwiGLU {
    static constexpr bool PERM = true, AFTER_DRAIN = false, HAS_INIT = false;
    KParams kp; const PG8_LAS float* rl;
    __device__ __forceinline__ void operator()(const f32x4 (&acc)[2][2][4][2], const Unit& u, int wr, int wc, int fr, int fq) const {
        KParams q = kp; asm volatile("" : "+s"(q)); unsigned char* ws = q->ws;
        bf16_t* H = (bf16_t*)(ws + WS_HB); const PG8_LAS float* rt = rl + u.slot * 256 + wr * 64 + fr;
        const int col0 = u.pn * 128 + wc * 32 + 8 * fq;
#pragma unroll
        for (int ai = 0; ai < 2; ++ai)
#pragma unroll
            for (int m = 0; m < 4; ++m) {
                const int row = u.pm * BM + ai * HALF + wr * 64 + m * 16 + fr; const float rs = rt[ai * HALF + m * 16]; const float cexp = -1.4426950408889634f * rs, rs2 = rs * rs;
                const f32x2 c2 = (f32x2){cexp, cexp}, r2 = (f32x2){rs2, rs2};
                f32x4 h0, h1;
#pragma unroll
                for (int n = 0; n < 2; ++n)
#pragma unroll
                    for (int p2 = 0; p2 < 2; ++p2) { const f32x4 g4 = acc[ai][0][m][n], u4 = acc[ai][1][m][n];
                        const f32x2 g = p2 ? (f32x2){g4[2], g4[3]} : (f32x2){g4[0], g4[1]}, u = p2 ? (f32x2){u4[2], u4[3]} : (f32x2){u4[0], u4[1]};
                        const f32x2 t = g * c2; f32x2 d = (f32x2){__builtin_amdgcn_exp2f(t[0]), __builtin_amdgcn_exp2f(t[1])} + (f32x2){1.0f, 1.0f};
                        const f32x2 r = (f32x2){__builtin_amdgcn_rcpf(d[0]), __builtin_amdgcn_rcpf(d[1])}; const f32x2 hh = (g * u) * (r * r2);
                        if (n == 0) { h0[2 * p2] = hh[0]; h0[2 * p2 + 1] = hh[1]; } else { h1[2 * p2] = hh[0]; h1[2 * p2 + 1] = hh[1]; } }
                *(u32x4*)(H + (size_t)row * 2816 + col0) = pack8(h0, h1);
                if (m & 1) asm volatile("" ::: "memory");
            }
    }
};

template <bool PLE> struct EpiX {
    static constexpr bool PERM = true, AFTER_DRAIN = false, HAS_INIT = false;
    static constexpr int NB = PLE ? 2 : 1, MB_ = 4 / NB;
    KParams kp; int xc_in, xc_out, sq_out; float alpha; const PG8_LAS float* rl; int fin;
    __device__ __forceinline__ void init(f32x4 (&)[2][2][4][2], const Unit&, int, int, int, int) const {}
    __device__ __forceinline__ void operator()(const f32x4 (&acc)[2][2][4][2], const Unit& u, int wr, int wc, int fr, int fq) const {
        KParams q = kp; asm volatile("" : "+s"(q)); unsigned char* ws = q->ws; float* X = q->out + O_X;
        const bf16_t* XI = (const bf16_t*)(ws + (xc_in ? WS_XB1 : WS_XB0)); bf16_t* XB = (bf16_t*)(ws + (xc_out ? WS_XB1 : WS_XB0)); bf16_t* XL = (bf16_t*)(ws + WS_XL); bf16_t* ssq_dummy = nullptr; (void)ssq_dummy;
        float* ssq_out = (float*)(ws + (sq_out ? WS_SSQ1 : WS_SSQ0));
        const bf16_t* PP = (const bf16_t*)(ws + WS_PPB);
        const size_t off0 = (size_t)(u.pm * BM + wr * 64 + fr) * 1024 + u.pn * BM + wc * 32 + 8 * fq;
#pragma unroll
        for (int ab = 0; ab < 2 * NB; ++ab) { const int ai = ab / NB, mb = (ab % NB) * MB_;
            u32x4 xh[4][2], xl[4][2], pw[4][2];
#pragma unroll
            for (int m = mb; m < mb + MB_; ++m)
#pragma unroll
                for (int bj = 0; bj < 2; ++bj) { const size_t off = off0 + (size_t)(ai * HALF + m * 16) * 1024 + bj * HALF;
                    xh[m][bj] = *(const u32x4*)(XI + off); if (USE_XL) xl[m][bj] = *(const u32x4*)(XL + off); if (PLE) pw[m][bj] = *(const u32x4*)(PP + off); }
#pragma unroll
            for (int m = mb; m < mb + MB_; ++m) {
                float s = 0.f; float rs = 0.f; if (PLE) rs = rl[u.slot * 256 + ai * HALF + wr * 64 + m * 16 + fr];
#pragma unroll
                for (int bj = 0; bj < 2; ++bj) { const size_t off = off0 + (size_t)(ai * HALF + m * 16) * 1024 + bj * HALF;
                    f32x4 a0 = acc[ai][bj][m][0], a1 = acc[ai][bj][m][1];
                    if (PLE) { const u32x4 p4 = pw[m][bj];
                        a0[0] = sigm(a0[0] * rs) * bf_lo(p4.x); a0[1] = sigm(a0[1] * rs) * bf_hi(p4.x); a0[2] = sigm(a0[2] * rs) * bf_lo(p4.y); a0[3] = sigm(a0[3] * rs) * bf_hi(p4.y);
                        a1[0] = sigm(a1[0] * rs) * bf_lo(p4.z); a1[1] = sigm(a1[1] * rs) * bf_hi(p4.z); a1[2] = sigm(a1[2] * rs) * bf_lo(p4.w); a1[3] = sigm(a1[3] * rs) * bf_hi(p4.w);
#if PROBE_DUP & 8192
                        a0 = a0 * alpha; a1 = a1 * alpha;
#endif
                    } else { a0 = a0 * alpha; a1 = a1 * alpha; }
                    const u32x4 h4 = xh[m][bj]; u32x4 l4 = (u32x4){0u, 0u, 0u, 0u}; if (USE_XL) l4 = xl[m][bj];
                    const f32x4 x0 = (f32x4){bf_lo(h4.x) + bf_lo(l4.x), bf_hi(h4.x) + bf_hi(l4.x), bf_lo(h4.y) + bf_lo(l4.y), bf_hi(h4.y) + bf_hi(l4.y)} + a0;
                    const f32x4 x1 = (f32x4){bf_lo(h4.z) + bf_lo(l4.z), bf_hi(h4.z) + bf_hi(l4.z), bf_lo(h4.w) + bf_lo(l4.w), bf_hi(h4.w) + bf_hi(l4.w)} + a1;
                    const u32x4 hw = pack8(x0, x1);
                    const f32x4 r0 = x0 - (f32x4){bf_lo(hw.x), bf_hi(hw.x), bf_lo(hw.y), bf_hi(hw.y)}, r1 = x1 - (f32x4){bf_lo(hw.z), bf_hi(hw.z), bf_lo(hw.w), bf_hi(hw.w)};
                    *(u32x4*)(XB + off) = hw; if (USE_XL) *(u32x4*)(XL + off) = pack8(r0, r1);
                    if (fin) { *(f32x4*)(X + off) = x0; *(f32x4*)(X + off + 4) = x1; }
                    s += ((x0[0] * x0[0] + x0[1] * x0[1]) + (x0[2] * x0[2] + x0[3] * x0[3])) + ((x1[0] * x1[0] + x1[1] * x1[1]) + (x1[2] * x1[2] + x1[3] * x1[3]));
                }
                s += __shfl_xor(s, 16); s += __shfl_xor(s, 32);
                if (fq == 0) ssq_out[(size_t)(u.pm * BM + ai * HALF + wr * 64 + m * 16 + fr) * 16 + u.pn * 4 + wc] = s;
            }
            asm volatile("" ::: "memory");
        }
    }
};

struct EpiIn {
    static constexpr bool PERM = true, AFTER_DRAIN = false, HAS_INIT = false;
    KParams kp; int L; const PG8_LAS float* rl;
    __device__ __forceinline__ void operator()(const f32x4 (&acc)[2][2][4][2], const Unit& u, int wr, int wc, int fr, int fq) const {
        KParams q = kp; asm volatile("" : "+s"(q)); unsigned char* ws = q->ws; float* out = q->out;
        const PG8_LAS float* rt = rl + u.slot * 256 + wr * 64 + fr;
        const int t = u.pn; const bool samp = u.pm >= 128;
        if (t >= 2 && t < 6) {
            const bool isk = t >= 4; const float* gn = q->in[isk ? I_KN : I_QN] + L * 64; bf16_t* dst = (bf16_t*)(ws + (isk ? WS_KB : WS_QB));
            float* fo = isk ? (samp ? out + O_KS + (size_t)L * MS * 512 - (size_t)32768 * 512 : out + O_KP + (size_t)L * MP * 512) : nullptr;
            const float sc = isk ? 1.0f : 0.125f * 1.4426950408889634f;
            f32x4 g[2][2];
#pragma unroll
            for (int bj = 0; bj < 2; ++bj)
#pragma unroll
                for (int n = 0; n < 2; ++n) g[bj][n] = *(const f32x4*)(gn + 32 * bj + 8 * fq + 4 * n) * sc;
            const int hcol = (4 * (t & 1) + wc) * 64 + 8 * fq;
#pragma unroll
            for (int ai = 0; ai < 2; ++ai)
#pragma unroll
                for (int m = 0; m < 4; ++m) {
                    const int row = u.pm * BM + ai * HALF + wr * 64 + m * 16 + fr; const float rs = rt[ai * HALF + m * 16];
                    f32x4 v[2][2]; float ss = 0.f;
#pragma unroll
                    for (int bj = 0; bj < 2; ++bj)
#pragma unroll
                        for (int n = 0; n < 2; ++n) { v[bj][n] = acc[ai][bj][m][n] * rs; ss += (v[bj][n][0] * v[bj][n][0] + v[bj][n][1] * v[bj][n][1]) + (v[bj][n][2] * v[bj][n][2] + v[bj][n][3] * v[bj][n][3]); }
                    ss += __shfl_xor(ss, 16); ss += __shfl_xor(ss, 32);
                    const float hr = __builtin_amdgcn_rsqf(ss * (1.0f / 64.0f) + 1e-6f);
#pragma unroll
                    for (int bj = 0; bj < 2; ++bj) { const f32x4 o0 = v[bj][0] * hr * g[bj][0], o1 = v[bj][1] * hr * g[bj][1];
                        const size_t off = (size_t)row * 512 + hcol + 32 * bj;
                        *(u32x4*)(dst + off) = pack8(o0, o1);
                        if (fo) { __builtin_nontemporal_store(o0, (f32x4*)(fo + off)); __builtin_nontemporal_store(o1, (f32x4*)(fo + off + 4)); }   }
                    asm volatile("" ::: "memory");
                }
            return;
        }
        if (t >= 18 && t < 34) {
            unsigned char* g8 = ws + WS_GB + (size_t)(256 * (t - 18)) + wc * 32 + 8 * fq;
#pragma unroll
            for (int ai = 0; ai < 2; ++ai)
#pragma unroll
                for (int m = 0; m < 4; ++m) {
                    const int row = u.pm * BM + ai * HALF + wr * 64 + m * 16 + fr; const float cexp = -1.4426950408889634f * rt[ai * HALF + m * 16];
#pragma unroll
                    for (int bj = 0; bj < 2; ++bj) { unsigned w0 = 0u, w1 = 0u;
#pragma unroll
                        for (int n = 0; n < 2; ++n)
#pragma unroll
                            for (int p2 = 0; p2 < 2; ++p2) {
                                const f32x4 a4 = acc[ai][bj][m][n]; const f32x2 a = p2 ? (f32x2){a4[2], a4[3]} : (f32x2){a4[0], a4[1]};
                                const f32x2 tt = a * (f32x2){cexp, cexp}; const f32x2 e = (f32x2){__builtin_amdgcn_exp2f(tt[0]), __builtin_amdgcn_exp2f(tt[1])};
                                const f32x2 d = e * (f32x2){1.0f / 255.0f, 1.0f / 255.0f} + (f32x2){1.0f / 255.0f, 1.0f / 255.0f};
                                const float y0 = __builtin_amdgcn_rcpf(d[0]), y1 = __builtin_amdgcn_rcpf(d[1]);
                                if (n == 0) { w0 = __builtin_amdgcn_cvt_pk_u8_f32(y0, 2 * p2, w0); w0 = __builtin_amdgcn_cvt_pk_u8_f32(y1, 2 * p2 + 1, w0); }
                                else { w1 = __builtin_amdgcn_cvt_pk_u8_f32(y0, 2 * p2, w1); w1 = __builtin_amdgcn_cvt_pk_u8_f32(y1, 2 * p2 + 1, w1); } }
                        typedef unsigned u32x2e __attribute__((ext_vector_type(2)));
                        __builtin_nontemporal_store((u32x2e){w0, w1}, (u32x2e*)(g8 + (size_t)row * 4096 + bj * HALF)); }
                    asm volatile("" ::: "memory");
                }
            return;
        }
        bf16_t* dst; int ld, dcol, act = 0; float* fo = nullptr;
        size_t wo;
        if (t < 2) { wo = WS_XPB; ld = 512; dcol = 256 * t; }
        else if (t < 8) { wo = WS_VB; ld = 512; dcol = 256 * (t - 6); fo = samp ? out + O_VS + (size_t)L * MS * 512 - (size_t)32768 * 512 : out + O_VP + (size_t)L * MP * 512; }
        else if (t < 10) { wo = WS_GUB; ld = 512; dcol = 256 * (t - 8); act = 1; }
        else if (t < 12) { wo = WS_GVB; ld = 512; dcol = 256 * (t - 10); act = 1; fo = samp ? out + O_GVS + (size_t)L * MS * 512 - (size_t)32768 * 512 : nullptr; }
        else if (t == 12) { wo = WS_LQB; ld = 256; dcol = 0; }
        else if (t == 13) { wo = WS_LKB; ld = 256; dcol = 0; }
        else if (t < 16) { wo = WS_LVB; ld = 512; dcol = 256 * (t - 14); }
        else if (t < 18) { wo = WS_LRB; ld = 512; dcol = 256 * (t - 16); act = 2; }
        else { wo = WS_LAB; ld = 256; dcol = 0; }
        dst = (bf16_t*)(ws + wo);
#pragma unroll
        for (int ai = 0; ai < 2; ++ai)
#pragma unroll
            for (int m = 0; m < 4; ++m) {
                const int row = u.pm * BM + ai * HALF + wr * 64 + m * 16 + fr; const float rs = rt[ai * HALF + m * 16];
#pragma unroll
                for (int bj = 0; bj < 2; ++bj) {
                    f32x4 v0 = acc[ai][bj][m][0] * rs, v1 = acc[ai][bj][m][1] * rs;
                    if (act == 1) {
#pragma unroll
                        for (int j = 0; j < 4; j += 2) { const f32x2 a = gelu_tanh2((f32x2){v0[j], v0[j + 1]}), b = gelu_tanh2((f32x2){v1[j], v1[j + 1]}); v0[j] = a[0]; v0[j + 1] = a[1]; v1[j] = b[0]; v1[j + 1] = b[1]; }
                    } else if (act == 2) {
#pragma unroll
                        for (int j = 0; j < 4; j += 2) { const f32x2 a = silu2((f32x2){v0[j], v0[j + 1]}), b = silu2((f32x2){v1[j], v1[j + 1]}); v0[j] = a[0]; v0[j + 1] = a[1]; v1[j] = b[0]; v1[j + 1] = b[1]; }
                    }
                    const int col = dcol + bj * HALF + wc * 32 + 8 * fq;
                    __builtin_nontemporal_store(pack8(v0, v1), (u32x4*)(dst + (size_t)row * ld + col));
                    if (fo) { float* f = fo + (size_t)row * 512 + col; __builtin_nontemporal_store(v0, (f32x4*)f); __builtin_nontemporal_store(v1, (f32x4*)(f + 4)); }
                }
                if (m & 1) asm volatile("" ::: "memory");
            }
    }
};

struct EpiBranch {
    static constexpr bool PERM = true, AFTER_DRAIN = false, HAS_INIT = true;
    KParams kp;
    __device__ __forceinline__ void init(f32x4 (&acc)[2][2][4][2], const Unit& u, int, int, int, int) const {
        if (u.pm < 130) {
#pragma unroll
            for (int a = 0; a < 2; ++a)
#pragma unroll
                for (int b = 0; b < 2; ++b)
#pragma unroll
                    for (int m = 0; m < 4; ++m)
#pragma unroll
                        for (int n = 0; n < 2; ++n) acc[a][b][m][n] = (f32x4){0.f, 0.f, 0.f, 0.f};
        }
    }
    __device__ __forceinline__ void operator()(const f32x4 (&acc_)[2][2][4][2], const Unit& u, int wr, int wc, int fr, int fq) const {
        f32x4 (&acc)[2][2][4][2] = const_cast<f32x4 (&)[2][2][4][2]>(acc_);
        KParams q = kp; asm volatile("" : "+s"(q)); unsigned char* ws = q->ws; const unsigned char* G = ws + WS_GB; bf16_t* MB = (bf16_t*)(ws + WS_MB);
        const int b = u.pm / 130, pm = u.pm - b * 130, pn = u.pn & 3;
        const int row0 = pm * BM + wr * 64 + fr, col0 = pn * BM + wc * 32 + 8 * fq;
        typedef unsigned u32x2e __attribute__((ext_vector_type(2)));
#pragma unroll
        for (int ab = 0; ab < 2; ++ab) { const int ai = ab;
            u32x2e gw[4][2], gn[4][2];
#pragma unroll
            for (int m = 0; m < 4; ++m)
#pragma unroll
                for (int bj = 0; bj < 2; ++bj) { const int row = row0 + ai * HALF + m * 16, col = col0 + bj * HALF;
                    gw[m][bj] = *(const u32x2e*)(G + (size_t)row * 4096 + b * 1024 + col); if (b < 3) gn[m][bj] = *(const u32x2e*)(G + (size_t)row * 4096 + (b + 1) * 1024 + col); }
#pragma unroll
            for (int m = 0; m < 4; ++m)
#pragma unroll
                for (int bj = 0; bj < 2; ++bj) { const int row = row0 + ai * HALF + m * 16, col = col0 + bj * HALF; const u32x2e g2 = gw[m][bj];
                    float f[8] = {(float)(g2.x & 255u), (float)((g2.x >> 8) & 255u), (float)((g2.x >> 16) & 255u), (float)(g2.x >> 24), (float)(g2.y & 255u), (float)((g2.y >> 8) & 255u), (float)((g2.y >> 16) & 255u), (float)(g2.y >> 24)};
#pragma unroll
                    for (int j = 0; j < 8; ++j) f[j] = f[j] > 1.0f ? f[j] : 1.0f;
                    if (b < 3) { const u32x2e n2 = gn[m][bj]; const float d[8] = {(float)(n2.x & 255u), (float)((n2.x >> 8) & 255u), (float)((n2.x >> 16) & 255u), (float)(n2.x >> 24), (float)(n2.y & 255u), (float)((n2.y >> 8) & 255u), (float)((n2.y >> 16) & 255u), (float)(n2.y >> 24)};
#pragma unroll
                        for (int j = 0; j < 8; ++j) f[j] *= __builtin_amdgcn_rcpf(d[j] > 1.0f ? d[j] : 1.0f); }
                    else {
#pragma unroll
                        for (int j = 0; j < 8; ++j) f[j] *= (1.0f / 255.0f); }
                    f32x4 v0 = acc[ai][bj][m][0], v1 = acc[ai][bj][m][1];
                    v0[0] *= f[0]; v0[1] *= f[1]; v0[2] *= f[2]; v0[3] *= f[3]; v1[0] *= f[4]; v1[1] *= f[5]; v1[2] *= f[6]; v1[3] *= f[7];
                    if (b < 3) { acc[ai][bj][m][0] = v0; acc[ai][bj][m][1] = v1; }
                    else *(u32x4*)(MB + (size_t)row * 1024 + col) = pack8(v0, v1); }
            asm volatile("" ::: "memory");
        }
    }
};
struct BranchOrder {
    int G, c;
    __device__ __forceinline__ bool next(int i, Unit& u) const { const int tl = (i >> 2) * G + c; if (tl >= 512) return false;   const int b = i & 3; u.pm = b * 130 + (tl >> 2); u.pn = b * 4 + (tl & 3); u.slot = 0; return true; }
    __device__ __forceinline__ void a_ready(const Unit&) const {}
    __device__ __forceinline__ void done(const Unit&) const {}
};
struct EpiPlain {
    static constexpr bool PERM = true, AFTER_DRAIN = false, HAS_INIT = false;
    KParams kp;
    __device__ __forceinline__ void operator()(const f32x4 (&acc)[2][2][4][2], const Unit& u, int wr, int wc, int fr, int fq) const {
        KParams q = kp; asm volatile("" : "+s"(q)); bf16_t* O = (bf16_t*)(q->ws + WS_PPB); const int ldc = 1024;
#pragma unroll
        for (int ai = 0; ai < 2; ++ai)
#pragma unroll
            for (int m = 0; m < 4; ++m) {
                const int row = u.pm * BM + ai * HALF + wr * 64 + m * 16 + fr;
#pragma unroll
                for (int bj = 0; bj < 2; ++bj) *(u32x4*)(O + (size_t)row * ldc + u.pn * BM + bj * HALF + wc * 32 + 8 * fq) = pack8(acc[ai][bj][m][0], acc[ai][bj][m][1]);
            }
    }
};
template <class Epi, class Sched, bool ALIGN_EPI = false, bool SP2 = false>
__device__ __forceinline__ void gemm_phase(PG8_LAS unsigned char* lds, const Gemm g, const Sched& S, const Epi& E) {
    int tid = threadIdx.x; asm volatile("" : "+v"(tid));
    const int wid = __builtin_amdgcn_readfirstlane(tid >> 6), lane = tid & 63, wr = wid >> 2, wc = wid & 3, fr = lane & 15, fq = lane >> 4;
    int K = g.K; asm volatile("" : "+s"(K)); const int nt = K / BK;
    unsigned voffA[2], voffB[2];
#pragma unroll
    for (int i = 0; i < 2; ++i) { int R, C; stage_rc(tid * 16 + i * 8192, R, C); const int Rb = Epi::PERM ? ((R & ~31) + perm32(R & 31)) : R;
        voffA[i] = (unsigned)(R * K + C) * 2u; voffB[i] = (unsigned)(Rb * K + C) * 2u; }
    const size_t kstep = (size_t)(BK * 2);
    const size_t hstep = (size_t)HALF * K * 2;
    const size_t tstep = 2 * hstep;
    const unsigned ldsw = (unsigned)wid * 1024u;
    const int aoff = lds_byte(wr * 64 + fr, fq * 8), boff = lds_byte(wc * 32 + fr, fq * 8);
#define PG8_SA(b, h) (((b) * 2 + (h)) * HTB)
#define PG8_SB(b, h) ((4 + (b) * 2 + (h)) * HTB)
#define PG8_STAGE(bufoff, gbase, voff) do { _Pragma("unroll") for (int _i = 0; _i < 2; ++_i) \
        __builtin_amdgcn_global_load_lds((const unsigned*)((const char*)(gbase) + (voff)[_i]), (PG8_LAS unsigned*)(lds + (bufoff) + ldsw + _i * 8192), 16, 0, 0); } while (0)
#define PG8_LDA(dst, b, h) do { _Pragma("unroll") for (int m = 0; m < 4; ++m) _Pragma("unroll") for (int k = 0; k < 2; ++k) dst[m][k] = *(const PG8_LAS bf16x8*)(lds + PG8_SA(b, h) + aoff + m * 2048 + k * 1024); } while (0)
#define PG8_LDB(dst, b, h) do { _Pragma("unroll") for (int n = 0; n < 2; ++n) _Pragma("unroll") for (int k = 0; k < 2; ++k) dst[n][k] = *(const PG8_LAS bf16x8*)(lds + PG8_SB(b, h) + boff + n * 2048 + k * 1024); } while (0)
#define PG8_MMA(ai, bj, At, Bt) do { __builtin_amdgcn_s_setprio(1); _Pragma("unroll") for (int m = 0; m < 4; ++m) _Pragma("unroll") for (int n = 0; n < 2; ++n) _Pragma("unroll") for (int k = 0; k < 2; ++k) \
        acc[ai][bj][m][n] = __builtin_amdgcn_mfma_f32_16x16x32_bf16(Bt[n][k], At[m][k], acc[ai][bj][m][n], 0, 0, 0); __builtin_amdgcn_s_setprio(0); } while (0)
#define PG8_WAIT_V(n) asm volatile("s_waitcnt vmcnt(" #n ")" ::: "memory")
#define PG8_WAIT_L(n) asm volatile("s_waitcnt lgkmcnt(" #n ")" ::: "memory")
#define PG8_BAR __builtin_amdgcn_s_barrier()
#define PG8_SCHED __builtin_amdgcn_sched_barrier(0)
    Unit cur, nxt; int ui = 0;
    if (!S.next(0, cur)) return;
    f32x4 acc[2][2][4][2];
    if constexpr (Epi::HAS_INIT) E.init(acc, cur, wr, wc, fr, fq);
    else {
#pragma unroll
    for (int a = 0; a < 2; ++a)
#pragma unroll
        for (int b = 0; b < 2; ++b)
#pragma unroll
            for (int m = 0; m < 4; ++m)
#pragma unroll
                for (int n = 0; n < 2; ++n) acc[a][b][m][n] = (f32x4){0.f, 0.f, 0.f, 0.f};
    }
    bf16x8 At[4][2], B0[2][2], B1[2][2];
    const char* cA = (const char*)g.A + (size_t)cur.pm * tstep; const char* cB = (const char*)g.Bt + (size_t)cur.pn * tstep;
    S.a_ready(cur);
    if constexpr (SP2) {
        PG8_STAGE(PG8_SB(0, 0), cB, voffB); PG8_STAGE(PG8_SB(0, 1), cB + hstep, voffB); PG8_STAGE(PG8_SA(0, 0), cA, voffA); PG8_STAGE(PG8_SA(0, 1), cA + hstep, voffA);
        if (wr == 1) PG8_BAR;
        PG8_WAIT_V(2); PG8_BAR;
        PG8_STAGE(PG8_SB(1, 0), cB + kstep, voffB); PG8_STAGE(PG8_SA(1, 0), cA + kstep, voffA); PG8_STAGE(PG8_SB(1, 1), cB + hstep + kstep, voffB);
        PG8_WAIT_V(6); PG8_BAR;
    } else {
        PG8_STAGE(PG8_SB(0, 0), cB, voffB); PG8_STAGE(PG8_SA(0, 0), cA, voffA); PG8_STAGE(PG8_SB(0, 1), cB + hstep, voffB); PG8_STAGE(PG8_SA(0, 1), cA + hstep, voffA);
        if (wr == 1) PG8_BAR;
        PG8_WAIT_V(4); PG8_BAR;
        PG8_STAGE(PG8_SB(1, 0), cB + kstep, voffB); PG8_STAGE(PG8_SA(1, 0), cA + kstep, voffA); PG8_STAGE(PG8_SB(1, 1), cB + hstep + kstep, voffB);
        PG8_WAIT_V(6); PG8_BAR;
    }
    for (;;) {
        const bool has_next = S.next(ui + 1, nxt);
        const char* nA = has_next ? (const char*)g.A + (size_t)nxt.pm * tstep : cA; const char* nB = has_next ? (const char*)g.Bt + (size_t)nxt.pn * tstep : cB;
        for (int t = 0; t < nt; t += 2) {
            const bool last = (t == nt - 2);
            const char* a1 = cA + (size_t)(t + 1) * kstep;
            const char* a2 = last ? nA : cA + (size_t)(t + 2) * kstep; const char* b2 = last ? nB : cB + (size_t)(t + 2) * kstep;
            const char* a3 = a2 + kstep; const char* b3 = b2 + kstep;
            if (last && has_next) S.a_ready(nxt);
            if constexpr (SP2) {
            PG8_LDB(B0, 0, 0); PG8_LDB(B1, 0, 1); PG8_SCHED; PG8_LDA(At, 0, 0); PG8_STAGE(PG8_SA(1, 1), a1 + hstep, voffA);
            PG8_WAIT_V(8); PG8_WAIT_L(0); PG8_BAR; PG8_MMA(0, 0, At, B0); PG8_MMA(0, 1, At, B1); PG8_BAR; PG8_SCHED;
            PG8_LDA(At, 0, 1); PG8_STAGE(PG8_SB(0, 0), b2, voffB); PG8_STAGE(PG8_SB(0, 1), b2 + hstep, voffB); PG8_STAGE(PG8_SA(0, 0), a2, voffA);
            PG8_WAIT_V(8); PG8_WAIT_L(0); PG8_BAR; PG8_MMA(1, 0, At, B0); PG8_MMA(1, 1, At, B1); PG8_BAR; PG8_SCHED;
            PG8_LDB(B0, 1, 0); PG8_LDB(B1, 1, 1); PG8_SCHED; PG8_LDA(At, 1, 0); PG8_STAGE(PG8_SA(0, 1), a2 + hstep, voffA);
            PG8_WAIT_V(8); PG8_WAIT_L(0); PG8_BAR; PG8_MMA(0, 0, At, B0); PG8_MMA(0, 1, At, B1); PG8_BAR; PG8_SCHED;
            PG8_LDA(At, 1, 1); PG8_STAGE(PG8_SB(1, 0), b3, voffB); PG8_STAGE(PG8_SB(1, 1), b3 + hstep, voffB); PG8_STAGE(PG8_SA(1, 0), a3, voffA);
            PG8_WAIT_V(8); PG8_WAIT_L(0); PG8_BAR; PG8_MMA(1, 0, At, B0); PG8_MMA(1, 1, At, B1); PG8_BAR; PG8_SCHED;
            } else {
            PG8_LDB(B0, 0, 0); PG8_SCHED; PG8_LDA(At, 0, 0); PG8_STAGE(PG8_SA(1, 1), a1 + hstep, voffA);
            PG8_WAIT_L(8); PG8_BAR; PG8_WAIT_L(0); PG8_MMA(0, 0, At, B0); PG8_BAR; PG8_SCHED;
            PG8_LDB(B1, 0, 1); PG8_STAGE(PG8_SB(0, 0), b2, voffB);
            PG8_BAR; PG8_WAIT_L(0); PG8_MMA(0, 1, At, B1); PG8_BAR;
            PG8_LDA(At, 0, 1); PG8_STAGE(PG8_SA(0, 0), a2, voffA);
            PG8_BAR; PG8_WAIT_L(0); PG8_MMA(1, 0, At, B0); PG8_BAR; PG8_SCHED;
            PG8_STAGE(PG8_SB(0, 1), b2 + hstep, voffB);
            PG8_WAIT_V(6); PG8_BAR; PG8_MMA(1, 1, At, B1); PG8_BAR;
            PG8_LDB(B0, 1, 0); PG8_SCHED; PG8_LDA(At, 1, 0); PG8_STAGE(PG8_SA(0, 1), a2 + hstep, voffA);
            PG8_WAIT_L(8); PG8_BAR; PG8_WAIT_L(0); PG8_MMA(0, 0, At, B0); PG8_BAR; PG8_SCHED;
            PG8_LDB(B1, 1, 1); PG8_STAGE(PG8_SB(1, 0), b3, voffB);
            PG8_BAR; PG8_WAIT_L(0); PG8_MMA(0, 1, At, B1); PG8_BAR;
            PG8_LDA(At, 1, 1); PG8_STAGE(PG8_SA(1, 0), a3, voffA);
            PG8_BAR; PG8_WAIT_L(0); PG8_MMA(1, 0, At, B0); PG8_BAR; PG8_SCHED;
            PG8_STAGE(PG8_SB(1, 1), b3 + hstep, voffB);
            PG8_WAIT_V(6); PG8_BAR; PG8_MMA(1, 1, At, B1); PG8_BAR;
            }
        }
        if constexpr (ALIGN_EPI) { if (wr == 0) PG8_BAR; }
        if constexpr (!Epi::AFTER_DRAIN) { E(acc, cur, wr, wc, fr, fq); S.done(cur); }
        if (!has_next) break;
        if constexpr (Epi::HAS_INIT) E.init(acc, nxt, wr, wc, fr, fq);
        else {
#pragma unroll
        for (int a = 0; a < 2; ++a)
#pragma unroll
            for (int b = 0; b < 2; ++b)
#pragma unroll
                for (int m = 0; m < 4; ++m)
#pragma unroll
                    for (int n = 0; n < 2; ++n) acc[a][b][m][n] = (f32x4){0.f, 0.f, 0.f, 0.f};
        }
        cur = nxt; cA = nA; cB = nB; ++ui;
        if constexpr (ALIGN_EPI) { if (wr == 1) PG8_BAR; }
    }
    PG8_WAIT_V(0);
    if constexpr (!ALIGN_EPI) { if (wr == 0) PG8_BAR; }
    PG8_BAR;
    if constexpr (Epi::AFTER_DRAIN) { E.fused(acc, cur, wr, wc, fr, fq, lds, wid, lane); S.done(cur); }
#undef PG8_SA
#undef PG8_SB
#undef PG8_STAGE
#undef PG8_LDA
#undef PG8_LDB
#undef PG8_MMA
#undef PG8_WAIT_V
#undef PG8_WAIT_L
#undef PG8_BAR
#undef PG8_SCHED
}
}
typedef unsigned v4u __attribute__((ext_vector_type(4)));
typedef float f32x4 __attribute__((ext_vector_type(4)));
typedef short bf16x8 __attribute__((ext_vector_type(8)));
typedef GAS unsigned gu32;
typedef GAS unsigned long long gu64;
#define RLX_AGENT __ATOMIC_RELAXED, __HIP_MEMORY_SCOPE_AGENT
#define LDS_WAIT() asm volatile("s_waitcnt lgkmcnt(0)" ::: "memory")
#define VM_WAIT() asm volatile("s_waitcnt vmcnt(0)" ::: "memory")
__device__ __forceinline__ unsigned long long rt() { return __builtin_amdgcn_s_memrealtime(); }
__device__ __forceinline__ unsigned f2bf(float f) { unsigned u = __builtin_bit_cast(unsigned, f); return (u + 0x7fffu + ((u >> 16) & 1u)) >> 16; }
__device__ __forceinline__ unsigned pk2(float lo, float hi) { return f2bf(lo) | (f2bf(hi) << 16); }

#define XB_TMO      128
#define XB_XCNT(j)  (256  + 64 * (j))
#define XB_XSUB(j)  (1280 + 64 * (j))
#define XB_XGEN(j)  (2304 + 64 * (j))
#define XB_TOP      3328
#define XB_TOPGEN   3392
#define XCD_BAR_WORDS 3456
#define XB_SPIN_CAP (1u << 18)

__device__ __forceinline__ unsigned xb_ld(unsigned* p)              { return __hip_atomic_load(p, __ATOMIC_RELAXED, __HIP_MEMORY_SCOPE_AGENT); }
__device__ __forceinline__ unsigned xb_add(unsigned* p, unsigned v) { return __hip_atomic_fetch_add(p, v, __ATOMIC_RELAXED, __HIP_MEMORY_SCOPE_AGENT); }
__device__ __forceinline__ unsigned xb_xcc_id() { return (unsigned)__builtin_amdgcn_s_getreg((3 << 11) | 20) & 0xFu; }
#define XB_SPIN(cond, bar) do { unsigned _sp = 0; while (cond) { __builtin_amdgcn_s_sleep(1); \
    if ((++_sp & 255u) == 0u) { if (xb_ld(&(bar)[XB_TMO])) break; if (_sp > XB_SPIN_CAP) { atomicAdd(&(bar)[XB_TMO], 1u); break; } } } } while (0)

struct XcdBarrier {
    unsigned* bar; unsigned x;
    volatile LAS unsigned* st;
};

__device__ __forceinline__ XcdBarrier xcd_barrier_post(unsigned* bar, volatile LAS unsigned* st) {
    XcdBarrier b; b.bar = bar; b.x = xb_xcc_id(); b.st = st;
    if (threadIdx.x == 0) (void)xb_add(&bar[XB_XCNT(b.x)], 1u);
    return b;
}
__device__ __forceinline__ void xcd_barrier_complete(unsigned* bar, unsigned x, unsigned& nloc, unsigned& nx) {
    const unsigned G = gridDim.x * gridDim.y * gridDim.z;
    unsigned sum, cnt, mine, sp = 0u;
    for (;;) {
        sum = 0u; cnt = 0u; mine = 0u;
#pragma unroll
        for (unsigned j = 0; j < 16; ++j) { const unsigned c = xb_ld(&bar[XB_XCNT(j)]); sum += c; cnt += (c > 0u) ? 1u : 0u; mine = (j == x) ? c : mine; }
        if (sum == G) break;
        __builtin_amdgcn_s_sleep(1);
        if ((++sp & 255u) == 0u) { if (xb_ld(&bar[XB_TMO])) break; if (sp > XB_SPIN_CAP) { atomicAdd(&bar[XB_TMO], 1u); break; } }
    }
    nloc = mine > 0u ? mine : 1u; nx = cnt > 0u ? cnt : 1u;
}

__device__ __forceinline__ void xcd_barrier(const XcdBarrier& b) {
    asm volatile("s_waitcnt vmcnt(0)" ::: "memory");
    __syncthreads();
    if (threadIdx.x == 0) {
        unsigned* bar = b.bar;
        __builtin_amdgcn_s_waitcnt(0);
        unsigned nloc = b.st[0], nx = b.st[1];
        if (nloc == 0u) { xcd_barrier_complete(bar, b.x, nloc, nx); b.st[0] = nloc; b.st[1] = nx; }
        const unsigned old = xb_add(&bar[XB_XSUB(b.x)], 1u);
        const unsigned gen = old / nloc;
        if (old + 1u == (gen + 1u) * nloc) {
            __builtin_amdgcn_fence(__ATOMIC_RELEASE, "agent");
            asm volatile("s_waitcnt vmcnt(0)" ::: "memory");
            const unsigned og = xb_add(&bar[XB_TOP], 1u);
            const unsigned tg = og / nx;
            if (og + 1u == (tg + 1u) * nx) xb_add(&bar[XB_TOPGEN], 1u);
            else XB_SPIN(xb_ld(&bar[XB_TOPGEN]) == tg, bar);
            __builtin_amdgcn_fence(__ATOMIC_ACQUIRE, "agent");
            xb_add(&bar[XB_XGEN(b.x)], 1u);
            asm volatile("s_waitcnt vmcnt(0)" ::: "memory");
        } else {
            XB_SPIN(xb_ld(&bar[XB_XGEN(b.x)]) == gen, bar);
            __builtin_amdgcn_fence(__ATOMIC_ACQUIRE, "agent");
            asm volatile("s_waitcnt vmcnt(0)" ::: "memory");
        }
    }
    __syncthreads();
}
__device__ __forceinline__ float wave_sum(float v) {
#pragma unroll
    for (int o = 1; o < 64; o <<= 1) v += __shfl_xor(v, o);
    return v;
}
__device__ __forceinline__ int crow(int r, int hi) { return (r & 3) + 8 * (r >> 2) + 4 * hi; }
__device__ __forceinline__ s16x4 vtr(const LAS unsigned char* p) { return __builtin_bit_cast(s16x4, __builtin_amdgcn_ds_read_tr16_b64_v4i16((LAS v4i16_t*)p)); }
__device__ __forceinline__ unsigned cvtpk(float lo, float hi) { return pg8::cvt_pk_bf16(lo, hi); }
__device__ __forceinline__ float bflo(unsigned w) { return __uint_as_float(w << 16); }
__device__ __forceinline__ float bfhi(unsigned w) { return __uint_as_float(w & 0xffff0000u); }
__device__ __forceinline__ float bf1(bf16 h) { return __uint_as_float((unsigned)h << 16); }

struct TrItem { const float* src; const float* gain; bf16* dst; int ldsrc, nvalid, K; };
__device__ __forceinline__ void tr_load(const TrItem& t, float (&tv)[32], int lane) {
    const bool ok = (lane & 31) < t.nvalid;
#pragma unroll
    for (int i = 0; i < 32; ++i) { const int kk = 2 * i + (lane >> 5); tv[i] = ok ? t.src[(size_t)kk * t.ldsrc + (lane & 31)] : 0.f; }
    if (t.gain) {
#pragma unroll
        for (int i = 0; i < 32; ++i) tv[i] *= t.gain[2 * i + (lane >> 5)]; }
}
__device__ __forceinline__ void tr_store(const TrItem& t, const float (&tv)[32], LAS float* scr, int lane) {
#pragma unroll
    for (int i = 0; i < 32; ++i) scr[(2 * i + (lane >> 5)) * 33 + (lane & 31)] = tv[i];
    LDS_WAIT(); asm volatile("" ::: "memory");
    const int c = lane & 7;
#pragma unroll
    for (int j = 0; j < 4; ++j) { const int n = (lane >> 3) + 8 * j; const LAS float* s = scr + (8 * c) * 33 + n;
        v4u o; o.x = cvtpk(s[0 * 33], s[1 * 33]); o.y = cvtpk(s[2 * 33], s[3 * 33]); o.z = cvtpk(s[4 * 33], s[5 * 33]); o.w = cvtpk(s[6 * 33], s[7 * 33]);
        *(GAS v4u*)(t.dst + (size_t)n * t.K + 8 * c) = o; }
    LDS_WAIT(); asm volatile("" ::: "memory");
}
__device__ __forceinline__ TrItem tr_make(const float* W, int ldsrc, int col0, int nvalid, const float* gain, int K, bf16* dest, int n0, int kb) {
    TrItem t; t.src = W + (size_t)(64 * kb) * ldsrc + col0; t.gain = gain ? gain + 64 * kb : nullptr; t.dst = dest + (size_t)n0 * K + 64 * kb; t.ldsrc = ldsrc; t.nvalid = nvalid; t.K = K; return t;
}
__device__ __forceinline__ int win_src_col(int n0, int& nvalid) {
    const int t = n0 >> 8, j0 = n0 & 255; nvalid = 32;
    if (t < 2) return 256 * t + j0;
    if (t < 6) { const int base = t < 4 ? 512 : 1024, wc = (j0 & 127) >> 5, bj = j0 >> 7; return base + (4 * (t & 1) + wc) * 64 + 32 * bj; }
    if (t < 8) return 1536 + 256 * (t - 6) + j0;
    if (t < 10) return 2048 + 256 * (t - 8) + j0;
    if (t < 12) return 2560 + 256 * (t - 10) + j0;
    if (t == 12) return 3072 + j0;
    if (t == 13) return 3328 + j0;
    if (t < 16) return 3584 + 256 * (t - 14) + j0;
    if (t < 18) return 4112 + 256 * (t - 16) + j0;
    if (t < 34) return 4624 + 256 * (t - 18) + j0;
    nvalid = (j0 == 0) ? 16 : 0; return 4096;
}
__device__ __forceinline__ void prologue(LAS unsigned char* lds, int gw, int NGW, int wave, int lane) {
    asm volatile("" : "+v"(lane));
    LAS float* scr = (LAS float*)(lds + wave * 16384);
    constexpr int I13 = 16 * 176, I2 = 44 * 32, IIN = 16 * 280, IBR = 3 * 8 * 32, IOUT = 16 * 32, IPG = 16 * 32, IPP = 4 * 32, IL = 2 * I13 + 2 * I2 + IIN + IBR + IOUT + IPG + IPP;
    auto decode = [&](int it) -> TrItem {
        KParams P = params_ptr(); const int L = it / IL; int r = it - L * IL; unsigned char* wl = P->ws + WS_W + (size_t)L * LW;
        if (r < 2 * I13) { const int which = r / I13; r -= which * I13; const int kb = r / 176, nb = r % 176, n0 = 32 * nb, tile = n0 >> 8, j0 = n0 & 255;
            const float* w1 = P->in[which ? I_F2W1 : I_F1W1] + (size_t)L * DM * DFF; const float* w3 = P->in[which ? I_F2W3 : I_F1W3] + (size_t)L * DM * DFF; const float* gn = P->in[which ? I_N2 : I_N1] + L * DM;
            return tr_make(j0 < 128 ? w1 : w3, DFF, 128 * tile + (j0 & 127), 32, gn, DM, (bf16*)(wl + (which ? OW13B : OW13A)), n0, kb); }
        r -= 2 * I13;
        if (r < 2 * I2) { const int which = r / I2; r -= which * I2; const int kb = r / 32, nb = r % 32;
            return tr_make(P->in[which ? I_F2W2 : I_F1W2] + (size_t)L * DFF * DM, DM, 32 * nb, 32, nullptr, DFF, (bf16*)(wl + (which ? OW2B : OW2A)), 32 * nb, kb); }
        r -= 2 * I2;
        if (r < IIN) { const int kb = r / 280, nb = r % 280; int nv; const int sc = win_src_col(32 * nb, nv);
            return tr_make(P->in[I_WIN] + (size_t)L * DM * 8720, 8720, sc, nv, P->in[I_NM] + L * DM, DM, (bf16*)(wl + OWIN), 32 * nb, kb); }
        r -= IIN;
        if (r < IBR) { const int b = 1 + r / 256; r &= 255; const int kb = r / 32, nb = r % 32;
            return tr_make(P->in[I_WBR] + ((size_t)L * 4 + b) * 512 * 1024, 1024, 32 * nb, 32, nullptr, 512, (bf16*)(wl + OWBR) + (size_t)b * 1024 * 512, 32 * nb, kb); }
        r -= IBR;
        if (r < IOUT) { const int kb = r / 32, nb = r % 32; return tr_make(P->in[I_WOUT] + (size_t)L * DM * DM, DM, 32 * nb, 32, nullptr, DM, (bf16*)(wl + OWOUT), 32 * nb, kb); }
        r -= IOUT;
        if (r < IPG) { const int kb = r / 32, nb = r % 32; return tr_make(P->in[I_WPG] + (size_t)L * DM * DM, DM, 32 * nb, 32, P->in[I_NPL] + L * DM, DM, (bf16*)(wl + OWPG), 32 * nb, kb); }
        r -= IPG;
        { const int kb = r / 32, nb = r % 32; return tr_make(P->in[I_WPP] + (size_t)L * 256 * DM, DM, 32 * nb, 32, nullptr, 256, (bf16*)(wl + OWPP), 32 * nb, kb); }
    };
    for (int it = gw; it < NL * IL; it += 4 * NGW) {
        const bool h1 = it + NGW < NL * IL, h2 = it + 2 * NGW < NL * IL, h3 = it + 3 * NGW < NL * IL;
        const TrItem ta = decode(it), tb = decode(h1 ? it + NGW : it), tc = decode(h2 ? it + 2 * NGW : it), td = decode(h3 ? it + 3 * NGW : it);
        float va[32], vb[32], vc[32], vd[32];
        tr_load(ta, va, lane); if (h1) tr_load(tb, vb, lane); if (h2) tr_load(tc, vc, lane); if (h3) tr_load(td, vd, lane);
        tr_store(ta, va, scr, lane); if (h1) tr_store(tb, vb, scr, lane); if (h2) tr_store(tc, vc, scr, lane); if (h3) tr_store(td, vd, scr, lane);
    }
    for (int it = gw; it < NL * 64 * 16; it += NGW) {
        KParams P = params_ptr(); unsigned char* ws = P->ws; const int L = it / (64 * 16); const int r = it - L * 64 * 16; const int k0 = (r >> 4) * 8, n = (r & 15) * 64 + lane, g = k0 >> 7;
        const float* pw = P->in[I_POOLW] + ((size_t)L * 512 + k0) * 128; const float* sc = P->in[I_POOLS] + L * 512 + g * 128; const float* wb = P->in[I_WBR] + ((size_t)L * 4) * 512 * 1024 + (size_t)(g * 128) * 1024 + n;
#pragma unroll
        for (int i = 0; i < 16; ++i) { const int e = i * 64 + lane; scr[e] = pw[e] * sc[e & 127]; }
        LDS_WAIT(); asm volatile("" ::: "memory");
        float a[8];
#pragma unroll
        for (int j = 0; j < 8; ++j) a[j] = 0.f;
        for (int d0 = 0; d0 < 128; d0 += 32) {
            float wv[32];
#pragma unroll
            for (int d = 0; d < 32; ++d) wv[d] = wb[(size_t)(d0 + d) * 1024];
#pragma unroll
            for (int d = 0; d < 32; ++d)
#pragma unroll
                for (int j = 0; j < 8; ++j) a[j] += scr[j * 128 + d0 + d] * wv[d];
        }
        v4u o; o.x = cvtpk(a[0], a[1]); o.y = cvtpk(a[2], a[3]); o.z = cvtpk(a[4], a[5]); o.w = cvtpk(a[6], a[7]);
        *(GAS v4u*)((bf16*)(ws + WS_W + (size_t)L * LW + OWBR) + (size_t)n * 512 + k0) = o;
        LDS_WAIT(); asm volatile("" ::: "memory");
    }
    for (int it = gw * 64 + lane; it < NL * 4 * 128 * 128; it += NGW * 64) {
        KParams P = params_ptr(); unsigned char* ws = P->ws; const int L = it >> 16, r = it & 65535, i = (r >> 7) & 127, j = r & 127;
        const float v = ((j >> 6) <= (i >> 6)) ? P->in[I_GWS][it] : 0.f;
        ((bf16*)(ws + WS_W + (size_t)L * LW + OWM))[r] = (bf16)(cvtpk(v, 0.f) & 0xffffu);
    }
    for (int m0 = gw * 4; m0 < M; m0 += NGW * 4) {
        KParams P = params_ptr(); unsigned char* ws = P->ws;
        f32x4 v[4][4];
#pragma unroll
        for (int r = 0; r < 4; ++r) { const int m = m0 + r; const float* src = m < MP ? P->in[I_XP] + (size_t)m * DM : P->in[I_XS] + (size_t)(m - MP) * DM;
#pragma unroll
            for (int j = 0; j < 4; ++j) v[r][j] = ((const GAS f32x4*)src)[lane + 64 * j]; }
#pragma unroll
        for (int r = 0; r < 4; ++r) { const int m = m0 + r; float s = 0.f;
#pragma unroll
            for (int j = 0; j < 4; ++j) s += (v[r][j].x * v[r][j].x + v[r][j].y * v[r][j].y) + (v[r][j].z * v[r][j].z + v[r][j].w * v[r][j].w);
            s = wave_sum(s);
            GAS u32x2* bo = (GAS u32x2*)((bf16*)(ws + WS_XB0) + (size_t)m * DM) + lane; GAS u32x2* lo = (GAS u32x2*)((bf16*)(ws + WS_XL) + (size_t)m * DM) + lane;
#pragma unroll
            for (int j = 0; j < 4; ++j) { u32x2 w; w.x = cvtpk(v[r][j].x, v[r][j].y); w.y = cvtpk(v[r][j].z, v[r][j].w); bo[64 * j] = w;
                if (USE_XL) { u32x2 l; l.x = cvtpk(v[r][j].x - bflo(w.x), v[r][j].y - bfhi(w.x)); l.y = cvtpk(v[r][j].z - bflo(w.y), v[r][j].w - bfhi(w.y)); lo[64 * j] = l; } }
            if (lane < 16) ((float*)(ws + WS_SSQ0))[(size_t)m * 16 + lane] = lane == 0 ? s : 0.f; }
    }
    for (int it0 = gw * 8; it0 < NL * M; it0 += NGW * 8) {
        KParams P = params_ptr(); unsigned char* ws = P->ws; f32x4 v[8];
#pragma unroll
        for (int j = 0; j < 8; ++j) { const int it = it0 + j, L = it / M, m = it - L * M;
            const float* src = m < MP ? P->in[I_PP] + ((size_t)L * MP + m) * 256 : P->in[I_PS] + ((size_t)L * MS + (m - MP)) * 256; v[j] = ((const GAS f32x4*)src)[lane]; }
#pragma unroll
        for (int j = 0; j < 8; ++j) { u32x2 w; w.x = cvtpk(v[j].x, v[j].y); w.y = cvtpk(v[j].z, v[j].w); ((GAS u32x2*)((bf16*)(ws + WS_PB) + (size_t)(it0 + j) * 256))[lane] = w; }
    }
}

template <int W> __device__ __forceinline__ void pool_rows(KParams P, int L, int rblk, int g, int lane) {
    const bf16* xpb = (const bf16*)(P->ws + WS_XPB); bf16* D = (bf16*)(P->ws + WS_AB);
    const int row0 = rblk * 32; const bool prompt = row0 < MP;
    int rowbase, t0; const float* hist = nullptr; float* pout; int pfirst;
    if (prompt) { const int b = row0 >> 12; rowbase = b << 12; t0 = row0 & 4095; pout = P->out + O_POOLP + ((size_t)L * 8 + b) * 15 * 512; pfirst = 4081; }
    else { const int b = (row0 - MP) >> 5; rowbase = MP + (b << 5); t0 = 0; hist = P->in[I_SPOOL] + ((size_t)L * 16 + b) * 15 * 512; pout = P->out + O_POOLS + ((size_t)L * 16 + b) * 15 * 512; pfirst = 17; }
    const int tb = t0 + 8 * (lane >> 4), c0 = g * 128 + (lane & 15) * 8;
    v4u x[W + 7];
#pragma unroll
    for (int i = 0; i < W + 7; ++i) { const int t = tb - (W - 1) + i; x[i] = *(const GAS v4u*)(xpb + (size_t)(rowbase + (t > 0 ? t : 0)) * 512 + c0); }
    if (prompt) {
#pragma unroll
        for (int i = 0; i < W - 1; ++i) { const int t = tb - (W - 1) + i; if (t < 0) x[i] = (v4u){0u, 0u, 0u, 0u}; }
    } else {
        v4u hx[W - 1];
#pragma unroll
        for (int i = 0; i < W - 1; ++i) { const int t = tb - (W - 1) + i; int hr = 15 + t; hr = hr < 0 ? 0 : (hr > 14 ? 14 : hr); const float* h = hist + (size_t)hr * 512 + c0;
            hx[i] = pg8::pack8(*(const f32x4*)h, *(const f32x4*)(h + 4)); }
#pragma unroll
        for (int i = 0; i < W - 1; ++i) { const int t = tb - (W - 1) + i; if (t < 0) x[i] = hx[i]; }
    }
    f32x4 s0 = (f32x4){0.f, 0.f, 0.f, 0.f}, s1 = s0;
#pragma unroll
    for (int i = 0; i < W - 1; ++i) { s0 = s0 + (f32x4){bflo(x[i].x), bfhi(x[i].x), bflo(x[i].y), bfhi(x[i].y)}; s1 = s1 + (f32x4){bflo(x[i].z), bfhi(x[i].z), bflo(x[i].w), bfhi(x[i].w)}; }
#pragma unroll
    for (int j = 0; j < 8; ++j) { const int t = tb + j; const v4u xn = x[j + W - 1], xo = x[j];
        const f32x4 a = (f32x4){bflo(xn.x), bfhi(xn.x), bflo(xn.y), bfhi(xn.y)}, b = (f32x4){bflo(xn.z), bfhi(xn.z), bflo(xn.w), bfhi(xn.w)};
        s0 = s0 + a; s1 = s1 + b;
        const int cnt = prompt ? (t + 1 < W ? t + 1 : W) : W; const float inv = 1.0f / (float)cnt;
        *(GAS v4u*)(D + (size_t)(rowbase + t) * 512 + c0) = pg8::pack8(s0 * inv - a, s1 * inv - b);
        if (t >= pfirst) { float* po = pout + (size_t)(t - pfirst) * 512 + c0; *(f32x4*)po = a; *(f32x4*)(po + 4) = b; }
        s0 = s0 - (f32x4){bflo(xo.x), bfhi(xo.x), bflo(xo.y), bfhi(xo.y)}; s1 = s1 - (f32x4){bflo(xo.z), bfhi(xo.z), bflo(xo.w), bfhi(xo.w)}; }
}
__device__ __forceinline__ void pool_unit(int L, int unit, int lane) {
    KParams P = params_ptr(); asm volatile("" : "+v"(lane));
    const int g = unit & 3, rblk = unit >> 2;
    if (g == 0) pool_rows<2>(P, L, rblk, 0, lane); else if (g == 1) pool_rows<4>(P, L, rblk, 1, lane); else if (g == 2) pool_rows<8>(P, L, rblk, 2, lane); else pool_rows<16>(P, L, rblk, 3, lane);
}

template <bool SAMPLE> __device__ __forceinline__ void sb_unit(LAS unsigned char* wl, int lane, int L, int unit) {
    KParams P = params_ptr(); asm volatile("" : "+v"(lane));
    const bf16* Qb = (const bf16*)(P->ws + WS_QB); const bf16* Kb = (const bf16*)(P->ws + WS_KB); const bf16* Vb = (const bf16*)(P->ws + WS_VB); bf16* Y = (bf16*)(P->ws + WS_AB) + (size_t)M * 512;
    int newrow0, nnew, npast, qidx0, h; const float* ck = nullptr; const float* cv = nullptr;
    if (!SAMPLE) { const int b = unit >> 10, r = unit & 1023; h = r >> 7; qidx0 = (r & 127) * 32; newrow0 = b << 12; nnew = 4096; npast = 0; }
    else { const int r = unit - 8192, b = r >> 3; h = r & 7; qidx0 = 0; newrow0 = MP + (b << 5); nnew = 32; npast = 4096;
        ck = P->in[I_CK] + ((size_t)L * 16 + b) * 4096 * 512; cv = P->in[I_CV] + ((size_t)L * 16 + b) * 4096 * 512; }
    const int r32 = lane & 31, hi = lane >> 5; const int qrow0 = newrow0 + qidx0;
    pg8::bf16x8 qf[4];
    { const bf16* qp = Qb + (size_t)(qrow0 + r32) * 512 + h * 64 + hi * 8;
#pragma unroll
      for (int d0 = 0; d0 < 4; ++d0) qf[d0] = *(const GAS pg8::bf16x8*)(qp + d0 * 16); }
    f32x16 o0, o1;
#pragma unroll
    for (int r = 0; r < 16; ++r) { o0[r] = 0.f; o1[r] = 0.f; }
    float R2 = 0.f;
    const int qpos0 = npast + qidx0, jd = qpos0 >> 6;
    v4u kv[8], vv[8];
    auto issue_new = [&](int jj) {
#pragma unroll
        for (int i = 0; i < 8; ++i) { const int r = (lane >> 3) + 8 * i; int idx = 64 * jj - npast + r; idx = idx < nnew ? idx : nnew - 1;
            const size_t off = (size_t)(newrow0 + idx) * 512 + h * 64 + (lane & 7) * 8; kv[i] = *(const GAS v4u*)(Kb + off); vv[i] = *(const GAS v4u*)(Vb + off); }
    };
    if (!SAMPLE) issue_new(jd);
    for (int j = jd; j >= 0; --j) {
        if (__all(R2 >= SB_CUT)) break;
        const int p0 = 64 * j; const bool isnew = !SAMPLE || p0 >= npast;
        if (isnew) {
            if (SAMPLE) issue_new(j);
#pragma unroll
            for (int i = 0; i < 8; ++i) { const int r = (lane >> 3) + 8 * i;
                *(LAS v4u*)(wl + r * 128 + (((lane & 7) ^ (r & 7)) * 16)) = kv[i]; *(LAS v4u*)(wl + 8192 + r * 128 + (lane & 7) * 16) = vv[i]; }
            if (!SAMPLE && j > 0) issue_new(j - 1);
        } else {
#pragma unroll
            for (int hf = 0; hf < 2; ++hf) {
                f32x4 kk[8], vf[8];
#pragma unroll
                for (int i = 0; i < 8; ++i) { const int r = (lane >> 4) + 4 * (8 * hf + i); const size_t off = ((size_t)(p0 + r) * 8 + h) * 64 + (lane & 15) * 4; kk[i] = *(const GAS f32x4*)(ck + off); vf[i] = *(const GAS f32x4*)(cv + off); }
#pragma unroll
                for (int i = 0; i < 8; ++i) { const int r = (lane >> 4) + 4 * (8 * hf + i); u32x2 a, b; a.x = cvtpk(kk[i].x, kk[i].y); a.y = cvtpk(kk[i].z, kk[i].w); b.x = cvtpk(vf[i].x, vf[i].y); b.y = cvtpk(vf[i].z, vf[i].w);
                    *(LAS u32x2*)(wl + r * 128 + ((((lane & 15) >> 1) ^ (r & 7)) * 16) + (lane & 1) * 8) = a; *(LAS u32x2*)(wl + 8192 + r * 128 + (lane & 15) * 8) = b; }
            }
        }
        asm volatile("" ::: "memory");
        f32x16 p[2];
#pragma unroll
        for (int kh = 0; kh < 2; ++kh) {
#pragma unroll
            for (int r = 0; r < 16; ++r) p[kh][r] = 0.f;
#pragma unroll
            for (int d0 = 0; d0 < 4; ++d0) { const int row = 32 * kh + r32; const pg8::bf16x8 kf = *(const LAS pg8::bf16x8*)(wl + row * 128 + (((2 * d0 + hi) ^ (row & 7)) * 16));
                p[kh] = __builtin_amdgcn_mfma_f32_32x32x16_bf16(kf, qf[d0], p[kh], 0, 0, 0); }
        }
        const float f = __builtin_amdgcn_exp2f(-R2);
        const bool diag = (j == jd);
#pragma unroll
        for (int kh = 0; kh < 2; ++kh)
#pragma unroll
            for (int r = 0; r < 16; ++r) { float s = p[kh][r]; s = s < 60.f ? s : 60.f; float u = __builtin_amdgcn_exp2f(s);
                if (diag) { const bool valid = (p0 + 32 * kh + crow(r, hi)) < (qpos0 + r32); u = valid ? u : 0.f; }
                p[kh][r] = u; }
        float gp[16];
#pragma unroll
        for (int kh = 0; kh < 2; ++kh)
#pragma unroll
            for (int a = 0; a < 4; ++a) { const float g = ((1.0f + p[kh][4 * a]) * (1.0f + p[kh][4 * a + 1])) * ((1.0f + p[kh][4 * a + 2]) * (1.0f + p[kh][4 * a + 3])); const float og = __shfl_xor(g, 32);
                gp[8 * kh + 2 * a] = hi ? og : g; gp[8 * kh + 2 * a + 1] = hi ? g : og; }
        float E[16]; E[15] = 1.0f;
#pragma unroll
        for (int G = 14; G >= 0; --G) E[G] = E[G + 1] * gp[G + 1];
        const float T = E[0] * gp[0];
#pragma unroll
        for (int kh = 0; kh < 2; ++kh)
#pragma unroll
            for (int a = 0; a < 4; ++a) { const float e = hi ? E[8 * kh + 2 * a + 1] : E[8 * kh + 2 * a];
                const float D3 = e * (1.0f + p[kh][4 * a + 3]), D2 = D3 * (1.0f + p[kh][4 * a + 2]), D1 = D2 * (1.0f + p[kh][4 * a + 1]), D0 = D1 * (1.0f + p[kh][4 * a]);
                p[kh][4 * a + 3] = p[kh][4 * a + 3] * __builtin_amdgcn_rcpf(D3) * f; p[kh][4 * a + 2] = p[kh][4 * a + 2] * __builtin_amdgcn_rcpf(D2) * f;
                p[kh][4 * a + 1] = p[kh][4 * a + 1] * __builtin_amdgcn_rcpf(D1) * f; p[kh][4 * a] = p[kh][4 * a] * __builtin_amdgcn_rcpf(D0) * f; }
        R2 += __builtin_amdgcn_logf(T);
#pragma unroll
        for (int s = 0; s < 4; ++s) {
            const int kh = s >> 1, rb = 8 * (s & 1);
            v4u pw; pw.x = cvtpk(p[kh][rb], p[kh][rb + 1]); pw.y = cvtpk(p[kh][rb + 2], p[kh][rb + 3]); pw.z = cvtpk(p[kh][rb + 4], p[kh][rb + 5]); pw.w = cvtpk(p[kh][rb + 6], p[kh][rb + 7]);
            const pg8::bf16x8 pf = __builtin_bit_cast(pg8::bf16x8, pw);
            const LAS unsigned char* vbase = wl + 8192 + (16 * s + 4 * hi + ((lane & 15) >> 2)) * 128 + ((lane >> 4) & 1) * 32 + (lane & 3) * 8;
#pragma unroll
            for (int dh = 0; dh < 2; ++dh) { const s16x4 lo = vtr(vbase + dh * 64), h4 = vtr(vbase + dh * 64 + 8 * 128);
                const pg8::bf16x8 vf = (pg8::bf16x8){lo[0], lo[1], lo[2], lo[3], h4[0], h4[1], h4[2], h4[3]};
                if (dh == 0) o0 = __builtin_amdgcn_mfma_f32_32x32x16_bf16(pf, vf, o0, 0, 0, 0); else o1 = __builtin_amdgcn_mfma_f32_32x32x16_bf16(pf, vf, o1, 0, 0, 0); }
        }
        asm volatile("" ::: "memory");
    }
    bf16* yp = Y + (size_t)qrow0 * 512 + h * 64 + r32;
#pragma unroll
    for (int r = 0; r < 16; ++r) { bf16* q = yp + (size_t)crow(r, hi) * 512; q[0] = (bf16)(cvtpk(o0[r], 0.f) & 0xffffu); q[32] = (bf16)(cvtpk(o1[r], 0.f) & 0xffffu); }
}

__device__ __forceinline__ void gmlp_unit(LAS unsigned char* wl, int lane, int L, int unit) {
    KParams P = params_ptr(); asm volatile("" : "+v"(lane));
    const bf16* gub = (const bf16*)(P->ws + WS_GUB); const bf16* gvb = (const bf16*)(P->ws + WS_GVB); bf16* Y = (bf16*)(P->ws + WS_AB) + (size_t)2 * M * 512;
    int row0, ntok, g, cb;
    if (unit < 4096) { const int ch = unit >> 4; g = (unit >> 2) & 3; cb = unit & 3; row0 = ch * 128; ntok = 128; }
    else { const int r = unit - 4096, b = r >> 4; g = (r >> 2) & 3; cb = r & 3; row0 = MP + b * 32; ntok = 32; }
    const bf16* wm = (const bf16*)(P->ws + WS_W + (size_t)L * LW + OWM) + (size_t)g * 128 * 128; const float* bs = P->in[I_GB] + ((size_t)L * 4 + g) * 128;
    const int r32 = lane & 31, hi = lane >> 5; const int colb = g * 128 + cb * 32;
    for (int i = 0; i < ntok / 16; ++i) { const int r = (lane >> 2) + 16 * i; *(LAS v4u*)(wl + r * 80 + (lane & 3) * 16) = *(const GAS v4u*)(gvb + (size_t)(row0 + r) * 512 + colb + (lane & 3) * 8); }
    asm volatile("" ::: "memory");
    const int nib = ntok / 32;
    for (int ib = 0; ib < nib; ++ib) {
        f32x16 acc;
#pragma unroll
        for (int r = 0; r < 16; ++r) acc[r] = 0.f;
        const int ns = ntok == 32 ? 2 : (ib < 2 ? 4 : 8);
        pg8::bf16x8 af[8]; bf16 guv[16]; float bsv[16];
#pragma unroll
        for (int s = 0; s < 8; ++s) if (s < ns) af[s] = *(const GAS pg8::bf16x8*)(wm + (size_t)(32 * ib + r32) * 128 + 16 * s + 8 * hi);
#pragma unroll
        for (int r = 0; r < 16; ++r) { const int i = 32 * ib + crow(r, hi); guv[r] = gub[(size_t)(row0 + i) * 512 + colb + r32]; bsv[r] = bs[i]; }
#pragma unroll
        for (int s = 0; s < 8; ++s) if (s < ns) {
            const LAS unsigned char* bb = wl + (16 * s + 8 * hi + ((lane & 15) >> 2)) * 80 + ((lane >> 4) & 1) * 32 + (lane & 3) * 8;
            const s16x4 lo = vtr(bb), h4 = vtr(bb + 4 * 80);
            const pg8::bf16x8 bfr = (pg8::bf16x8){lo[0], lo[1], lo[2], lo[3], h4[0], h4[1], h4[2], h4[3]};
            acc = __builtin_amdgcn_mfma_f32_32x32x16_bf16(af[s], bfr, acc, 0, 0, 0);
        }
#pragma unroll
        for (int r = 0; r < 16; ++r) { const int i = 32 * ib + crow(r, hi); const size_t off = (size_t)(row0 + i) * 512 + colb + r32;
            Y[off] = (bf16)(cvtpk(bf1(guv[r]) * (acc[r] + bsv[r]), 0.f) & 0xffffu); }
    }
    asm volatile("" ::: "memory");
}

__device__ __forceinline__ void gla_ids(int cid, int& row0, int& ntok, int& h) {
    if (cid < 2048) { const int sq = cid >> 6, c = cid & 63; h = sq & 3; row0 = (sq >> 2) * 4096 + c * 64; ntok = 64; }
    else { const int sq = cid - 2048; h = sq & 3; row0 = MP + (sq >> 2) * 32; ntok = 32; }
}
struct GlaInA { v4u la; v4u q, k, v0, v1; };
__device__ __forceinline__ GlaInA gla_a_issue(KParams P, int L, int cid, int tid) {
    int row0, ntok, h; gla_ids(cid, row0, ntok, h);
    const int t = tid >> 3, q8 = tid & 7; const bool live = t < ntok; GlaInA r;
    const bf16* lab = (const bf16*)(P->ws + WS_LAB); const bf16* lqb = (const bf16*)(P->ws + WS_LQB); const bf16* lkb = (const bf16*)(P->ws + WS_LKB); const bf16* lvb = (const bf16*)(P->ws + WS_LVB);
    const v4u z = (v4u){0u, 0u, 0u, 0u}; r.la = z; r.q = z; r.k = z; r.v0 = z; r.v1 = z;
    { const int ar = 32 * ((tid >> 6) & 1) + (tid & 31); if (ar < ntok) r.la = *(const GAS v4u*)(lab + (size_t)(row0 + ar) * 256 + 8 * ((tid >> 5) & 1)); }
    if (live) { r.q = *(const GAS v4u*)(lqb + (size_t)(row0 + t) * 256 + h * 64 + 8 * q8); r.k = *(const GAS v4u*)(lkb + (size_t)(row0 + t) * 256 + h * 64 + 8 * q8);
                r.v0 = *(const GAS v4u*)(lvb + (size_t)(row0 + t) * 512 + h * 128 + 16 * q8); r.v1 = *(const GAS v4u*)(lvb + (size_t)(row0 + t) * 512 + h * 128 + 16 * q8 + 8); }
    return r;
}
__device__ __forceinline__ void gla_pass_a_loop(LAS unsigned char* lds, int L, int vcu, int G, int tid) {
    asm volatile("" : "+v"(tid)); const int lane = tid & 63, wave = __builtin_amdgcn_readfirstlane(tid >> 6);
    LAS float* LA = (LAS float*)lds;
    LAS float* WA = LA + 64 * 17;
    LAS float* BA = WA + 16 * 64;
    LAS float* SEG = BA + 64;
    LAS float* LAMS = SEG + 8 * 64;
    LAS float* Gt = LAMS + 64;
    LAS unsigned char* KT = (LAS unsigned char*)(Gt + 64 * 65);
    LAS unsigned char* VT0 = KT + 64 * 144;
    int vpar = 0;
    int seg = vcu; if (seg >= NSEG) return; int ci = 0;
    int c = seg < 256 ? seg * 8 : 2048 + (seg - 256);
    const int t = tid >> 3, q8 = tid & 7, r32 = lane & 31, hi = lane >> 5;
    f32x16 Srun; float Lrun = 1.0f;
#pragma unroll
    for (int r = 0; r < 16; ++r) Srun[r] = 0.f;
    GlaInA in = gla_a_issue(params_ptr(), L, c, tid);
    int seg1 = seg, ci1 = 1; if (ci1 >= (seg < 256 ? 8 : 1)) { seg1 = seg + G; ci1 = 0; }
    bool has1 = seg1 < NSEG; int c1 = has1 ? (seg1 < 256 ? seg1 * 8 + ci1 : 2048 + (seg1 - 256)) : c;
    GlaInA in2 = in; if (has1) in2 = gla_a_issue(params_ptr(), L, c1, tid);
    v4u bhi = (v4u){0u, 0u, 0u, 0u}, blo = bhi; float bcol = 0.f;
    auto step = [&](GlaInA& in) -> bool {
        KParams P = params_ptr(); const int nch = seg < 256 ? 8 : 1;
        int row0, ntok, h; gla_ids(c, row0, ntok, h); const bool live = t < ntok;
        LAS unsigned char* VT = VT0 + vpar * (64 * 272); vpar ^= 1;
        if (ci == 0) {
            const float* wa = P->in[I_WA2] + ((size_t)L * 16 + 8 * hi) * 256 + h * 64 + 32 * ((wave >> 1) & 1) + r32; float w[8];
#pragma unroll
            for (int i = 0; i < 8; ++i) w[i] = wa[(size_t)i * 256];
            bcol = P->in[I_BA][L * 256 + h * 64 + 32 * ((wave >> 1) & 1) + r32];
            bhi.x = cvtpk(w[0], w[1]); bhi.y = cvtpk(w[2], w[3]); bhi.z = cvtpk(w[4], w[5]); bhi.w = cvtpk(w[6], w[7]);
            blo.x = cvtpk(w[0] - bflo(bhi.x), w[1] - bfhi(bhi.x)); blo.y = cvtpk(w[2] - bflo(bhi.y), w[3] - bfhi(bhi.y)); blo.z = cvtpk(w[4] - bflo(bhi.z), w[5] - bfhi(bhi.z)); blo.w = cvtpk(w[6] - bflo(bhi.w), w[7] - bfhi(bhi.w)); }
        *(LAS v4u*)(VT + t * 272 + q8 * 32) = in.v0; *(LAS v4u*)(VT + t * 272 + q8 * 32 + 16) = in.v1;
        const v4u qraw = in.q, kraw = in.k; const pg8::bf16x8 afr = __builtin_bit_cast(pg8::bf16x8, in.la);
        int seg2 = seg1, ci2 = ci1 + 1; if (ci2 >= (seg1 < 256 ? 8 : 1)) { seg2 = seg1 + G; ci2 = 0; }
        const bool has2 = has1 && seg2 < NSEG; const int c2 = has2 ? (seg2 < 256 ? seg2 * 8 + ci2 : 2048 + (seg2 - 256)) : c1;
        if (has2) in = gla_a_issue(P, L, c2, tid);
        { f32x16 xg;
#pragma unroll
          for (int r = 0; r < 16; ++r) xg[r] = bcol;
          xg = __builtin_amdgcn_mfma_f32_32x32x16_bf16(afr, __builtin_bit_cast(pg8::bf16x8, bhi), xg, 0, 0, 0);
          xg = __builtin_amdgcn_mfma_f32_32x32x16_bf16(afr, __builtin_bit_cast(pg8::bf16x8, blo), xg, 0, 0, 0);
          const int tb_ = wave & 1, kb_ = (wave >> 1) & 1, half = wave >> 2;
#pragma unroll
          for (int r8 = 0; r8 < 8; ++r8) { const float x = half ? xg[8 + r8] : xg[r8]; const int tt = 32 * tb_ + crow(r8, hi) + 16 * half;
              const float ax = __builtin_fabsf(x); const float l2 = 1.4426950408889634f * (x < 0.f ? x : 0.f) - __builtin_amdgcn_logf(1.0f + __builtin_amdgcn_exp2f(-1.4426950408889634f * ax));
              Gt[tt * 65 + 32 * kb_ + r32] = tt < ntok ? l2 * (1.0f / 16.0f) : 0.f; } }
        __syncthreads();
        { float g[8], sg[7];
#pragma unroll
          for (int s = 0; s < 8; ++s) g[s] = Gt[(8 * wave + s) * 65 + lane];
#pragma unroll
          for (int s = 1; s < 8; ++s) g[s] += g[s - 1];
          SEG[wave * 64 + lane] = g[7];
          __syncthreads();
#pragma unroll
          for (int w = 0; w < 7; ++w) sg[w] = SEG[w * 64 + lane];
          float off = 0.f;
#pragma unroll
          for (int w = 0; w < 7; ++w) off += (w < wave) ? sg[w] : 0.f;
#pragma unroll
          for (int s = 0; s < 8; ++s) Gt[(8 * wave + s) * 65 + lane] = g[s] + off; }
        __syncthreads();
        { const float qin[8] = {bflo(qraw.x), bfhi(qraw.x), bflo(qraw.y), bfhi(qraw.y), bflo(qraw.z), bfhi(qraw.z), bflo(qraw.w), bfhi(qraw.w)};
          const float kin[8] = {bflo(kraw.x), bfhi(kraw.x), bflo(kraw.y), bfhi(kraw.y), bflo(kraw.z), bfhi(kraw.z), bflo(kraw.w), bfhi(kraw.w)};
          float qo[8], ko[8];
          float bb[8];
#pragma unroll
          for (int kk = 0; kk < 8; ++kk) bb[kk] = Gt[t * 65 + 8 * q8 + kk];
#pragma unroll
          for (int kk = 0; kk < 8; ++kk) { float b2 = bb[kk]; b2 = b2 > -120.f ? b2 : -120.f; qo[kk] = qin[kk] * __builtin_amdgcn_exp2f(b2) * 0.125f; ko[kk] = kin[kk] * __builtin_amdgcn_exp2f(-b2); }
          v4u qw, kw; qw.x = cvtpk(qo[0], qo[1]); qw.y = cvtpk(qo[2], qo[3]); qw.z = cvtpk(qo[4], qo[5]); qw.w = cvtpk(qo[6], qo[7]); kw.x = cvtpk(ko[0], ko[1]); kw.y = cvtpk(ko[2], ko[3]); kw.z = cvtpk(ko[4], ko[5]); kw.w = cvtpk(ko[6], ko[7]);
          *(LAS v4u*)(KT + t * 144 + q8 * 16) = kw;
          if (live) { *(GAS v4u*)((bf16*)(P->ws + WS_QT) + (size_t)(row0 + t) * 256 + h * 64 + 8 * q8) = qw; *(GAS v4u*)((bf16*)(P->ws + WS_KT) + (size_t)(row0 + t) * 256 + h * 64 + 8 * q8) = kw; } }
        if (tid < 64) { float b2 = Gt[63 * 65 + tid]; b2 = b2 > -120.f ? b2 : -120.f; const float lamv = __builtin_amdgcn_exp2f(b2); LAMS[tid] = lamv;
            if (ci == 0) Lrun = 1.0f;
            ((float*)(P->ws + WS_LAM))[(size_t)c * 64 + tid] = lamv;
            Lrun *= lamv;
            if (ci == nch - 1) ((float*)(P->ws + WS_SC) + (size_t)NSEG * 8192)[(size_t)seg * 64 + tid] = Lrun; }
        __syncthreads();
        { const int kb = wave & 1, vb = wave >> 1;
          f32x16 acc;
#pragma unroll
          for (int r = 0; r < 16; ++r) acc[r] = 0.f;
          const LAS unsigned char* ka = KT + (8 * hi + ((lane & 15) >> 2)) * 144 + (32 * kb + 16 * ((lane >> 4) & 1) + 4 * (lane & 3)) * 2;
          const LAS unsigned char* va = VT + (8 * hi + ((lane & 15) >> 2)) * 272 + (32 * vb + 16 * ((lane >> 4) & 1) + 4 * (lane & 3)) * 2;
#pragma unroll
          for (int s4 = 0; s4 < 4; ++s4) { const s16x4 a0 = vtr(ka + s4 * 16 * 144), a1 = vtr(ka + s4 * 16 * 144 + 4 * 144), b0 = vtr(va + s4 * 16 * 272), b1 = vtr(va + s4 * 16 * 272 + 4 * 272);
              const pg8::bf16x8 af = (pg8::bf16x8){a0[0], a0[1], a0[2], a0[3], a1[0], a1[1], a1[2], a1[3]}, bfr = (pg8::bf16x8){b0[0], b0[1], b0[2], b0[3], b1[0], b1[1], b1[2], b1[3]};
              acc = __builtin_amdgcn_mfma_f32_32x32x16_bf16(af, bfr, acc, 0, 0, 0); }
          if (ci == 0) {
#pragma unroll
              for (int r = 0; r < 16; ++r) Srun[r] = 0.f; }
#pragma unroll
          for (int r = 0; r < 16; ++r) Srun[r] = LAMS[32 * kb + crow(r, hi)] * (Srun[r] + acc[r]);
          if (ci == nch - 1) { float* sg = (float*)(P->ws + WS_SC) + (size_t)seg * 8192;
#pragma unroll
              for (int r = 0; r < 16; ++r) sg[(32 * kb + crow(r, hi)) * 128 + 32 * vb + r32] = Srun[r]; } }
        if (!has1) return false;
        seg = seg1; ci = ci1; c = c1; seg1 = seg2; ci1 = ci2; c1 = c2; has1 = has2;
        return true;
    };
    for (;;) { if (!step(in)) break; if (!step(in2)) break; }
    __syncthreads();
}
struct GlaInC { v4u q, k, v0, v1, l0, l1; float lc; };
__device__ __forceinline__ GlaInC gla_c_issue(KParams P, int cid, int tid) {
    int row0, ntok, h; gla_ids(cid, row0, ntok, h);
    const int t = tid >> 3, q8 = tid & 7; const bool live = t < ntok; GlaInC r;
    const v4u z = (v4u){0u, 0u, 0u, 0u}; r.q = z; r.k = z; r.v0 = z; r.v1 = z; r.l0 = z; r.l1 = z;
    if (live) { r.q = *(const GAS v4u*)((const bf16*)(P->ws + WS_QT) + (size_t)(row0 + t) * 256 + h * 64 + 8 * q8); r.k = *(const GAS v4u*)((const bf16*)(P->ws + WS_KT) + (size_t)(row0 + t) * 256 + h * 64 + 8 * q8);
                const bf16* lv = (const bf16*)(P->ws + WS_LVB) + (size_t)(row0 + t) * 512 + h * 128 + 16 * q8; r.v0 = *(const GAS v4u*)lv; r.v1 = *(const GAS v4u*)(lv + 8);
                const bf16* lr = (const bf16*)(P->ws + WS_LRB) + (size_t)(row0 + t) * 512 + h * 128 + 16 * q8; r.l0 = *(const GAS v4u*)lr; r.l1 = *(const GAS v4u*)(lr + 8); }
    r.lc = ((const float*)(P->ws + WS_LAM))[(size_t)cid * 64 + (tid & 63)];
    return r;
}
__device__ __forceinline__ void gla_pass_c_loop(LAS unsigned char* lds, int L, int vcu, int G, int tid) {
    asm volatile("" : "+v"(tid)); const int lane = tid & 63, wave = __builtin_amdgcn_readfirstlane(tid >> 6);
    LAS unsigned char* QT = lds;
    LAS unsigned char* KT = QT + 64 * 144;
    LAS unsigned char* VT = KT + 64 * 144;
    LAS unsigned char* ST = VT + 64 * 272;
    LAS float* O = (LAS float*)(ST + 64 * 272);
    LAS float* LAMS = O + 64 * 128;
    int seg = vcu; if (seg >= NSEG) return; int ci = 0;
    int c = seg < 256 ? seg * 8 : 2048 + (seg - 256);
    const int t = tid >> 3, q8 = tid & 7, r32 = lane & 31, hi = lane >> 5;
    const int so = (32 * (wave & 1) + 4 * hi) * 128 + 32 * (wave >> 1) + r32;
    f32x16 S0;
#pragma unroll
    for (int j = 0; j < 16; ++j) S0[j] = 0.f;
    float gon[16];
    { const float* gp = params_ptr()->in[I_GON] + L * 128 + 16 * q8;
#pragma unroll
      for (int j = 0; j < 4; ++j) { const f32x4 g4 = *(const f32x4*)(gp + 4 * j); gon[4 * j] = g4[0]; gon[4 * j + 1] = g4[1]; gon[4 * j + 2] = g4[2]; gon[4 * j + 3] = g4[3]; } }
    GlaInC in = gla_c_issue(params_ptr(), c, tid);
    int seg1 = seg, ci1 = 1; if (ci1 >= (seg < 256 ? 8 : 1)) { seg1 = seg + G; ci1 = 0; }
    bool has1 = seg1 < NSEG; int c1 = has1 ? (seg1 < 256 ? seg1 * 8 + ci1 : 2048 + (seg1 - 256)) : c;
    GlaInC in2 = in; if (has1) in2 = gla_c_issue(params_ptr(), c1, tid);
    auto step = [&](GlaInC& in) -> bool {
        KParams P = params_ptr(); const int nch = seg < 256 ? 8 : 1;
        const float* SSEG = (const float*)(P->ws + WS_SC); const float* LSEG = SSEG + (size_t)NSEG * 8192;
        if (ci == 0) {
            if (seg >= 256) { const float* sg = P->in[I_SGLA] + ((size_t)L * 64 + (seg - 256)) * 8192 + so;
#pragma unroll
                for (int r = 0; r < 16; ++r) S0[r] = sg[((r & 3) + 8 * (r >> 2)) * 128]; }
            else { const int jn = seg & 7, sb = seg - jn;
#pragma unroll
                for (int j = 0; j < 16; ++j) S0[j] = 0.f;
#pragma unroll 1
                for (int j0 = 0; j0 < jn; j0 += 2) {
                    float sv[2][16], lv[2][16];
#pragma unroll
                    for (int jj = 0; jj < 2; ++jj) if (j0 + jj < jn) { const float* sp = SSEG + (size_t)(sb + j0 + jj) * 8192 + so; const float* lp = LSEG + (size_t)(sb + j0 + jj) * 64 + 32 * (wave & 1) + 4 * hi;
#pragma unroll
                        for (int r = 0; r < 16; ++r) { sv[jj][r] = sp[((r & 3) + 8 * (r >> 2)) * 128]; lv[jj][r] = lp[(r & 3) + 8 * (r >> 2)]; } }
#pragma unroll
                    for (int jj = 0; jj < 2; ++jj) if (j0 + jj < jn) {
#pragma unroll
                        for (int r = 0; r < 16; ++r) S0[r] = lv[jj][r] * S0[r] + sv[jj][r]; }
                }
            }
        }
        int row0, ntok, h; gla_ids(c, row0, ntok, h); const bool live = t < ntok;
        *(LAS v4u*)(QT + t * 144 + q8 * 16) = in.q; *(LAS v4u*)(KT + t * 144 + q8 * 16) = in.k;
        *(LAS v4u*)(VT + t * 272 + q8 * 32) = in.v0; *(LAS v4u*)(VT + t * 272 + q8 * 32 + 16) = in.v1;
#pragma unroll
        for (int r = 0; r < 16; ++r) *(LAS unsigned short*)(ST + (32 * (wave & 1) + crow(r, hi)) * 272 + (32 * (wave >> 1) + r32) * 2) = (unsigned short)(cvtpk(S0[r], 0.f) & 0xffffu);
        if (tid < 64) LAMS[tid] = in.lc;
        const v4u l0 = in.l0, l1 = in.l1;
        int seg2 = seg1, ci2 = ci1 + 1; if (ci2 >= (seg1 < 256 ? 8 : 1)) { seg2 = seg1 + G; ci2 = 0; }
        const bool has2 = has1 && seg2 < NSEG; const int c2 = has2 ? (seg2 < 256 ? seg2 * 8 + ci2 : 2048 + (seg2 - 256)) : c1;
        if (has2) in = gla_c_issue(P, c2, tid);
        __syncthreads();
        { const int tb = wave & 1, vb = wave >> 1;
          pg8::bf16x8 qf[4];
#pragma unroll
          for (int k4 = 0; k4 < 4; ++k4) qf[k4] = *(const LAS pg8::bf16x8*)(QT + (32 * tb + r32) * 144 + (16 * k4 + 8 * hi) * 2);
          f32x16 o;
#pragma unroll
          for (int r = 0; r < 16; ++r) o[r] = 0.f;
          const LAS unsigned char* sa = ST + (8 * hi + ((lane & 15) >> 2)) * 272 + (32 * vb + 16 * ((lane >> 4) & 1) + 4 * (lane & 3)) * 2;
#pragma unroll
          for (int k4 = 0; k4 < 4; ++k4) { const s16x4 b0 = vtr(sa + k4 * 16 * 272), b1 = vtr(sa + k4 * 16 * 272 + 4 * 272);
              o = __builtin_amdgcn_mfma_f32_32x32x16_bf16(qf[k4], (pg8::bf16x8){b0[0], b0[1], b0[2], b0[3], b1[0], b1[1], b1[2], b1[3]}, o, 0, 0, 0); }
#pragma unroll
          for (int sb = 0; sb < 2; ++sb) if (sb <= tb) {
              f32x16 at;
#pragma unroll
              for (int r = 0; r < 16; ++r) at[r] = 0.f;
#pragma unroll
              for (int k4 = 0; k4 < 4; ++k4) at = __builtin_amdgcn_mfma_f32_32x32x16_bf16(*(const LAS pg8::bf16x8*)(KT + (32 * sb + r32) * 144 + (16 * k4 + 8 * hi) * 2), qf[k4], at, 0, 0, 0);
              if (sb == tb) {
#pragma unroll
                  for (int r = 0; r < 16; ++r) at[r] = (crow(r, hi) <= r32) ? at[r] : 0.f; }
              const LAS unsigned char* va = VT + (32 * sb + 4 * hi + ((lane & 15) >> 2)) * 272 + (32 * vb + 16 * ((lane >> 4) & 1) + 4 * (lane & 3)) * 2;
#pragma unroll
              for (int s2 = 0; s2 < 2; ++s2) { v4u pw; pw.x = cvtpk(at[8 * s2], at[8 * s2 + 1]); pw.y = cvtpk(at[8 * s2 + 2], at[8 * s2 + 3]); pw.z = cvtpk(at[8 * s2 + 4], at[8 * s2 + 5]); pw.w = cvtpk(at[8 * s2 + 6], at[8 * s2 + 7]);
                  const s16x4 b0 = vtr(va + s2 * 16 * 272), b1 = vtr(va + s2 * 16 * 272 + 8 * 272);
                  o = __builtin_amdgcn_mfma_f32_32x32x16_bf16(__builtin_bit_cast(pg8::bf16x8, pw), (pg8::bf16x8){b0[0], b0[1], b0[2], b0[3], b1[0], b1[1], b1[2], b1[3]}, o, 0, 0, 0); }
          }
#pragma unroll
          for (int r = 0; r < 16; ++r) O[(32 * tb + crow(r, hi)) * 128 + 32 * vb + r32] = o[r];
          { f32x16 acc;
#pragma unroll
            for (int r = 0; r < 16; ++r) acc[r] = 0.f;
            const LAS unsigned char* ka = KT + (8 * hi + ((lane & 15) >> 2)) * 144 + (32 * tb + 16 * ((lane >> 4) & 1) + 4 * (lane & 3)) * 2;
            const LAS unsigned char* vd = VT + (8 * hi + ((lane & 15) >> 2)) * 272 + (32 * vb + 16 * ((lane >> 4) & 1) + 4 * (lane & 3)) * 2;
#pragma unroll
            for (int s4 = 0; s4 < 4; ++s4) { const s16x4 a0 = vtr(ka + s4 * 16 * 144), a1 = vtr(ka + s4 * 16 * 144 + 4 * 144), b0 = vtr(vd + s4 * 16 * 272), b1 = vtr(vd + s4 * 16 * 272 + 4 * 272);
                const pg8::bf16x8 af = (pg8::bf16x8){a0[0], a0[1], a0[2], a0[3], a1[0], a1[1], a1[2], a1[3]}, bfr = (pg8::bf16x8){b0[0], b0[1], b0[2], b0[3], b1[0], b1[1], b1[2], b1[3]};
                acc = __builtin_amdgcn_mfma_f32_32x32x16_bf16(af, bfr, acc, 0, 0, 0); }
#pragma unroll
            for (int r = 0; r < 16; ++r) S0[r] = LAMS[32 * tb + crow(r, hi)] * (S0[r] + acc[r]); }
          if (ci == nch - 1 && (seg >= 256 || (seg & 7) == 7)) {
              float* op = (seg >= 256 ? P->out + O_GLAS + ((size_t)L * 64 + (seg - 256)) * 8192 : P->out + O_GLAP + ((size_t)L * 32 + (seg >> 3)) * 8192) + so;
#pragma unroll
              for (int r = 0; r < 16; ++r) op[((r & 3) + 8 * (r >> 2)) * 128] = S0[r]; } }
        __syncthreads();
        { float v[16]; float ss = 0.f;
#pragma unroll
          for (int j = 0; j < 16; ++j) { v[j] = O[t * 128 + 16 * q8 + j]; ss += v[j] * v[j]; }
          ss += __shfl_xor(ss, 1); ss += __shfl_xor(ss, 2); ss += __shfl_xor(ss, 4);
          const float rs = __builtin_amdgcn_rsqf(ss * (1.0f / 128.0f) + 1e-6f);
          if (live) {
              const float lr[16] = {bflo(l0.x), bfhi(l0.x), bflo(l0.y), bfhi(l0.y), bflo(l0.z), bfhi(l0.z), bflo(l0.w), bfhi(l0.w), bflo(l1.x), bfhi(l1.x), bflo(l1.y), bfhi(l1.y), bflo(l1.z), bfhi(l1.z), bflo(l1.w), bfhi(l1.w)};
              float y[16];
#pragma unroll
              for (int j = 0; j < 16; ++j) y[j] = v[j] * rs * gon[j] * lr[j];
              bf16* yo = (bf16*)(P->ws + WS_AB) + (size_t)3 * M * 512 + (size_t)(row0 + t) * 512 + h * 128 + 16 * q8;
              v4u w0, w1; w0.x = cvtpk(y[0], y[1]); w0.y = cvtpk(y[2], y[3]); w0.z = cvtpk(y[4], y[5]); w0.w = cvtpk(y[6], y[7]); w1.x = cvtpk(y[8], y[9]); w1.y = cvtpk(y[10], y[11]); w1.z = cvtpk(y[12], y[13]); w1.w = cvtpk(y[14], y[15]);
              *(GAS v4u*)yo = w0; *(GAS v4u*)(yo + 8) = w1; } }
        if (!has1) return false;
        seg = seg1; ci = ci1; c = c1; seg1 = seg2; ci1 = ci2; c1 = c2; has1 = has2;
        return true;
    };
    for (;;) { if (!step(in)) break; if (!step(in2)) break; }
}

template <int U> __device__ __forceinline__ void sg_batch(f32x16& c0, f32x16& c1, const GAS pg8::bf16x8* ap, const GAS pg8::bf16x8* b0, const GAS pg8::bf16x8* b1, int s) {
    pg8::bf16x8 a[U], w0[U], w1[U];
#pragma unroll
    for (int i = 0; i < U; ++i) { a[i] = ap[2 * (s + i)]; w0[i] = b0[2 * (s + i)]; w1[i] = b1[2 * (s + i)]; }
#pragma unroll
    for (int i = 0; i < U; ++i) { c0 = __builtin_amdgcn_mfma_f32_32x32x16_bf16(w0[i], a[i], c0, 0, 0, 0); c1 = __builtin_amdgcn_mfma_f32_32x32x16_bf16(w1[i], a[i], c1, 0, 0, 0); }
}
template <int B1OFF = 32> __device__ __forceinline__ void sg_accum(f32x16& c0, f32x16& c1, const bf16* A, int lda, const bf16* Bt, int ldb, int row0, int col0, int kbeg, int nsteps, int lane) {
    const int r32 = lane & 31, hi = lane >> 5;
    const GAS pg8::bf16x8* ap = (const GAS pg8::bf16x8*)(A + (size_t)(row0 + r32) * lda + kbeg + 8 * hi);
    const GAS pg8::bf16x8* b0 = (const GAS pg8::bf16x8*)(Bt + (size_t)(col0 + r32) * ldb + kbeg + 8 * hi);
    const GAS pg8::bf16x8* b1 = (const GAS pg8::bf16x8*)(Bt + (size_t)(col0 + B1OFF + r32) * ldb + kbeg + 8 * hi);
    asm volatile("" : "+s"(nsteps));
    int s = 0;
#pragma unroll 1
    for (; s + 8 <= nsteps; s += 8) sg_batch<8>(c0, c1, ap, b0, b1, s);
    if (nsteps & 4) { sg_batch<4>(c0, c1, ap, b0, b1, s); s += 4; }
    if (nsteps & 2) sg_batch<2>(c0, c1, ap, b0, b1, s);
}
__device__ __forceinline__ void sg_zero(f32x16& c) {
#pragma unroll
    for (int r = 0; r < 16; ++r) c[r] = 0.f;
}
__device__ __forceinline__ void sample_up_tiles(int L, int xc, int second, int gw, int NGW, int lane) {
    asm volatile("" : "+v"(lane)); const int r32 = lane & 31, hi = lane >> 5;
    for (int t = gw; t < 16 * 88; t += NGW) {
        KParams P = params_ptr(); unsigned char* ws = P->ws; const bf16* Bt = (const bf16*)(ws + WS_W + (size_t)L * LW + (second ? OW13B : OW13A));
        const int row0 = MP + 32 * (t / 88), hc = 32 * (t % 88), brow = (hc >> 7) * 256 + (hc & 127);
        f32x16 c0, c1; sg_zero(c0); sg_zero(c1);
        sg_accum<128>(c0, c1, (const bf16*)(ws + (xc ? WS_XB1 : WS_XB0)), DM, Bt, DM, row0, brow, 0, 64, lane);
        const int row = row0 + r32; const float rs = pg8::row_rstd((const float*)(ws + WS_SSQ0), row);
        bf16* hp = (bf16*)(ws + WS_HB) + (size_t)row * DFF + hc + 4 * hi;
#pragma unroll
        for (int a = 0; a < 4; ++a) { float h[4];
#pragma unroll
            for (int i = 0; i < 4; ++i) h[i] = pg8::silu_f(c0[4 * a + i] * rs) * (c1[4 * a + i] * rs);
            u32x2 w; w.x = cvtpk(h[0], h[1]); w.y = cvtpk(h[2], h[3]); *(GAS u32x2*)(hp + 8 * a) = w; }
    }
}
template <int MODE> __device__ __forceinline__ void sample_tiles(LAS unsigned char* lds, int L, int xc, int second, float alpha, int sq_out, int vcu, int G, int tid, int fin = 0) {
    asm volatile("" : "+v"(tid)); const int lane = tid & 63, wave = __builtin_amdgcn_readfirstlane(tid >> 6), r32 = lane & 31, hi = lane >> 5;
    LAS float* part = (LAS float*)lds;
    LAS float* part2 = part + 16384; asm volatile("" : "+v"(part2));
    for (int t = vcu; t < 256; t += G) {
        KParams P = params_ptr(); unsigned char* ws = P->ws; unsigned char* wl = ws + WS_W + (size_t)L * LW;
        const int row0 = MP + 32 * (t >> 4), tc = t & 15, col0 = 64 * tc;
        f32x16 c0, c1, d0, d1; sg_zero(c0); sg_zero(c1); sg_zero(d0); sg_zero(d1);
        if (MODE == 0) {
            if (sq_out == 1) sg_accum(c0, c1, (const bf16*)(ws + WS_HB), DFF, (const bf16*)(wl + (second ? OW2B : OW2A)), DFF, row0, col0, wave * 352, 22, lane);
            else sg_accum(c0, c1, (const bf16*)(ws + WS_MB), DM, (const bf16*)(wl + OWOUT), DM, row0, col0, wave * 128, 8, lane);
        } else if (MODE == 1) {
            sg_accum(c0, c1, (const bf16*)(ws + (xc ? WS_XB1 : WS_XB0)), DM, (const bf16*)(wl + OWPG), DM, row0, col0, wave * 128, 8, lane);
            sg_accum(d0, d1, (const bf16*)(ws + WS_PB) + (size_t)L * M * 256, 256, (const bf16*)(wl + OWPP), 256, row0, col0, wave * 32, 2, lane);
        } else {
            const unsigned char* gbp = ws + WS_GB + (size_t)(row0 + r32) * 4096 + col0 + 4 * hi;
            for (int b = 0; b < 4; ++b) {
                sg_zero(d0); sg_zero(d1);
                sg_accum(d0, d1, (const bf16*)(ws + WS_AB) + (size_t)b * M * 512, 512, (const bf16*)(wl + OWBR) + (size_t)b * 1024 * 512, 512, row0, col0, wave * 64, 4, lane);
#pragma unroll
                for (int a = 0; a < 4; ++a) { const unsigned g0 = *(const GAS unsigned*)(gbp + b * 1024 + 8 * a), g1 = *(const GAS unsigned*)(gbp + b * 1024 + 32 + 8 * a);
#pragma unroll
                    for (int i = 0; i < 4; ++i) { float f0 = (float)((g0 >> (8 * i)) & 255u), f1 = (float)((g1 >> (8 * i)) & 255u); f0 = (f0 > 1.0f ? f0 : 1.0f) * (1.0f / 255.0f); f1 = (f1 > 1.0f ? f1 : 1.0f) * (1.0f / 255.0f);
                        c0[4 * a + i] += f0 * d0[4 * a + i]; c1[4 * a + i] += f1 * d1[4 * a + i]; } }
            }
        }
#pragma unroll
        for (int r = 0; r < 16; ++r) { part[((wave * 32 + r) * 64) + lane] = c0[r]; part[((wave * 32 + 16 + r) * 64) + lane] = c1[r]; }
        if (MODE == 1) {
#pragma unroll
            for (int r = 0; r < 16; ++r) { part2[((wave * 32 + r) * 64) + lane] = d0[r]; part2[((wave * 32 + 16 + r) * 64) + lane] = d1[r]; }
        }
        __syncthreads();
        if (wave == 0) {
#pragma unroll 1
            for (int w = 1; w < 8; ++w) {
                const LAS float* pw_ = part + w * 2048 + lane;
#pragma unroll
                for (int r = 0; r < 16; ++r) { c0[r] += pw_[r * 64]; c1[r] += pw_[(16 + r) * 64]; }
                if (MODE == 1) { const LAS float* pd_ = part2 + w * 2048 + lane;
#pragma unroll
                    for (int r = 0; r < 16; ++r) { d0[r] += pd_[r * 64]; d1[r] += pd_[(16 + r) * 64]; } }
            }
            const int row = row0 + r32; const size_t rb = (size_t)row * 1024 + col0 + 4 * hi;
            if (MODE == 2) {
                bf16* mb = (bf16*)(ws + WS_MB) + rb;
#pragma unroll
                for (int a = 0; a < 4; ++a) { u32x2 w0, w1; w0.x = cvtpk(c0[4 * a], c0[4 * a + 1]); w0.y = cvtpk(c0[4 * a + 2], c0[4 * a + 3]); w1.x = cvtpk(c1[4 * a], c1[4 * a + 1]); w1.y = cvtpk(c1[4 * a + 2], c1[4 * a + 3]);
                    *(GAS u32x2*)(mb + 8 * a) = w0; *(GAS u32x2*)(mb + 32 + 8 * a) = w1; }
            } else {
                float* X = P->out + O_X + rb; bf16* XB = (bf16*)(ws + ((MODE == 1 ? (xc ^ 1) : xc) ? WS_XB1 : WS_XB0)) + rb; const bf16* XI = (const bf16*)(ws + (xc ? WS_XB1 : WS_XB0)) + rb; bf16* XL = (bf16*)(ws + WS_XL) + rb;
                float rs = 0.f; if (MODE == 1) rs = pg8::row_rstd((const float*)(ws + (sq_out ? WS_SSQ0 : WS_SSQ1)), row);
                float ss = 0.f;
#pragma unroll
                for (int j = 0; j < 2; ++j)
#pragma unroll
                    for (int a = 0; a < 4; ++a) { f32x4 v; const u32x2 h2 = *(const GAS u32x2*)(XI + 32 * j + 8 * a); u32x2 l2 = (u32x2){0u, 0u}; if (USE_XL) l2 = *(const GAS u32x2*)(XL + 32 * j + 8 * a);
                        f32x4 xo = (f32x4){bflo(h2.x) + bflo(l2.x), bfhi(h2.x) + bfhi(l2.x), bflo(h2.y) + bflo(l2.y), bfhi(h2.y) + bfhi(l2.y)};
#pragma unroll
                        for (int i = 0; i < 4; ++i) { const float cv = j ? c1[4 * a + i] : c0[4 * a + i]; if (MODE == 1) { const float dv = j ? d1[4 * a + i] : d0[4 * a + i]; v[i] = pg8::sigm(cv * rs) * dv * ((PROBE_DUP & 8192) ? alpha : 1.0f); } else v[i] = cv * alpha; }
                        xo = xo + v; if (fin) *(GAS f32x4*)(X + 32 * j + 8 * a) = xo; u32x2 w; w.x = cvtpk(xo[0], xo[1]); w.y = cvtpk(xo[2], xo[3]); *(GAS u32x2*)(XB + 32 * j + 8 * a) = w;
                        if (USE_XL) { u32x2 l; l.x = cvtpk(xo[0] - bflo(w.x), xo[1] - bfhi(w.x)); l.y = cvtpk(xo[2] - bflo(w.y), xo[3] - bfhi(w.y)); *(GAS u32x2*)(XL + 32 * j + 8 * a) = l; }
                        ss += (xo[0] * xo[0] + xo[1] * xo[1]) + (xo[2] * xo[2] + xo[3] * xo[3]); }
                ss += __shfl_xor(ss, 32);
                if (hi == 0) ((float*)(ws + (sq_out ? WS_SSQ1 : WS_SSQ0)))[(size_t)row * 16 + tc] = ss;
            }
        }
        __syncthreads();
    }
}

struct WaveQ { unsigned* heads; int n, s, tries; };
__device__ __forceinline__ int q_pull(WaveQ& q, int lane) {
    for (;;) {
        unsigned v = 0u; if (lane == 0) v = __hip_atomic_fetch_add(q.heads + 64 * q.s, 1u, __ATOMIC_RELAXED, __HIP_MEMORY_SCOPE_AGENT);
        const int u = (int)__builtin_amdgcn_readfirstlane(v) * 8 + q.s;
        if (u < q.n) return u;
        if (++q.tries >= 8) return q.n;
        q.s = (q.s + 1) & 7;
    }
}
__global__ void __launch_bounds__(NWAVES * 64, 2) hybrid_fwd(Params Pargs) {
    extern __shared__ __attribute__((aligned(16))) unsigned char lds_raw[];
    LAS unsigned char* lds = (LAS unsigned char*)lds_raw;
    const int tid = threadIdx.x, lane = tid & 63, wave = __builtin_amdgcn_readfirstlane(tid >> 6);
    const int G = gridDim.x, bx = blockIdx.x;
    const int vcu = (G % 8 == 0) ? (bx % 8) * (G / 8) + bx / 8 : bx;
    const int gw = vcu * NWAVES + wave, NGW = G * NWAVES;
    for (int u = tid; u < (LDS_BYTES - RING_BYTES) / 4; u += NWAVES * 64) ((LAS unsigned*)(lds + RING_BYTES))[u] = 0u;
    __syncthreads();
    (void)xcd_barrier_post((unsigned*)(params_ptr()->ws + WS_CTL) + CW_BAR, (volatile LAS unsigned*)(lds + MISC_OFF) + 8);
#define GRID_BAR() do { XcdBarrier b_; b_.bar = (unsigned*)(params_ptr()->ws + WS_CTL) + CW_BAR; b_.x = xb_xcc_id(); b_.st = (volatile LAS unsigned*)(lds + MISC_OFF) + 8; xcd_barrier(b_); } while (0)

    prologue(lds, gw, NGW, wave, lane);
    GRID_BAR();
#if PROBE_DUP & 16
    prologue(lds, gw, NGW, wave, lane);
    GRID_BAR();
#endif

    for (int hl = 0; hl < 2 * NL; ++hl) {
        const int L = hl >> 1, second = hl & 1, xc = L & 1;
        for (int rep_ = 0; rep_ < ((PROBE_DUP & 1) ? 2 : 1); ++rep_) {
        { KParams P = params_ptr(); unsigned char* ws = P->ws; unsigned char* wl = ws + WS_W + (size_t)L * LW;
          pg8::Gemm g{(const bf16*)(ws + (xc ? WS_XB1 : WS_XB0)), (const bf16*)(wl + (second ? OW13B : OW13A)), MP, 5632, DM}; pg8::RstdOrder S; S.init(MP, 5632, G, bx, WGM_UP); S.kp = P; S.sq = 0; S.rl = (LAS float*)(lds + RSTD_OFF); S.nd = 0; S.started = false;
          pg8::EpiSwiGLU E{P, (const LAS float*)(lds + RSTD_OFF)};
          pg8::gemm_phase<pg8::EpiSwiGLU, pg8::RstdOrder, true, true>(lds, g, S, E); }
        sample_up_tiles(L, xc, second, gw, NGW, lane);
        GRID_BAR();
        }
        for (int rep_ = 0; rep_ < ((PROBE_DUP & 2048) ? 2 : 1); ++rep_) {
        { KParams P = params_ptr(); unsigned char* ws = P->ws; unsigned char* wl = ws + WS_W + (size_t)L * LW;
          pg8::Gemm g{(const bf16*)(ws + WS_HB), (const bf16*)(wl + (second ? OW2B : OW2A)), MP, DM, DFF}; pg8::StaticOrder S; S.init(MP, DM, G, bx, WGM_X);
          pg8::EpiX<false> E{P, xc, xc, 1, (PROBE_DUP & 2048) ? 0.25f : 0.5f, nullptr, 0};
          pg8::gemm_phase<pg8::EpiX<false>, pg8::StaticOrder, true, true>(lds, g, S, E); }
        sample_tiles<0>(lds, L, xc, second, (PROBE_DUP & 2048) ? 0.25f : 0.5f, 1, vcu, G, tid);
        GRID_BAR();
        }
        if (!second) {
            for (int rep_ = 0; rep_ < ((PROBE_DUP & 2) ? 2 : 1); ++rep_) {
            { KParams P = params_ptr(); unsigned char* ws = P->ws; unsigned char* wl = ws + WS_W + (size_t)L * LW;
              pg8::Gemm g{(const bf16*)(ws + (xc ? WS_XB1 : WS_XB0)), (const bf16*)(wl + OWIN), M, NIN, DM}; pg8::RstdOrder S; S.init(M, NIN, G, bx, WGM_IN); S.kp = P; S.sq = 1; S.rl = (LAS float*)(lds + RSTD_OFF); S.nd = 0; S.started = false;
              pg8::EpiIn E{P, L, (const LAS float*)(lds + RSTD_OFF)};
              pg8::gemm_phase<pg8::EpiIn, pg8::RstdOrder, true, true>(lds, g, S, E); }
            GRID_BAR();
            }
            for (int rep_ = 0; rep_ < ((PROBE_DUP & 4) ? 2 : 1); ++rep_) {
#if PROBE_DUP & 262144
            { const unsigned long long t0_ = wall_clock64(); while (wall_clock64() - t0_ < 25000ull) __builtin_amdgcn_s_sleep(64); }
#endif
            for (int rq_ = 0; rq_ < ((PROBE_DUP & 32) ? 2 : 1); ++rq_) gla_pass_a_loop(lds, L, vcu, G, tid);
            for (int rq_ = 0; rq_ < ((PROBE_DUP & (64 | 256)) ? 2 : 1); ++rq_)
            { const int qn_ = (rq_ && (PROBE_DUP & 64)) ? 128 + 8192 : 128 + 8192 + M / 8 + 4096 + 256;
              WaveQ q{(unsigned*)(params_ptr()->ws + WS_CTL) + CW_Q + 512 * (2 * L) + 8192 * rq_, qn_, (int)(xb_xcc_id() & 7u), 0};
              int u = q_pull(q, lane);
              while (u < qn_) { const int un = q_pull(q, lane);
                  if (u < 128) sb_unit<true>(lds + wave * 16384, lane, L, 8192 + u);
                  else { const int k = u - 128;
                      if (k < 6 * 2048) { const int g6 = k / 6, r6 = k - 6 * g6; if (r6 < 4) sb_unit<false>(lds + wave * 16384, lane, L, 4 * g6 + r6); else pool_unit(L, 2 * g6 + (r6 - 4), lane); }
                      else { const int k2 = k - 6 * 2048;
                          if (k2 < 4096 + 256) gmlp_unit(lds + wave * 16384, lane, L, k2); else pool_unit(L, 4096 + (k2 - (4096 + 256)), lane); } }
                  u = un; } }
            GRID_BAR();
            for (int rq_ = 0; rq_ < ((PROBE_DUP & 512) ? 2 : 1); ++rq_) gla_pass_c_loop(lds, L, vcu, G, tid);
            GRID_BAR();
            }
            for (int rep_ = 0; rep_ < ((PROBE_DUP & 8) ? 2 : 1); ++rep_) {
            { KParams P = params_ptr(); unsigned char* ws = P->ws; unsigned char* wl = ws + WS_W + (size_t)L * LW;
              pg8::Gemm g{(const bf16*)(ws + WS_AB), (const bf16*)(wl + OWBR), 4 * M, 4 * DM, 512}; pg8::BranchOrder S{G, vcu};
              pg8::EpiBranch E{P};
              pg8::gemm_phase<pg8::EpiBranch, pg8::BranchOrder, true, true>(lds, g, S, E); }
            sample_tiles<2>(lds, L, xc, 0, 1.0f, 0, vcu, G, tid);
            GRID_BAR();
            }
            for (int rep_ = 0; rep_ < ((PROBE_DUP & 4096) ? 2 : 1); ++rep_) {
            { KParams P = params_ptr(); unsigned char* ws = P->ws; unsigned char* wl = ws + WS_W + (size_t)L * LW;
              pg8::Gemm g{(const bf16*)(ws + WS_MB), (const bf16*)(wl + OWOUT), MP, DM, DM}; pg8::StaticOrder S; S.init(MP, DM, G, bx, WGM_X);
              pg8::EpiX<false> E{P, xc, xc, 0, (PROBE_DUP & 4096) ? 0.5f : 1.0f, nullptr, 0};
              pg8::gemm_phase<pg8::EpiX<false>, pg8::StaticOrder, true, true>(lds, g, S, E); }
            sample_tiles<0>(lds, L, xc, 0, (PROBE_DUP & 4096) ? 0.5f : 1.0f, 0, vcu, G, tid);
            { KParams P = params_ptr(); unsigned char* ws = P->ws; unsigned char* wl = ws + WS_W + (size_t)L * LW;
              pg8::Gemm g{(const bf16*)(ws + WS_PB) + (size_t)L * M * 256, (const bf16*)(wl + OWPP), MP, DM, 256}; pg8::StaticOrder S; S.init(MP, DM, G, bx, WGM_X);
              pg8::EpiPlain E{P};
              pg8::gemm_phase<pg8::EpiPlain, pg8::StaticOrder, true, true>(lds, g, S, E); }
            GRID_BAR();
            }
        } else {
            for (int rep_ = 0; rep_ < ((PROBE_DUP & 8192) ? 2 : 1); ++rep_) {
            { KParams P = params_ptr(); unsigned char* ws = P->ws; unsigned char* wl = ws + WS_W + (size_t)L * LW;
              pg8::Gemm g{(const bf16*)(ws + (xc ? WS_XB1 : WS_XB0)), (const bf16*)(wl + OWPG), MP, DM, DM}; pg8::RstdOrder S; S.init(MP, DM, G, bx, WGM_X); S.kp = P; S.sq = 1; S.rl = (LAS float*)(lds + RSTD_OFF); S.nd = 0; S.started = false;
              pg8::EpiX<true> E{P, xc, xc ^ 1, 0, (PROBE_DUP & 8192) ? 0.5f : 1.0f, (const LAS float*)(lds + RSTD_OFF), hl == 2 * NL - 1};
              pg8::gemm_phase<pg8::EpiX<true>, pg8::RstdOrder, true, true>(lds, g, S, E); }
            sample_tiles<1>(lds, L, xc, 0, (PROBE_DUP & 8192) ? 0.5f : 1.0f, 0, vcu, G, tid, hl == 2 * NL - 1);
            GRID_BAR();
            }
        }
    }
#undef GRID_BAR
}

extern "C" void kernel_launch(void* const* d_in, const int* in_sizes, int n_in, void* d_out, int out_size, void* d_ws, size_t ws_size, hipStream_t stream) {
    static int grid = 0;
    if (grid == 0) {
        if (n_in != 32 || (size_t)out_size != O_END || ws_size < WS_END) { fprintf(stderr, "kernel_launch: unexpected shapes: n_in %d out %d ws %zu (want 32, %zu, >= %zu)\n", n_in, out_size, ws_size, (size_t)O_END, (size_t)WS_END); grid = -1; return; }
        int dev = 0, cus = 0, per_cu = 0;
        if (hipGetDevice(&dev) != hipSuccess || hipDeviceGetAttribute(&cus, hipDeviceAttributeMultiprocessorCount, dev) != hipSuccess) { grid = -1; return; }
        if (hipFuncSetAttribute((const void*)hybrid_fwd, hipFuncAttributeMaxDynamicSharedMemorySize, LDS_BYTES) != hipSuccess) { fprintf(stderr, "kernel_launch: hipFuncSetAttribute failed\n"); grid = -1; return; }
        if (hipOccupancyMaxActiveBlocksPerMultiprocessor(&per_cu, (const void*)hybrid_fwd, NWAVES * 64, LDS_BYTES) != hipSuccess || per_cu < 1) fprintf(stderr, "kernel_launch: occupancy query reports %d\n", per_cu);
        (void)hipGetLastError();
        grid = cus;
    }
    if (grid < 0) return;
    if (hipMemsetAsync((char*)d_ws + WS_CTL, 0, CTL_ZERO_BYTES, stream) != hipSuccess) return;
    Params p{};
    for (int i = 0; i < 32; ++i) p.in[i] = (const float*)d_in[i];
    p.out = (float*)d_out; p.ws = (unsigned char*)d_ws;
    hipLaunchKernelGGL(hybrid_fwd, dim3(grid), dim3(NWAVES * 64), LDS_BYTES, stream, p);
    const hipError_t le = hipPeekAtLastError();
    if (le != hipSuccess) fprintf(stderr, "kernel_launch: launch failed: %s\n", hipGetErrorName(le));
}
```

```cpp
#include <hip/hip_runtime.h>
#include <cstdio>
#include <cstdint>
#define GAS __attribute__((address_space(1)))
#define LAS __attribute__((address_space(3)))
typedef unsigned short bf16;
#ifndef PROBE_DUP
#define PROBE_DUP 0
#endif

constexpr int NWAVES = 8;
constexpr int DM = 1024, MP = 32768, MS = 512, M = MP + MS, NL = 4, DFF = 2816, NIN = 8960;
constexpr int NCHUNK = 2048 + 64;
constexpr int NSEQ = 32 + 64;
constexpr int NSEG = 256 + 64;
constexpr size_t O_X = 0, O_KP = (size_t)M * DM, O_VP = O_KP + (size_t)NL * MP * 512, O_POOLP = O_VP + (size_t)NL * MP * 512, O_GLAP = O_POOLP + (size_t)NL * 8 * 15 * 512,
    O_KS = O_GLAP + (size_t)NL * 8 * 4 * 64 * 128, O_VS = O_KS + (size_t)NL * MS * 512, O_POOLS = O_VS + (size_t)NL * MS * 512, O_GLAS = O_POOLS + (size_t)NL * 16 * 15 * 512,
    O_GVS = O_GLAS + (size_t)NL * 16 * 4 * 64 * 128, O_END = O_GVS + (size_t)NL * MS * 512;
constexpr size_t MiB = 1u << 20;
constexpr size_t WS_CTL = 0, CTL_ZERO_BYTES = 1 * MiB;
constexpr size_t WS_W = 2 * MiB, LW = 60 * MiB;
constexpr size_t OW13A = 0, OW2A = 11 * MiB, OW13B = 16 * MiB + MiB / 2, OW2B = 27 * MiB + MiB / 2, OWIN = 33 * MiB, OWBR = 50 * MiB + MiB / 2, OWOUT = 54 * MiB + MiB / 2, OWPG = 56 * MiB + MiB / 2,
    OWPP = 58 * MiB + MiB / 2, OWM = 59 * MiB;
constexpr size_t WS_XB0 = 242 * MiB, WS_XB1 = 307 * MiB, WS_SSQ0 = 372 * MiB, WS_SSQ1 = 375 * MiB, WS_HB = 378 * MiB;
constexpr size_t WS_XPB = 557 * MiB, WS_QB = 590 * MiB, WS_KB = 623 * MiB, WS_VB = 656 * MiB, WS_GUB = 689 * MiB, WS_GVB = 722 * MiB, WS_LVB = 755 * MiB, WS_LRB = 788 * MiB;
constexpr size_t WS_LQB = 821 * MiB, WS_LKB = 838 * MiB, WS_LAB = 855 * MiB, WS_GB = 872 * MiB, WS_AB = 1132 * MiB, WS_MB = 1262 * MiB, WS_PPB = 1327 * MiB, WS_PB = 1392 * MiB;
constexpr size_t WS_QT = 1457 * MiB, WS_KT = 1490 * MiB, WS_DS = 1523 * MiB, WS_SC = 1589 * MiB, WS_LAM = 1655 * MiB, WS_XL = 1656 * MiB, WS_END = 1721 * MiB;
static_assert(OW13A + (size_t)5632 * 1024 * 2 <= OW2A && OW2A + (size_t)1024 * 2816 * 2 <= OW13B && OW13B + (size_t)5632 * 1024 * 2 <= OW2B && OW2B + (size_t)1024 * 2816 * 2 <= OWIN &&
              OWIN + (size_t)NIN * 1024 * 2 <= OWBR && OWBR + (size_t)4 * 1024 * 512 * 2 <= OWOUT && OWOUT + 2 * MiB <= OWPG && OWPG + 2 * MiB <= OWPP && OWPP + MiB / 2 <= OWM && OWM + 131072 <= LW, "weight map");
static_assert(WS_W + NL * LW <= WS_XB0 && WS_XB0 + (size_t)M * DM * 2 <= WS_XB1 && WS_XB1 + (size_t)M * DM * 2 <= WS_SSQ0 && WS_SSQ0 + (size_t)M * 64 <= WS_SSQ1 && WS_SSQ1 + (size_t)M * 64 <= WS_HB &&
              WS_HB + (size_t)M * DFF * 2 <= WS_XPB && WS_XPB + (size_t)M * 1024 <= WS_QB && WS_LRB + (size_t)M * 1024 <= WS_LQB && WS_LQB + (size_t)M * 512 <= WS_LKB && WS_LAB + (size_t)M * 512 <= WS_GB &&
              WS_GB + (size_t)M * 8192 <= WS_AB && WS_AB + (size_t)4 * M * 1024 <= WS_MB && WS_MB + (size_t)M * 2048 <= WS_PPB && WS_PPB + (size_t)M * 2048 <= WS_PB && WS_PB + (size_t)4 * M * 512 <= WS_QT &&
              WS_QT + (size_t)M * 1024 <= WS_KT && WS_KT + (size_t)M * 1024 <= WS_DS && WS_DS + (size_t)NCHUNK * 32768 <= WS_SC && WS_SC + (size_t)NCHUNK * 32768 <= WS_LAM && WS_LAM + (size_t)NCHUNK * 256 <= WS_XL && WS_XL + (size_t)M * DM * 2 <= WS_END, "ws map");
constexpr int WGM_UP = 8, WGM_IN = 8, WGM_X = 8;
constexpr float SB_CUT = 48.f;
constexpr bool USE_XL = false;
constexpr int CW_BAR = 4096;
constexpr int CW_Q = 8192;
constexpr int RING_BYTES = 131072, MISC_OFF = RING_BYTES + 320, RSTD_OFF = RING_BYTES + 2048  , LDS_BYTES = 147456;

typedef float f32x16 __attribute__((ext_vector_type(16)));
typedef short s16x4 __attribute__((ext_vector_type(4)));
typedef short v4i16_t __attribute__((ext_vector_type(4)));
typedef unsigned u32x2 __attribute__((ext_vector_type(2)));

struct Params { const float* in[32]; float* out; unsigned char* ws; };
enum { I_XP = 0, I_XS, I_PP, I_PS, I_CK, I_CV, I_SPOOL, I_SGLA, I_N1, I_F1W1, I_F1W3, I_F1W2, I_NM, I_WIN, I_POOLW, I_POOLS, I_QN, I_KN, I_GWS, I_GB, I_WA2, I_BA, I_GON, I_WBR, I_WOUT, I_N2, I_F2W1,
       I_F2W3, I_F2W2, I_NPL, I_WPG, I_WPP };


typedef const __attribute__((address_space(4))) Params* KParams;
__device__ __forceinline__ KParams params_ptr() { KParams p = (KParams)__builtin_amdgcn_kernarg_segment_ptr(); asm volatile("" : "+s"(p)); return p; }
namespace pg8 {
#define PG8_LAS __attribute__((address_space(3)))
typedef unsigned short bf16_t;
typedef short bf16x8 __attribute__((ext_vector_type(8)));
typedef float f32x4 __attribute__((ext_vector_type(4)));
typedef unsigned u32x4 __attribute__((ext_vector_type(4)));
constexpr int BM = 256, BK = 64, HALF = 128, HTB = HALF * BK * 2  , STAGE_BYTES = 8 * HTB, NXCD = 8, WGM = 8;

__host__ __device__ __forceinline__ int lds_byte(int r, int c) { const int st = (r >> 4) * 2 + (c >> 5), rr = r & 15, cc = c & 31, ob = rr * 64 + cc * 2; return st * 1024 + (ob ^ (((ob >> 9) & 1) << 5)); }
__host__ __device__ __forceinline__ void stage_rc(int b, int& R, int& C) { const int st = b / 1024, sb = b % 1024, swz = sb ^ (((sb >> 9) & 1) << 5); R = (st >> 1) * 16 + swz / 64; C = (st & 1) * 32 + (swz % 64) / 2; }
__host__ __device__ __forceinline__ int perm32(int rho) { const int n = rho >> 4, i = rho & 15; return 8 * (i >> 2) + 4 * n + (i & 3); }

struct Unit { int pm, pn, slot; };
struct Gemm { const bf16_t* A; const bf16_t* Bt; int M, N, K; };

struct StaticOrder {
    int nM, nN, nwg, G, c, wgm;
    __host__ __device__ void init(int M, int N, int G_, int c_, int wgm_ = WGM) { nM = M / BM; nN = N / BM; nwg = nM * nN; G = G_; c = c_; wgm = wgm_; }
    __host__ __device__ bool next(int i, Unit& u) const {
        const long L = (long)i * G + c; if (L >= nwg) return false;
        int wgid = (int)L; { const int q = nwg / NXCD, r = nwg % NXCD, xcd = wgid % NXCD, off = wgid / NXCD; wgid = (xcd < r ? xcd * (q + 1) : r * (q + 1) + (xcd - r) * q) + off; }
        const int nig = wgm * nN, gid = wgid / nig, fm = gid * wgm, gsz = (nM - fm) < wgm ? (nM - fm) : wgm;
        u.pm = fm + ((wgid % nig) % gsz); u.pn = (wgid % nig) / gsz; u.slot = i & 1; return true;
    }
    __device__ __forceinline__ void a_ready(const Unit&) const {}
    __device__ __forceinline__ void done(const Unit&) const {}
};

typedef float f32x2 __attribute__((ext_vector_type(2)));
typedef __bf16 bf16x2_t __attribute__((ext_vector_type(2)));
__device__ __forceinline__ unsigned cvt_pk_bf16(float lo, float hi) { const bf16x2_t r = __builtin_convertvector((f32x2){lo, hi}, bf16x2_t); return __builtin_bit_cast(unsigned, r); }
__device__ __forceinline__ float sigm(float t) { return __builtin_amdgcn_rcpf(1.0f + __builtin_amdgcn_exp2f(-1.4426950408889634f * t)); }
__device__ __forceinline__ float silu_f(float t) { return t * sigm(t); }
__device__ __forceinline__ float gelu_tanh_f(float t) { return t * sigm(1.5957691216057308f * (t + 0.044715f * t * t * t)); }
__device__ __forceinline__ f32x2 sigm_arg2(f32x2 a) { const f32x2 d = (f32x2){__builtin_amdgcn_exp2f(a[0]), __builtin_amdgcn_exp2f(a[1])} + (f32x2){1.0f, 1.0f}; return (f32x2){__builtin_amdgcn_rcpf(d[0]), __builtin_amdgcn_rcpf(d[1])}; }
__device__ __forceinline__ f32x2 silu2(f32x2 t) { return t * sigm_arg2(t * (f32x2){-1.4426950408889634f, -1.4426950408889634f}); }
__device__ __forceinline__ f32x2 gelu_tanh2(f32x2 t) { constexpr float k0 = -1.4426950408889634f * 1.5957691216057308f, k1 = k0 * 0.044715f;
    return t * sigm_arg2(t * ((t * t) * (f32x2){k1, k1} + (f32x2){k0, k0})); }
__device__ __forceinline__ float bf_lo(unsigned w) { return __uint_as_float(w << 16); }
__device__ __forceinline__ float bf_hi(unsigned w) { return __uint_as_float(w & 0xffff0000u); }
__device__ __forceinline__ float row_rstd(const float* ssq, int row) {
    const f32x4* p = (const f32x4*)(ssq + (size_t)row * 16); const f32x4 a = p[0], b = p[1], c = p[2], d = p[3];
    const float s = (((a[0] + a[1]) + (a[2] + a[3])) + ((b[0] + b[1]) + (b[2] + b[3]))) + (((c[0] + c[1]) + (c[2] + c[3])) + ((d[0] + d[1]) + (d[2] + d[3])));
    return __builtin_amdgcn_rsqf(s * (1.0f / 1024.0f) + 1e-6f);
}
struct RstdOrder : StaticOrder {
    KParams kp; int sq; PG8_LAS float* rl; mutable int nd; mutable bool started;
    __device__ __forceinline__ bool next(int i, Unit& u) const { return StaticOrder::next(i, u); }
    __device__ __forceinline__ void fill(const Unit& u) const {
        int t = threadIdx.x; asm volatile("" : "+v"(t));
        if (t < 256) { KParams q = kp; asm volatile("" : "+s"(q)); rl[u.slot * 256 + t] = row_rstd((const float*)(q->ws + (sq ? WS_SSQ1 : WS_SSQ0)), u.pm * BM + t); }
    }
    __device__ __forceinline__ void a_ready(const Unit& u) const { if (!started) { started = true; fill(u); } }
    __device__ __forceinline__ void done(const Unit&) const { ++nd; Unit n; if (next(nd, n)) fill(n); }
};
__device__ __forceinline__ u32x4 pack8(const f32x4 a, const f32x4 b) { u32x4 w; w.x = cvt_pk_bf16(a[0], a[1]); w.y = cvt_pk_bf16(a[2], a[3]); w.z = cvt_pk_bf16(b[0], b[1]); w.w = cvt_pk_bf16(b[2], b[3]); return w; }

struct EpiSwiGLU {
    static constexpr bool PERM = true, AFTER_DRAIN = false, HAS_INIT = false;
    KParams kp; const PG8_LAS float* rl;
    __device__ __forceinline__ void operator()(const f32x4 (&acc)[2][2][4][2], const Unit& u, int wr, int wc, int fr, int fq) const {
        KParams q = kp; asm volatile("" : "+s"(q)); unsigned char* ws = q->ws;
        bf16_t* H = (bf16_t*)(ws + WS_HB); const PG8_LAS float* rt = rl + u.slot * 256 + wr * 64 + fr;
        const int col0 = u.pn * 128 + wc * 32 + 8 * fq;
#pragma unroll
        for (int ai = 0; ai < 2; ++ai)
#pragma unroll
            for (int m = 0; m < 4; ++m) {
                const int row = u.pm * BM + ai * HALF + wr * 64 + m * 16 + fr; const float rs = rt[ai * HALF + m * 16]; const float cexp = -1.4426950408889634f * rs, rs2 = rs * rs;
                const f32x2 c2 = (f32x2){cexp, cexp}, r2 = (f32x2){rs2, rs2};
                f32x4 h0, h1;
#pragma unroll
                for (int n = 0; n < 2; ++n)
#pragma unroll
                    for (int p2 = 0; p2 < 2; ++p2) { const f32x4 g4 = acc[ai][0][m][n], u4 = acc[ai][1][m][n];
                        const f32x2 g = p2 ? (f32x2){g4[2], g4[3]} : (f32x2){g4[0], g4[1]}, u = p2 ? (f32x2){u4[2], u4[3]} : (f32x2){u4[0], u4[1]};
                        const f32x2 t = g * c2; f32x2 d = (f32x2){__builtin_amdgcn_exp2f(t[0]), __builtin_amdgcn_exp2f(t[1])} + (f32x2){1.0f, 1.0f};
                        const f32x2 r = (f32x2){__builtin_amdgcn_rcpf(d[0]), __builtin_amdgcn_rcpf(d[1])}; const f32x2 hh = (g * u) * (r * r2);
                        if (n == 0) { h0[2 * p2] = hh[0]; h0[2 * p2 + 1] = hh[1]; } else { h1[2 * p2] = hh[0]; h1[2 * p2 + 1] = hh[1]; } }
                *(u32x4*)(H + (size_t)row * 2816 + col0) = pack8(h0, h1);
                if (m & 1) asm volatile("" ::: "memory");
            }
    }
};

template <bool PLE> struct EpiX {
    static constexpr bool PERM = true, AFTER_DRAIN = false, HAS_INIT = false;
    static constexpr int NB = PLE ? 2 : 1, MB_ = 4 / NB;
    KParams kp; int xc_in, xc_out, sq_out; float alpha; const PG8_LAS float* rl; int fin;
    __device__ __forceinline__ void init(f32x4 (&)[2][2][4][2], const Unit&, int, int, int, int) const {}
    __device__ __forceinline__ void operator()(const f32x4 (&acc)[2][2][4][2], const Unit& u, int wr, int wc, int fr, int fq) const {
        KParams q = kp; asm volatile("" : "+s"(q)); unsigned char* ws = q->ws; float* X = q->out + O_X;
        const bf16_t* XI = (const bf16_t*)(ws + (xc_in ? WS_XB1 : WS_XB0)); bf16_t* XB = (bf16_t*)(ws + (xc_out ? WS_XB1 : WS_XB0)); bf16_t* XL = (bf16_t*)(ws + WS_XL); bf16_t* ssq_dummy = nullptr; (void)ssq_dummy;
        float* ssq_out = (float*)(ws + (sq_out ? WS_SSQ1 : WS_SSQ0));
        const bf16_t* PP = (const bf16_t*)(ws + WS_PPB);
        const size_t off0 = (size_t)(u.pm * BM + wr * 64 + fr) * 1024 + u.pn * BM + wc * 32 + 8 * fq;
#pragma unroll
        for (int ab = 0; ab < 2 * NB; ++ab) { const int ai = ab / NB, mb = (ab % NB) * MB_;
            u32x4 xh[4][2], xl[4][2], pw[4][2];
#pragma unroll
            for (int m = mb; m < mb + MB_; ++m)
#pragma unroll
                for (int bj = 0; bj < 2; ++bj) { const size_t off = off0 + (size_t)(ai * HALF + m * 16) * 1024 + bj * HALF;
                    xh[m][bj] = *(const u32x4*)(XI + off); if (USE_XL) xl[m][bj] = *(const u32x4*)(XL + off); if (PLE) pw[m][bj] = *(const u32x4*)(PP + off); }
#pragma unroll
            for (int m = mb; m < mb + MB_; ++m) {
                float s = 0.f; float rs = 0.f; if (PLE) rs = rl[u.slot * 256 + ai * HALF + wr * 64 + m * 16 + fr];
#pragma unroll
                for (int bj = 0; bj < 2; ++bj) { const size_t off = off0 + (size_t)(ai * HALF + m * 16) * 1024 + bj * HALF;
                    f32x4 a0 = acc[ai][bj][m][0], a1 = acc[ai][bj][m][1];
                    if (PLE) { const u32x4 p4 = pw[m][bj];
                        a0[0] = sigm(a0[0] * rs) * bf_lo(p4.x); a0[1] = sigm(a0[1] * rs) * bf_hi(p4.x); a0[2] = sigm(a0[2] * rs) * bf_lo(p4.y); a0[3] = sigm(a0[3] * rs) * bf_hi(p4.y);
                        a1[0] = sigm(a1[0] * rs) * bf_lo(p4.z); a1[1] = sigm(a1[1] * rs) * bf_hi(p4.z); a1[2] = sigm(a1[2] * rs) * bf_lo(p4.w); a1[3] = sigm(a1[3] * rs) * bf_hi(p4.w);
#if PROBE_DUP & 8192
                        a0 = a0 * alpha; a1 = a1 * alpha;
#endif
                    } else { a0 = a0 * alpha; a1 = a1 * alpha; }
                    const u32x4 h4 = xh[m][bj]; u32x4 l4 = (u32x4){0u, 0u, 0u, 0u}; if (USE_XL) l4 = xl[m][bj];
                    const f32x4 x0 = (f32x4){bf_lo(h4.x) + bf_lo(l4.x), bf_hi(h4.x) + bf_hi(l4.x), bf_lo(h4.y) + bf_lo(l4.y), bf_hi(h4.y) + bf_hi(l4.y)} + a0;
                    const f32x4 x1 = (f32x4){bf_lo(h4.z) + bf_lo(l4.z), bf_hi(h4.z) + bf_hi(l4.z), bf_lo(h4.w) + bf_lo(l4.w), bf_hi(h4.w) + bf_hi(l4.w)} + a1;
                    const u32x4 hw = pack8(x0, x1);
                    const f32x4 r0 = x0 - (f32x4){bf_lo(hw.x), bf_hi(hw.x), bf_lo(hw.y), bf_hi(hw.y)}, r1 = x1 - (f32x4){bf_lo(hw.z), bf_hi(hw.z), bf_lo(hw.w), bf_hi(hw.w)};
                    *(u32x4*)(XB + off) = hw; if (USE_XL) *(u32x4*)(XL + off) = pack8(r0, r1);
                    if (fin) { *(f32x4*)(X + off) = x0; *(f32x4*)(X + off + 4) = x1; }
                    s += ((x0[0] * x0[0] + x0[1] * x0[1]) + (x0[2] * x0[2] + x0[3] * x0[3])) + ((x1[0] * x1[0] + x1[1] * x1[1]) + (x1[2] * x1[2] + x1[3] * x1[3]));
                }
                s += __shfl_xor(s, 16); s += __shfl_xor(s, 32);
                if (fq == 0) ssq_out[(size_t)(u.pm * BM + ai * HALF + wr * 64 + m * 16 + fr) * 16 + u.pn * 4 + wc] = s;
            }
            asm volatile("" ::: "memory");
        }
    }
};

struct EpiIn {
    static constexpr bool PERM = true, AFTER_DRAIN = false, HAS_INIT = false;
    KParams kp; int L; const PG8_LAS float* rl;
    __device__ __forceinline__ void operator()(const f32x4 (&acc)[2][2][4][2], const Unit& u, int wr, int wc, int fr, int fq) const {
        KParams q = kp; asm volatile("" : "+s"(q)); unsigned char* ws = q->ws; float* out = q->out;
        const PG8_LAS float* rt = rl + u.slot * 256 + wr * 64 + fr;
        const int t = u.pn; const bool samp = u.pm >= 128;
        if (t >= 2 && t < 6) {
            const bool isk = t >= 4; const float* gn = q->in[isk ? I_KN : I_QN] + L * 64; bf16_t* dst = (bf16_t*)(ws + (isk ? WS_KB : WS_QB));
            float* fo = isk ? (samp ? out + O_KS + (size_t)L * MS * 512 - (size_t)32768 * 512 : out + O_KP + (size_t)L * MP * 512) : nullptr;
            const float sc = isk ? 1.0f : 0.125f * 1.4426950408889634f;
            f32x4 g[2][2];
#pragma unroll
            for (int bj = 0; bj < 2; ++bj)
#pragma unroll
                for (int n = 0; n < 2; ++n) g[bj][n] = *(const f32x4*)(gn + 32 * bj + 8 * fq + 4 * n) * sc;
            const int hcol = (4 * (t & 1) + wc) * 64 + 8 * fq;
#pragma unroll
            for (int ai = 0; ai < 2; ++ai)
#pragma unroll
                for (int m = 0; m < 4; ++m) {
                    const int row = u.pm * BM + ai * HALF + wr * 64 + m * 16 + fr; const float rs = rt[ai * HALF + m * 16];
                    f32x4 v[2][2]; float ss = 0.f;
#pragma unroll
                    for (int bj = 0; bj < 2; ++bj)
#pragma unroll
                        for (int n = 0; n < 2; ++n) { v[bj][n] = acc[ai][bj][m][n] * rs; ss += (v[bj][n][0] * v[bj][n][0] + v[bj][n][1] * v[bj][n][1]) + (v[bj][n][2] * v[bj][n][2] + v[bj][n][3] * v[bj][n][3]); }
                    ss += __shfl_xor(ss, 16); ss += __shfl_xor(ss, 32);
                    const float hr = __builtin_amdgcn_rsqf(ss * (1.0f / 64.0f) + 1e-6f);
#pragma unroll
                    for (int bj = 0; bj < 2; ++bj) { const f32x4 o0 = v[bj][0] * hr * g[bj][0], o1 = v[bj][1] * hr * g[bj][1];
                        const size_t off = (size_t)row * 512 + hcol + 32 * bj;
                        *(u32x4*)(dst + off) = pack8(o0, o1);
                        if (fo) { __builtin_nontemporal_store(o0, (f32x4*)(fo + off)); __builtin_nontemporal_store(o1, (f32x4*)(fo + off + 4)); }   }
                    asm volatile("" ::: "memory");
                }
            return;
        }
        if (t >= 18 && t < 34) {
            unsigned char* g8 = ws + WS_GB + (size_t)(256 * (t - 18)) + wc * 32 + 8 * fq;
#pragma unroll
            for (int ai = 0; ai < 2; ++ai)
#pragma unroll
                for (int m = 0; m < 4; ++m) {
                    const int row = u.pm * BM + ai * HALF + wr * 64 + m * 16 + fr; const float cexp = -1.4426950408889634f * rt[ai * HALF + m * 16];
#pragma unroll
                    for (int bj = 0; bj < 2; ++bj) { unsigned w0 = 0u, w1 = 0u;
#pragma unroll
                        for (int n = 0; n < 2; ++n)
#pragma unroll
                            for (int p2 = 0; p2 < 2; ++p2) {
                                const f32x4 a4 = acc[ai][bj][m][n]; const f32x2 a = p2 ? (f32x2){a4[2], a4[3]} : (f32x2){a4[0], a4[1]};
                                const f32x2 tt = a * (f32x2){cexp, cexp}; const f32x2 e = (f32x2){__builtin_amdgcn_exp2f(tt[0]), __builtin_amdgcn_exp2f(tt[1])};
                                const f32x2 d = e * (f32x2){1.0f / 255.0f, 1.0f / 255.0f} + (f32x2){1.0f / 255.0f, 1.0f / 255.0f};
                                const float y0 = __builtin_amdgcn_rcpf(d[0]), y1 = __builtin_amdgcn_rcpf(d[1]);
                                if (n == 0) { w0 = __builtin_amdgcn_cvt_pk_u8_f32(y0, 2 * p2, w0); w0 = __builtin_amdgcn_cvt_pk_u8_f32(y1, 2 * p2 + 1, w0); }
                                else { w1 = __builtin_amdgcn_cvt_pk_u8_f32(y0, 2 * p2, w1); w1 = __builtin_amdgcn_cvt_pk_u8_f32(y1, 2 * p2 + 1, w1); } }
                        typedef unsigned u32x2e __attribute__((ext_vector_type(2)));
                        __builtin_nontemporal_store((u32x2e){w0, w1}, (u32x2e*)(g8 + (size_t)row * 4096 + bj * HALF)); }
                    asm volatile("" ::: "memory");
                }
            return;
        }
        bf16_t* dst; int ld, dcol, act = 0; float* fo = nullptr;
        size_t wo;
        if (t < 2) { wo = WS_XPB; ld = 512; dcol = 256 * t; }
        else if (t < 8) { wo = WS_VB; ld = 512; dcol = 256 * (t - 6); fo = samp ? out + O_VS + (size_t)L * MS * 512 - (size_t)32768 * 512 : out + O_VP + (size_t)L * MP * 512; }
        else if (t < 10) { wo = WS_GUB; ld = 512; dcol = 256 * (t - 8); act = 1; }
        else if (t < 12) { wo = WS_GVB; ld = 512; dcol = 256 * (t - 10); act = 1; fo = samp ? out + O_GVS + (size_t)L * MS * 512 - (size_t)32768 * 512 : nullptr; }
        else if (t == 12) { wo = WS_LQB; ld = 256; dcol = 0; }
        else if (t == 13) { wo = WS_LKB; ld = 256; dcol = 0; }
        else if (t < 16) { wo = WS_LVB; ld = 512; dcol = 256 * (t - 14); }
        else if (t < 18) { wo = WS_LRB; ld = 512; dcol = 256 * (t - 16); act = 2; }
        else { wo = WS_LAB; ld = 256; dcol = 0; }
        dst = (bf16_t*)(ws + wo);
#pragma unroll
        for (int ai = 0; ai < 2; ++ai)
#pragma unroll
            for (int m = 0; m < 4; ++m) {
                const int row = u.pm * BM + ai * HALF + wr * 64 + m * 16 + fr; const float rs = rt[ai * HALF + m * 16];
#pragma unroll
                for (int bj = 0; bj < 2; ++bj) {
                    f32x4 v0 = acc[ai][bj][m][0] * rs, v1 = acc[ai][bj][m][1] * rs;
                    if (act == 1) {
#pragma unroll
                        for (int j = 0; j < 4; j += 2) { const f32x2 a = gelu_tanh2((f32x2){v0[j], v0[j + 1]}), b = gelu_tanh2((f32x2){v1[j], v1[j + 1]}); v0[j] = a[0]; v0[j + 1] = a[1]; v1[j] = b[0]; v1[j + 1] = b[1]; }
                    } else if (act == 2) {
#pragma unroll
                        for (int j = 0; j < 4; j += 2) { const f32x2 a = silu2((f32x2){v0[j], v0[j + 1]}), b = silu2((f32x2){v1[j], v1[j + 1]}); v0[j] = a[0]; v0[j + 1] = a[1]; v1[j] = b[0]; v1[j + 1] = b[1]; }
                    }
                    const int col = dcol + bj * HALF + wc * 32 + 8 * fq;
                    __builtin_nontemporal_store(pack8(v0, v1), (u32x4*)(dst + (size_t)row * ld + col));
                    if (fo) { float* f = fo + (size_t)row * 512 + col; __builtin_nontemporal_store(v0, (f32x4*)f); __builtin_nontemporal_store(v1, (f32x4*)(f + 4)); }
                }
                if (m & 1) asm volatile("" ::: "memory");
            }
    }
};

struct EpiBranch {
    static constexpr bool PERM = true, AFTER_DRAIN = false, HAS_INIT = true;
    KParams kp;
    __device__ __forceinline__ void init(f32x4 (&acc)[2][2][4][2], const Unit& u, int, int, int, int) const {
        if (u.pm < 130) {
#pragma unroll
            for (int a = 0; a < 2; ++a)
#pragma unroll
                for (int b = 0; b < 2; ++b)
#pragma unroll
                    for (int m = 0; m < 4; ++m)
#pragma unroll
                        for (int n = 0; n < 2; ++n) acc[a][b][m][n] = (f32x4){0.f, 0.f, 0.f, 0.f};
        }
    }
    __device__ __forceinline__ void operator()(const f32x4 (&acc_)[2][2][4][2], const Unit& u, int wr, int wc, int fr, int fq) const {
        f32x4 (&acc)[2][2][4][2] = const_cast<f32x4 (&)[2][2][4][2]>(acc_);
        KParams q = kp; asm volatile("" : "+s"(q)); unsigned char* ws = q->ws; const unsigned char* G = ws + WS_GB; bf16_t* MB = (bf16_t*)(ws + WS_MB);
        const int b = u.pm / 130, pm = u.pm - b * 130, pn = u.pn & 3;
        const int row0 = pm * BM + wr * 64 + fr, col0 = pn * BM + wc * 32 + 8 * fq;
        typedef unsigned u32x2e __attribute__((ext_vector_type(2)));
#pragma unroll
        for (int ab = 0; ab < 2; ++ab) { const int ai = ab;
            u32x2e gw[4][2], gn[4][2];
#pragma unroll
            for (int m = 0; m < 4; ++m)
#pragma unroll
                for (int bj = 0; bj < 2; ++bj) { const int row = row0 + ai * HALF + m * 16, col = col0 + bj * HALF;
                    gw[m][bj] = *(const u32x2e*)(G + (size_t)row * 4096 + b * 1024 + col); if (b < 3) gn[m][bj] = *(const u32x2e*)(G + (size_t)row * 4096 + (b + 1) * 1024 + col); }
#pragma unroll
            for (int m = 0; m < 4; ++m)
#pragma unroll
                for (int bj = 0; bj < 2; ++bj) { const int row = row0 + ai * HALF + m * 16, col = col0 + bj * HALF; const u32x2e g2 = gw[m][bj];
                    float f[8] = {(float)(g2.x & 255u), (float)((g2.x >> 8) & 255u), (float)((g2.x >> 16) & 255u), (float)(g2.x >> 24), (float)(g2.y & 255u), (float)((g2.y >> 8) & 255u), (float)((g2.y >> 16) & 255u), (float)(g2.y >> 24)};
#pragma unroll
                    for (int j = 0; j < 8; ++j) f[j] = f[j] > 1.0f ? f[j] : 1.0f;
                    if (b < 3) { const u32x2e n2 = gn[m][bj]; const float d[8] = {(float)(n2.x & 255u), (float)((n2.x >> 8) & 255u), (float)((n2.x >> 16) & 255u), (float)(n2.x >> 24), (float)(n2.y & 255u), (float)((n2.y >> 8) & 255u), (float)((n2.y >> 16) & 255u), (float)(n2.y >> 24)};
#pragma unroll
                        for (int j = 0; j < 8; ++j) f[j] *= __builtin_amdgcn_rcpf(d[j] > 1.0f ? d[j] : 1.0f); }
                    else {
#pragma unroll
                        for (int j = 0; j < 8; ++j) f[j] *= (1.0f / 255.0f); }
                    f32x4 v0 = acc[ai][bj][m][0], v1 = acc[ai][bj][m][1];
                    v0[0] *= f[0]; v0[1] *= f[1]; v0[2] *= f[2]; v0[3] *= f[3]; v1[0] *= f[4]; v1[1] *= f[5]; v1[2] *= f[6]; v1[3] *= f[7];
                    if (b < 3) { acc[ai][bj][m][0] = v0; acc[ai][bj][m][1] = v1; }
                    else *(u32x4*)(MB + (size_t)row * 1024 + col) = pack8(v0, v1); }
            asm volatile("" ::: "memory");
        }
    }
};
struct BranchOrder {
    int G, c;
    __device__ __forceinline__ bool next(int i, Unit& u) const { const int tl = (i >> 2) * G + c; if (tl >= 512) return false;   const int b = i & 3; u.pm = b * 130 + (tl >> 2); u.pn = b * 4 + (tl & 3); u.slot = 0; return true; }
    __device__ __forceinline__ void a_ready(const Unit&) const {}
    __device__ __forceinline__ void done(const Unit&) const {}
};
struct EpiPlain {
    static constexpr bool PERM = true, AFTER_DRAIN = false, HAS_INIT = false;
    KParams kp;
    __device__ __forceinline__ void operator()(const f32x4 (&acc)[2][2][4][2], const Unit& u, int wr, int wc, int fr, int fq) const {
        KParams q = kp; asm volatile("" : "+s"(q)); bf16_t* O = (bf16_t*)(q->ws + WS_PPB); const int ldc = 1024;
#pragma unroll
        for (int ai = 0; ai < 2; ++ai)
#pragma unroll
            for (int m = 0; m < 4; ++m) {
                const int row = u.pm * BM + ai * HALF + wr * 64 + m * 16 + fr;
#pragma unroll
                for (int bj = 0; bj < 2; ++bj) *(u32x4*)(O + (size_t)row * ldc + u.pn * BM + bj * HALF + wc * 32 + 8 * fq) = pack8(acc[ai][bj][m][0], acc[ai][bj][m][1]);
            }
    }
};
template <class Epi, class Sched, bool ALIGN_EPI = false, bool SP2 = false>
__device__ __forceinline__ void gemm_phase(PG8_LAS unsigned char* lds, const Gemm g, const Sched& S, const Epi& E) {
    int tid = threadIdx.x; asm volatile("" : "+v"(tid));
    const int wid = __builtin_amdgcn_readfirstlane(tid >> 6), lane = tid & 63, wr = wid >> 2, wc = wid & 3, fr = lane & 15, fq = lane >> 4;
    int K = g.K; asm volatile("" : "+s"(K)); const int nt = K / BK;
    unsigned voffA[2], voffB[2];
#pragma unroll
    for (int i = 0; i < 2; ++i) { int R, C; stage_rc(tid * 16 + i * 8192, R, C); const int Rb = Epi::PERM ? ((R & ~31) + perm32(R & 31)) : R;
        voffA[i] = (unsigned)(R * K + C) * 2u; voffB[i] = (unsigned)(Rb * K + C) * 2u; }
    const size_t kstep = (size_t)(BK * 2);
    const size_t hstep = (size_t)HALF * K * 2;
    const size_t tstep = 2 * hstep;
    const unsigned ldsw = (unsigned)wid * 1024u;
    const int aoff = lds_byte(wr * 64 + fr, fq * 8), boff = lds_byte(wc * 32 + fr, fq * 8);
#define PG8_SA(b, h) (((b) * 2 + (h)) * HTB)
#define PG8_SB(b, h) ((4 + (b) * 2 + (h)) * HTB)
#define PG8_STAGE(bufoff, gbase, voff) do { _Pragma("unroll") for (int _i = 0; _i < 2; ++_i) \
        __builtin_amdgcn_global_load_lds((const unsigned*)((const char*)(gbase) + (voff)[_i]), (PG8_LAS unsigned*)(lds + (bufoff) + ldsw + _i * 8192), 16, 0, 0); } while (0)
#define PG8_LDA(dst, b, h) do { _Pragma("unroll") for (int m = 0; m < 4; ++m) _Pragma("unroll") for (int k = 0; k < 2; ++k) dst[m][k] = *(const PG8_LAS bf16x8*)(lds + PG8_SA(b, h) + aoff + m * 2048 + k * 1024); } while (0)
#define PG8_LDB(dst, b, h) do { _Pragma("unroll") for (int n = 0; n < 2; ++n) _Pragma("unroll") for (int k = 0; k < 2; ++k) dst[n][k] = *(const PG8_LAS bf16x8*)(lds + PG8_SB(b, h) + boff + n * 2048 + k * 1024); } while (0)
#define PG8_MMA(ai, bj, At, Bt) do { __builtin_amdgcn_s_setprio(1); _Pragma("unroll") for (int m = 0; m < 4; ++m) _Pragma("unroll") for (int n = 0; n < 2; ++n) _Pragma("unroll") for (int k = 0; k < 2; ++k) \
        acc[ai][bj][m][n] = __builtin_amdgcn_mfma_f32_16x16x32_bf16(Bt[n][k], At[m][k], acc[ai][bj][m][n], 0, 0, 0); __builtin_amdgcn_s_setprio(0); } while (0)
#define PG8_WAIT_V(n) asm volatile("s_waitcnt vmcnt(" #n ")" ::: "memory")
#define PG8_WAIT_L(n) asm volatile("s_waitcnt lgkmcnt(" #n ")" ::: "memory")
#define PG8_BAR __builtin_amdgcn_s_barrier()
#define PG8_SCHED __builtin_amdgcn_sched_barrier(0)
    Unit cur, nxt; int ui = 0;
    if (!S.next(0, cur)) return;
    f32x4 acc[2][2][4][2];
    if constexpr (Epi::HAS_INIT) E.init(acc, cur, wr, wc, fr, fq);
    else {
#pragma unroll
    for (int a = 0; a < 2; ++a)
#pragma unroll
        for (int b = 0; b < 2; ++b)
#pragma unroll
            for (int m = 0; m < 4; ++m)
#pragma unroll
                for (int n = 0; n < 2; ++n) acc[a][b][m][n] = (f32x4){0.f, 0.f, 0.f, 0.f};
    }
    bf16x8 At[4][2], B0[2][2], B1[2][2];
    const char* cA = (const char*)g.A + (size_t)cur.pm * tstep; const char* cB = (const char*)g.Bt + (size_t)cur.pn * tstep;
    S.a_ready(cur);
    if constexpr (SP2) {
        PG8_STAGE(PG8_SB(0, 0), cB, voffB); PG8_STAGE(PG8_SB(0, 1), cB + hstep, voffB); PG8_STAGE(PG8_SA(0, 0), cA, voffA); PG8_STAGE(PG8_SA(0, 1), cA + hstep, voffA);
        if (wr == 1) PG8_BAR;
        PG8_WAIT_V(2); PG8_BAR;
        PG8_STAGE(PG8_SB(1, 0), cB + kstep, voffB); PG8_STAGE(PG8_SA(1, 0), cA + kstep, voffA); PG8_STAGE(PG8_SB(1, 1), cB + hstep + kstep, voffB);
        PG8_WAIT_V(6); PG8_BAR;
    } else {
        PG8_STAGE(PG8_SB(0, 0), cB, voffB); PG8_STAGE(PG8_SA(0, 0), cA, voffA); PG8_STAGE(PG8_SB(0, 1), cB + hstep, voffB); PG8_STAGE(PG8_SA(0, 1), cA + hstep, voffA);
        if (wr == 1) PG8_BAR;
        PG8_WAIT_V(4); PG8_BAR;
        PG8_STAGE(PG8_SB(1, 0), cB + kstep, voffB); PG8_STAGE(PG8_SA(1, 0), cA + kstep, voffA); PG8_STAGE(PG8_SB(1, 1), cB + hstep + kstep, voffB);
        PG8_WAIT_V(6); PG8_BAR;
    }
    for (;;) {
        const bool has_next = S.next(ui + 1, nxt);
        const char* nA = has_next ? (const char*)g.A + (size_t)nxt.pm * tstep : cA; const char* nB = has_next ? (const char*)g.Bt + (size_t)nxt.pn * tstep : cB;
        for (int t = 0; t < nt; t += 2) {
            const bool last = (t == nt - 2);
            const char* a1 = cA + (size_t)(t + 1) * kstep;
            const char* a2 = last ? nA : cA + (size_t)(t + 2) * kstep; const char* b2 = last ? nB : cB + (size_t)(t + 2) * kstep;
            const char* a3 = a2 + kstep; const char* b3 = b2 + kstep;
            if (last && has_next) S.a_ready(nxt);
            if constexpr (SP2) {
            PG8_LDB(B0, 0, 0); PG8_LDB(B1, 0, 1); PG8_SCHED; PG8_LDA(At, 0, 0); PG8_STAGE(PG8_SA(1, 1), a1 + hstep, voffA);
            PG8_WAIT_V(8); PG8_WAIT_L(0); PG8_BAR; PG8_MMA(0, 0, At, B0); PG8_MMA(0, 1, At, B1); PG8_BAR; PG8_SCHED;
            PG8_LDA(At, 0, 1); PG8_STAGE(PG8_SB(0, 0), b2, voffB); PG8_STAGE(PG8_SB(0, 1), b2 + hstep, voffB); PG8_STAGE(PG8_SA(0, 0), a2, voffA);
            PG8_WAIT_V(8); PG8_WAIT_L(0); PG8_BAR; PG8_MMA(1, 0, At, B0); PG8_MMA(1, 1, At, B1); PG8_BAR; PG8_SCHED;
            PG8_LDB(B0, 1, 0); PG8_LDB(B1, 1, 1); PG8_SCHED; PG8_LDA(At, 1, 0); PG8_STAGE(PG8_SA(0, 1), a2 + hstep, voffA);
            PG8_WAIT_V(8); PG8_WAIT_L(0); PG8_BAR; PG8_MMA(0, 0, At, B0); PG8_MMA(0, 1, At, B1); PG8_BAR; PG8_SCHED;
            PG8_LDA(At, 1, 1); PG8_STAGE(PG8_SB(1, 0), b3, voffB); PG8_STAGE(PG8_SB(1, 1), b3 + hstep, voffB); PG8_STAGE(PG8_SA(1, 0), a3, voffA);
            PG8_WAIT_V(8); PG8_WAIT_L(0); PG8_BAR; PG8_MMA(1, 0, At, B0); PG8_MMA(1, 1, At, B1); PG8_BAR; PG8_SCHED;
            } else {
            PG8_LDB(B0, 0, 0); PG8_SCHED; PG8_LDA(At, 0, 0); PG8_STAGE(PG8_SA(1, 1), a1 + hstep, voffA);
            PG8_WAIT_L(8); PG8_BAR; PG8_WAIT_L(0); PG8_MMA(0, 0, At, B0); PG8_BAR; PG8_SCHED;
            PG8_LDB(B1, 0, 1); PG8_STAGE(PG8_SB(0, 0), b2, voffB);
            PG8_BAR; PG8_WAIT_L(0); PG8_MMA(0, 1, At, B1); PG8_BAR;
            PG8_LDA(At, 0, 1); PG8_STAGE(PG8_SA(0, 0), a2, voffA);
            PG8_BAR; PG8_WAIT_L(0); PG8_MMA(1, 0, At, B0); PG8_BAR; PG8_SCHED;
            PG8_STAGE(PG8_SB(0, 1), b2 + hstep, voffB);
            PG8_WAIT_V(6); PG8_BAR; PG8_MMA(1, 1, At, B1); PG8_BAR;
            PG8_LDB(B0, 1, 0); PG8_SCHED; PG8_LDA(At, 1, 0); PG8_STAGE(PG8_SA(0, 1), a2 + hstep, voffA);
            PG8_WAIT_L(8); PG8_BAR; PG8_WAIT_L(0); PG8_MMA(0, 0, At, B0); PG8_BAR; PG8_SCHED;
            PG8_LDB(B1, 1, 1); PG8_STAGE(PG8_SB(1, 0), b3, voffB);
            PG8_BAR; PG8_WAIT_L(0); PG8_MMA(0, 1, At, B1); PG8_BAR;
            PG8_LDA(At, 1, 1); PG8_STAGE(PG8_SA(1, 0), a3, voffA);
            PG8_BAR; PG8_WAIT_L(0); PG8_MMA(1, 0, At, B0); PG8_BAR; PG8_SCHED;
            PG8_STAGE(PG8_SB(1, 1), b3 + hstep, voffB);
            PG8_WAIT_V(6); PG8_BAR; PG8_MMA(1, 1, At, B1); PG8_BAR;
            }
        }
        if constexpr (ALIGN_EPI) { if (wr == 0) PG8_BAR; }
        if constexpr (!Epi::AFTER_DRAIN) { E(acc, cur, wr, wc, fr, fq); S.done(cur); }
        if (!has_next) break;
        if constexpr (Epi::HAS_INIT) E.init(acc, nxt, wr, wc, fr, fq);
        else {
#pragma unroll
        for (int a = 0; a < 2; ++a)
#pragma unroll
            for (int b = 0; b < 2; ++b)
#pragma unroll
                for (int m = 0; m < 4; ++m)
#pragma unroll
                    for (int n = 0; n < 2; ++n) acc[a][b][m][n] = (f32x4){0.f, 0.f, 0.f, 0.f};
        }
        cur = nxt; cA = nA; cB = nB; ++ui;
        if constexpr (ALIGN_EPI) { if (wr == 1) PG8_BAR; }
    }
    PG8_WAIT_V(0);
    if constexpr (!ALIGN_EPI) { if (wr == 0) PG8_BAR; }
    PG8_BAR;
    if constexpr (Epi::AFTER_DRAIN) { E.fused(acc, cur, wr, wc, fr, fq, lds, wid, lane); S.done(cur); }
#undef PG8_SA
#undef PG8_SB
#undef PG8_STAGE
#undef PG8_LDA
#undef PG8_LDB
#undef PG8_MMA
#undef PG8_WAIT_V
#undef PG8_WAIT_L
#undef PG8_BAR
#undef PG8_SCHED
}
}
typedef unsigned v4u __attribute__((ext_vector_type(4)));
typedef float f32x4 __attribute__((ext_vector_type(4)));
typedef short bf16x8 __attribute__((ext_vector_type(8)));
typedef GAS unsigned gu32;
typedef GAS unsigned long long gu64;
#define RLX_AGENT __ATOMIC_RELAXED, __HIP_MEMORY_SCOPE_AGENT
#define LDS_WAIT() asm volatile("s_waitcnt lgkmcnt(0)" ::: "memory")
#define VM_WAIT() asm volatile("s_waitcnt vmcnt(0)" ::: "memory")
__device__ __forceinline__ unsigned long long rt() { return __builtin_amdgcn_s_memrealtime(); }
__device__ __forceinline__ unsigned f2bf(float f) { unsigned u = __builtin_bit_cast(unsigned, f); return (u + 0x7fffu + ((u >> 16) & 1u)) >> 16; }
__device__ __forceinline__ unsigned pk2(float lo, float hi) { return f2bf(lo) | (f2bf(hi) << 16); }

#define XB_TMO      128
#define XB_XCNT(j)  (256  + 64 * (j))
#define XB_XSUB(j)  (1280 + 64 * (j))
#define XB_XGEN(j)  (2304 + 64 * (j))
#define XB_TOP      3328
#define XB_TOPGEN   3392
#define XCD_BAR_WORDS 3456
#define XB_SPIN_CAP (1u << 18)

__device__ __forceinline__ unsigned xb_ld(unsigned* p)              { return __hip_atomic_load(p, __ATOMIC_RELAXED, __HIP_MEMORY_SCOPE_AGENT); }
__device__ __forceinline__ unsigned xb_add(unsigned* p, unsigned v) { return __hip_atomic_fetch_add(p, v, __ATOMIC_RELAXED, __HIP_MEMORY_SCOPE_AGENT); }
__device__ __forceinline__ unsigned xb_xcc_id() { return (unsigned)__builtin_amdgcn_s_getreg((3 << 11) | 20) & 0xFu; }
#define XB_SPIN(cond, bar) do { unsigned _sp = 0; while (cond) { __builtin_amdgcn_s_sleep(1); \
    if ((++_sp & 255u) == 0u) { if (xb_ld(&(bar)[XB_TMO])) break; if (_sp > XB_SPIN_CAP) { atomicAdd(&(bar)[XB_TMO], 1u); break; } } } } while (0)

struct XcdBarrier {
    unsigned* bar; unsigned x;
    volatile LAS unsigned* st;
};

__device__ __forceinline__ XcdBarrier xcd_barrier_post(unsigned* bar, volatile LAS unsigned* st) {
    XcdBarrier b; b.bar = bar; b.x = xb_xcc_id(); b.st = st;
    if (threadIdx.x == 0) (void)xb_add(&bar[XB_XCNT(b.x)], 1u);
    return b;
}
__device__ __forceinline__ void xcd_barrier_complete(unsigned* bar, unsigned x, unsigned& nloc, unsigned& nx) {
    const unsigned G = gridDim.x * gridDim.y * gridDim.z;
    unsigned sum, cnt, mine, sp = 0u;
    for (;;) {
        sum = 0u; cnt = 0u; mine = 0u;
#pragma unroll
        for (unsigned j = 0; j < 16; ++j) { const unsigned c = xb_ld(&bar[XB_XCNT(j)]); sum += c; cnt += (c > 0u) ? 1u : 0u; mine = (j == x) ? c : mine; }
        if (sum == G) break;
        __builtin_amdgcn_s_sleep(1);
        if ((++sp & 255u) == 0u) { if (xb_ld(&bar[XB_TMO])) break; if (sp > XB_SPIN_CAP) { atomicAdd(&bar[XB_TMO], 1u); break; } }
    }
    nloc = mine > 0u ? mine : 1u; nx = cnt > 0u ? cnt : 1u;
}

__device__ __forceinline__ void xcd_barrier(const XcdBarrier& b) {
    asm volatile("s_waitcnt vmcnt(0)" ::: "memory");
    __syncthreads();
    if (threadIdx.x == 0) {
        unsigned* bar = b.bar;
        __builtin_amdgcn_s_waitcnt(0);
        unsigned nloc = b.st[0], nx = b.st[1];
        if (nloc == 0u) { xcd_barrier_complete(bar, b.x, nloc, nx); b.st[0] = nloc; b.st[1] = nx; }
        const unsigned old = xb_add(&bar[XB_XSUB(b.x)], 1u);
        const unsigned gen = old / nloc;
        if (old + 1u == (gen + 1u) * nloc) {
            __builtin_amdgcn_fence(__ATOMIC_RELEASE, "agent");
            asm volatile("s_waitcnt vmcnt(0)" ::: "memory");
            const unsigned og = xb_add(&bar[XB_TOP], 1u);
            const unsigned tg = og / nx;
            if (og + 1u == (tg + 1u) * nx) xb_add(&bar[XB_TOPGEN], 1u);
            else XB_SPIN(xb_ld(&bar[XB_TOPGEN]) == tg, bar);
            __builtin_amdgcn_fence(__ATOMIC_ACQUIRE, "agent");
            xb_add(&bar[XB_XGEN(b.x)], 1u);
            asm volatile("s_waitcnt vmcnt(0)" ::: "memory");
        } else {
            XB_SPIN(xb_ld(&bar[XB_XGEN(b.x)]) == gen, bar);
            __builtin_amdgcn_fence(__ATOMIC_ACQUIRE, "agent");
            asm volatile("s_waitcnt vmcnt(0)" ::: "memory");
        }
    }
    __syncthreads();
}
__device__ __forceinline__ float wave_sum(float v) {
#pragma unroll
    for (int o = 1; o < 64; o <<= 1) v += __shfl_xor(v, o);
    return v;
}
__device__ __forceinline__ int crow(int r, int hi) { return (r & 3) + 8 * (r >> 2) + 4 * hi; }
__device__ __forceinline__ s16x4 vtr(const LAS unsigned char* p) { return __builtin_bit_cast(s16x4, __builtin_amdgcn_ds_read_tr16_b64_v4i16((LAS v4i16_t*)p)); }
__device__ __forceinline__ unsigned cvtpk(float lo, float hi) { return pg8::cvt_pk_bf16(lo, hi); }
__device__ __forceinline__ float bflo(unsigned w) { return __uint_as_float(w << 16); }
__device__ __forceinline__ float bfhi(unsigned w) { return __uint_as_float(w & 0xffff0000u); }
__device__ __forceinline__ float bf1(bf16 h) { return __uint_as_float((unsigned)h << 16); }

struct TrItem { const float* src; const float* gain; bf16* dst; int ldsrc, nvalid, K; };
__device__ __forceinline__ void tr_load(const TrItem& t, float (&tv)[32], int lane) {
    const bool ok = (lane & 31) < t.nvalid;
#pragma unroll
    for (int i = 0; i < 32; ++i) { const int kk = 2 * i + (lane >> 5); tv[i] = ok ? t.src[(size_t)kk * t.ldsrc + (lane & 31)] : 0.f; }
    if (t.gain) {
#pragma unroll
        for (int i = 0; i < 32; ++i) tv[i] *= t.gain[2 * i + (lane >> 5)]; }
}
__device__ __forceinline__ void tr_store(const TrItem& t, const float (&tv)[32], LAS float* scr, int lane) {
#pragma unroll
    for (int i = 0; i < 32; ++i) scr[(2 * i + (lane >> 5)) * 33 + (lane & 31)] = tv[i];
    LDS_WAIT(); asm volatile("" ::: "memory");
    const int c = lane & 7;
#pragma unroll
    for (int j = 0; j < 4; ++j) { const int n = (lane >> 3) + 8 * j; const LAS float* s = scr + (8 * c) * 33 + n;
        v4u o; o.x = cvtpk(s[0 * 33], s[1 * 33]); o.y = cvtpk(s[2 * 33], s[3 * 33]); o.z = cvtpk(s[4 * 33], s[5 * 33]); o.w = cvtpk(s[6 * 33], s[7 * 33]);
        *(GAS v4u*)(t.dst + (size_t)n * t.K + 8 * c) = o; }
    LDS_WAIT(); asm volatile("" ::: "memory");
}
__device__ __forceinline__ TrItem tr_make(const float* W, int ldsrc, int col0, int nvalid, const float* gain, int K, bf16* dest, int n0, int kb) {
    TrItem t; t.src = W + (size_t)(64 * kb) * ldsrc + col0; t.gain = gain ? gain + 64 * kb : nullptr; t.dst = dest + (size_t)n0 * K + 64 * kb; t.ldsrc = ldsrc; t.nvalid = nvalid; t.K = K; return t;
}
__device__ __forceinline__ int win_src_col(int n0, int& nvalid) {
    const int t = n0 >> 8, j0 = n0 & 255; nvalid = 32;
    if (t < 2) return 256 * t + j0;
    if (t < 6) { const int base = t < 4 ? 512 : 1024, wc = (j0 & 127) >> 5, bj = j0 >> 7; return base + (4 * (t & 1) + wc) * 64 + 32 * bj; }
    if (t < 8) return 1536 + 256 * (t - 6) + j0;
    if (t < 10) return 2048 + 256 * (t - 8) + j0;
    if (t < 12) return 2560 + 256 * (t - 10) + j0;
    if (t == 12) return 3072 + j0;
    if (t == 13) return 3328 + j0;
    if (t < 16) return 3584 + 256 * (t - 14) + j0;
    if (t < 18) return 4112 + 256 * (t - 16) + j0;
    if (t < 34) return 4624 + 256 * (t - 18) + j0;
    nvalid = (j0 == 0) ? 16 : 0; return 4096;
}
__device__ __forceinline__ void prologue(LAS unsigned char* lds, int gw, int NGW, int wave, int lane) {
    asm volatile("" : "+v"(lane));
    LAS float* scr = (LAS float*)(lds + wave * 16384);
    constexpr int I13 = 16 * 176, I2 = 44 * 32, IIN = 16 * 280, IBR = 3 * 8 * 32, IOUT = 16 * 32, IPG = 16 * 32, IPP = 4 * 32, IL = 2 * I13 + 2 * I2 + IIN + IBR + IOUT + IPG + IPP;
    auto decode = [&](int it) -> TrItem {
        KParams P = params_ptr(); const int L = it / IL; int r = it - L * IL; unsigned char* wl = P->ws + WS_W + (size_t)L * LW;
        if (r < 2 * I13) { const int which = r / I13; r -= which * I13; const int kb = r / 176, nb = r % 176, n0 = 32 * nb, tile = n0 >> 8, j0 = n0 & 255;
            const float* w1 = P->in[which ? I_F2W1 : I_F1W1] + (size_t)L * DM * DFF; const float* w3 = P->in[which ? I_F2W3 : I_F1W3] + (size_t)L * DM * DFF; const float* gn = P->in[which ? I_N2 : I_N1] + L * DM;
            return tr_make(j0 < 128 ? w1 : w3, DFF, 128 * tile + (j0 & 127), 32, gn, DM, (bf16*)(wl + (which ? OW13B : OW13A)), n0, kb); }
        r -= 2 * I13;
        if (r < 2 * I2) { const int which = r / I2; r -= which * I2; const int kb = r / 32, nb = r % 32;
            return tr_make(P->in[which ? I_F2W2 : I_F1W2] + (size_t)L * DFF * DM, DM, 32 * nb, 32, nullptr, DFF, (bf16*)(wl + (which ? OW2B : OW2A)), 32 * nb, kb); }
        r -= 2 * I2;
        if (r < IIN) { const int kb = r / 280, nb = r % 280; int nv; const int sc = win_src_col(32 * nb, nv);
            return tr_make(P->in[I_WIN] + (size_t)L * DM * 8720, 8720, sc, nv, P->in[I_NM] + L * DM, DM, (bf16*)(wl + OWIN), 32 * nb, kb); }
        r -= IIN;
        if (r < IBR) { const int b = 1 + r / 256; r &= 255; const int kb = r / 32, nb = r % 32;
            return tr_make(P->in[I_WBR] + ((size_t)L * 4 + b) * 512 * 1024, 1024, 32 * nb, 32, nullptr, 512, (bf16*)(wl + OWBR) + (size_t)b * 1024 * 512, 32 * nb, kb); }
        r -= IBR;
        if (r < IOUT) { const int kb = r / 32, nb = r % 32; return tr_make(P->in[I_WOUT] + (size_t)L * DM * DM, DM, 32 * nb, 32, nullptr, DM, (bf16*)(wl + OWOUT), 32 * nb, kb); }
        r -= IOUT;
        if (r < IPG) { const int kb = r / 32, nb = r % 32; return tr_make(P->in[I_WPG] + (size_t)L * DM * DM, DM, 32 * nb, 32, P->in[I_NPL] + L * DM, DM, (bf16*)(wl + OWPG), 32 * nb, kb); }
        r -= IPG;
        { const int kb = r / 32, nb = r % 32; return tr_make(P->in[I_WPP] + (size_t)L * 256 * DM, DM, 32 * nb, 32, nullptr, 256, (bf16*)(wl + OWPP), 32 * nb, kb); }
    };
    for (int it = gw; it < NL * IL; it += 4 * NGW) {
        const bool h1 = it + NGW < NL * IL, h2 = it + 2 * NGW < NL * IL, h3 = it + 3 * NGW < NL * IL;
        const TrItem ta = decode(it), tb = decode(h1 ? it + NGW : it), tc = decode(h2 ? it + 2 * NGW : it), td = decode(h3 ? it + 3 * NGW : it);
        float va[32], vb[32], vc[32], vd[32];
        tr_load(ta, va, lane); if (h1) tr_load(tb, vb, lane); if (h2) tr_load(tc, vc, lane); if (h3) tr_load(td, vd, lane);
        tr_store(ta, va, scr, lane); if (h1) tr_store(tb, vb, scr, lane); if (h2) tr_store(tc, vc, scr, lane); if (h3) tr_store(td, vd, scr, lane);
    }
    for (int it = gw; it < NL * 64 * 16; it += NGW) {
        KParams P = params_ptr(); unsigned char* ws = P->ws; const int L = it / (64 * 16); const int r = it - L * 64 * 16; const int k0 = (r >> 4) * 8, n = (r & 15) * 64 + lane, g = k0 >> 7;
        const float* pw = P->in[I_POOLW] + ((size_t)L * 512 + k0) * 128; const float* sc = P->in[I_POOLS] + L * 512 + g * 128; const float* wb = P->in[I_WBR] + ((size_t)L * 4) * 512 * 1024 + (size_t)(g * 128) * 1024 + n;
#pragma unroll
        for (int i = 0; i < 16; ++i) { const int e = i * 64 + lane; scr[e] = pw[e] * sc[e & 127]; }
        LDS_WAIT(); asm volatile("" ::: "memory");
        float a[8];
#pragma unroll
        for (int j = 0; j < 8; ++j) a[j] = 0.f;
        for (int d0 = 0; d0 < 128; d0 += 32) {
            float wv[32];
#pragma unroll
            for (int d = 0; d < 32; ++d) wv[d] = wb[(size_t)(d0 + d) * 1024];
#pragma unroll
            for (int d = 0; d < 32; ++d)
#pragma unroll
                for (int j = 0; j < 8; ++j) a[j] += scr[j * 128 + d0 + d] * wv[d];
        }
        v4u o; o.x = cvtpk(a[0], a[1]); o.y = cvtpk(a[2], a[3]); o.z = cvtpk(a[4], a[5]); o.w = cvtpk(a[6], a[7]);
        *(GAS v4u*)((bf16*)(ws + WS_W + (size_t)L * LW + OWBR) + (size_t)n * 512 + k0) = o;
        LDS_WAIT(); asm volatile("" ::: "memory");
    }
    for (int it = gw * 64 + lane; it < NL * 4 * 128 * 128; it += NGW * 64) {
        KParams P = params_ptr(); unsigned char* ws = P->ws; const int L = it >> 16, r = it & 65535, i = (r >> 7) & 127, j = r & 127;
        const float v = ((j >> 6) <= (i >> 6)) ? P->in[I_GWS][it] : 0.f;
        ((bf16*)(ws + WS_W + (size_t)L * LW + OWM))[r] = (bf16)(cvtpk(v, 0.f) & 0xffffu);
    }
    for (int m0 = gw * 4; m0 < M; m0 += NGW * 4) {
        KParams P = params_ptr(); unsigned char* ws = P->ws;
        f32x4 v[4][4];
#pragma unroll
        for (int r = 0; r < 4; ++r) { const int m = m0 + r; const float* src = m < MP ? P->in[I_XP] + (size_t)m * DM : P->in[I_XS] + (size_t)(m - MP) * DM;
#pragma unroll
            for (int j = 0; j < 4; ++j) v[r][j] = ((const GAS f32x4*)src)[lane + 64 * j]; }
#pragma unroll
        for (int r = 0; r < 4; ++r) { const int m = m0 + r; float s = 0.f;
#pragma unroll
            for (int j = 0; j < 4; ++j) s += (v[r][j].x * v[r][j].x + v[r][j].y * v[r][j].y) + (v[r][j].z * v[r][j].z + v[r][j].w * v[r][j].w);
            s = wave_sum(s);
            GAS u32x2* bo = (GAS u32x2*)((bf16*)(ws + WS_XB0) + (size_t)m * DM) + lane; GAS u32x2* lo = (GAS u32x2*)((bf16*)(ws + WS_XL) + (size_t)m * DM) + lane;
#pragma unroll
            for (int j = 0; j < 4; ++j) { u32x2 w; w.x = cvtpk(v[r][j].x, v[r][j].y); w.y = cvtpk(v[r][j].z, v[r][j].w); bo[64 * j] = w;
                if (USE_XL) { u32x2 l; l.x = cvtpk(v[r][j].x - bflo(w.x), v[r][j].y - bfhi(w.x)); l.y = cvtpk(v[r][j].z - bflo(w.y), v[r][j].w - bfhi(w.y)); lo[64 * j] = l; } }
            if (lane < 16) ((float*)(ws + WS_SSQ0))[(size_t)m * 16 + lane] = lane == 0 ? s : 0.f; }
    }
    for (int it0 = gw * 8; it0 < NL * M; it0 += NGW * 8) {
        KParams P = params_ptr(); unsigned char* ws = P->ws; f32x4 v[8];
#pragma unroll
        for (int j = 0; j < 8; ++j) { const int it = it0 + j, L = it / M, m = it - L * M;
            const float* src = m < MP ? P->in[I_PP] + ((size_t)L * MP + m) * 256 : P->in[I_PS] + ((size_t)L * MS + (m - MP)) * 256; v[j] = ((const GAS f32x4*)src)[lane]; }
#pragma unroll
        for (int j = 0; j < 8; ++j) { u32x2 w; w.x = cvtpk(v[j].x, v[j].y); w.y = cvtpk(v[j].z, v[j].w); ((GAS u32x2*)((bf16*)(ws + WS_PB) + (size_t)(it0 + j) * 256))[lane] = w; }
    }
}

template <int W> __device__ __forceinline__ void pool_rows(KParams P, int L, int rblk, int g, int lane) {
    const bf16* xpb = (const bf16*)(P->ws + WS_XPB); bf16* D = (bf16*)(P->ws + WS_AB);
    const int row0 = rblk * 32; const bool prompt = row0 < MP;
    int rowbase, t0; const float* hist = nullptr; float* pout; int pfirst;
    if (prompt) { const int b = row0 >> 12; rowbase = b << 12; t0 = row0 & 4095; pout = P->out + O_POOLP + ((size_t)L * 8 + b) * 15 * 512; pfirst = 4081; }
    else { const int b = (row0 - MP) >> 5; rowbase = MP + (b << 5); t0 = 0; hist = P->in[I_SPOOL] + ((size_t)L * 16 + b) * 15 * 512; pout = P->out + O_POOLS + ((size_t)L * 16 + b) * 15 * 512; pfirst = 17; }
    const int tb = t0 + 8 * (lane >> 4), c0 = g * 128 + (lane & 15) * 8;
    v4u x[W + 7];
#pragma unroll
    for (int i = 0; i < W + 7; ++i) { const int t = tb - (W - 1) + i; x[i] = *(const GAS v4u*)(xpb + (size_t)(rowbase + (t > 0 ? t : 0)) * 512 + c0); }
    if (prompt) {
#pragma unroll
        for (int i = 0; i < W - 1; ++i) { const int t = tb - (W - 1) + i; if (t < 0) x[i] = (v4u){0u, 0u, 0u, 0u}; }
    } else {
        v4u hx[W - 1];
#pragma unroll
        for (int i = 0; i < W - 1; ++i) { const int t = tb - (W - 1) + i; int hr = 15 + t; hr = hr < 0 ? 0 : (hr > 14 ? 14 : hr); const float* h = hist + (size_t)hr * 512 + c0;
            hx[i] = pg8::pack8(*(const f32x4*)h, *(const f32x4*)(h + 4)); }
#pragma unroll
        for (int i = 0; i < W - 1; ++i) { const int t = tb - (W - 1) + i; if (t < 0) x[i] = hx[i]; }
    }
    f32x4 s0 = (f32x4){0.f, 0.f, 0.f, 0.f}, s1 = s0;
#pragma unroll
    for (int i = 0; i < W - 1; ++i) { s0 = s0 + (f32x4){bflo(x[i].x), bfhi(x[i].x), bflo(x[i].y), bfhi(x[i].y)}; s1 = s1 + (f32x4){bflo(x[i].z), bfhi(x[i].z), bflo(x[i].w), bfhi(x[i].w)}; }
#pragma unroll
    for (int j = 0; j < 8; ++j) { const int t = tb + j; const v4u xn = x[j + W - 1], xo = x[j];
        const f32x4 a = (f32x4){bflo(xn.x), bfhi(xn.x), bflo(xn.y), bfhi(xn.y)}, b = (f32x4){bflo(xn.z), bfhi(xn.z), bflo(xn.w), bfhi(xn.w)};
        s0 = s0 + a; s1 = s1 + b;
        const int cnt = prompt ? (t + 1 < W ? t + 1 : W) : W; const float inv = 1.0f / (float)cnt;
        *(GAS v4u*)(D + (size_t)(rowbase + t) * 512 + c0) = pg8::pack8(s0 * inv - a, s1 * inv - b);
        if (t >= pfirst) { float* po = pout + (size_t)(t - pfirst) * 512 + c0; *(f32x4*)po = a; *(f32x4*)(po + 4) = b; }
        s0 = s0 - (f32x4){bflo(xo.x), bfhi(xo.x), bflo(xo.y), bfhi(xo.y)}; s1 = s1 - (f32x4){bflo(xo.z), bfhi(xo.z), bflo(xo.w), bfhi(xo.w)}; }
}
__device__ __forceinline__ void pool_unit(int L, int unit, int lane) {
    KParams P = params_ptr(); asm volatile("" : "+v"(lane));
    const int g = unit & 3, rblk = unit >> 2;
    if (g == 0) pool_rows<2>(P, L, rblk, 0, lane); else if (g == 1) pool_rows<4>(P, L, rblk, 1, lane); else if (g == 2) pool_rows<8>(P, L, rblk, 2, lane); else pool_rows<16>(P, L, rblk, 3, lane);
}

template <bool SAMPLE> __device__ __forceinline__ void sb_unit(LAS unsigned char* wl, int lane, int L, int unit) {
    KParams P = params_ptr(); asm volatile("" : "+v"(lane));
    const bf16* Qb = (const bf16*)(P->ws + WS_QB); const bf16* Kb = (const bf16*)(P->ws + WS_KB); const bf16* Vb = (const bf16*)(P->ws + WS_VB); bf16* Y = (bf16*)(P->ws + WS_AB) + (size_t)M * 512;
    int newrow0, nnew, npast, qidx0, h; const float* ck = nullptr; const float* cv = nullptr;
    if (!SAMPLE) { const int b = unit >> 10, r = unit & 1023; h = r >> 7; qidx0 = (r & 127) * 32; newrow0 = b << 12; nnew = 4096; npast = 0; }
    else { const int r = unit - 8192, b = r >> 3; h = r & 7; qidx0 = 0; newrow0 = MP + (b << 5); nnew = 32; npast = 4096;
        ck = P->in[I_CK] + ((size_t)L * 16 + b) * 4096 * 512; cv = P->in[I_CV] + ((size_t)L * 16 + b) * 4096 * 512; }
    const int r32 = lane & 31, hi = lane >> 5; const int qrow0 = newrow0 + qidx0;
    pg8::bf16x8 qf[4];
    { const bf16* qp = Qb + (size_t)(qrow0 + r32) * 512 + h * 64 + hi * 8;
#pragma unroll
      for (int d0 = 0; d0 < 4; ++d0) qf[d0] = *(const GAS pg8::bf16x8*)(qp + d0 * 16); }
    f32x16 o0, o1;
#pragma unroll
    for (int r = 0; r < 16; ++r) { o0[r] = 0.f; o1[r] = 0.f; }
    float R2 = 0.f;
    const int qpos0 = npast + qidx0, jd = qpos0 >> 6;
    v4u kv[8], vv[8];
    auto issue_new = [&](int jj) {
#pragma unroll
        for (int i = 0; i < 8; ++i) { const int r = (lane >> 3) + 8 * i; int idx = 64 * jj - npast + r; idx = idx < nnew ? idx : nnew - 1;
            const size_t off = (size_t)(newrow0 + idx) * 512 + h * 64 + (lane & 7) * 8; kv[i] = *(const GAS v4u*)(Kb + off); vv[i] = *(const GAS v4u*)(Vb + off); }
    };
    if (!SAMPLE) issue_new(jd);
    for (int j = jd; j >= 0; --j) {
        if (__all(R2 >= SB_CUT)) break;
        const int p0 = 64 * j; const bool isnew = !SAMPLE || p0 >= npast;
        if (isnew) {
            if (SAMPLE) issue_new(j);
#pragma unroll
            for (int i = 0; i < 8; ++i) { const int r = (lane >> 3) + 8 * i;
                *(LAS v4u*)(wl + r * 128 + (((lane & 7) ^ (r & 7)) * 16)) = kv[i]; *(LAS v4u*)(wl + 8192 + r * 128 + (lane & 7) * 16) = vv[i]; }
            if (!SAMPLE && j > 0) issue_new(j - 1);
        } else {
#pragma unroll
            for (int hf = 0; hf < 2; ++hf) {
                f32x4 kk[8], vf[8];
#pragma unroll
                for (int i = 0; i < 8; ++i) { const int r = (lane >> 4) + 4 * (8 * hf + i); const size_t off = ((size_t)(p0 + r) * 8 + h) * 64 + (lane & 15) * 4; kk[i] = *(const GAS f32x4*)(ck + off); vf[i] = *(const GAS f32x4*)(cv + off); }
#pragma unroll
                for (int i = 0; i < 8; ++i) { const int r = (lane >> 4) + 4 * (8 * hf + i); u32x2 a, b; a.x = cvtpk(kk[i].x, kk[i].y); a.y = cvtpk(kk[i].z, kk[i].w); b.x = cvtpk(vf[i].x, vf[i].y); b.y = cvtpk(vf[i].z, vf[i].w);
                    *(LAS u32x2*)(wl + r * 128 + ((((lane & 15) >> 1) ^ (r & 7)) * 16) + (lane & 1) * 8) = a; *(LAS u32x2*)(wl + 8192 + r * 128 + (lane & 15) * 8) = b; }
            }
        }
        asm volatile("" ::: "memory");
        f32x16 p[2];
#pragma unroll
        for (int kh = 0; kh < 2; ++kh) {
#pragma unroll
            for (int r = 0; r < 16; ++r) p[kh][r] = 0.f;
#pragma unroll
            for (int d0 = 0; d0 < 4; ++d0) { const int row = 32 * kh + r32; const pg8::bf16x8 kf = *(const LAS pg8::bf16x8*)(wl + row * 128 + (((2 * d0 + hi) ^ (row & 7)) * 16));
                p[kh] = __builtin_amdgcn_mfma_f32_32x32x16_bf16(kf, qf[d0], p[kh], 0, 0, 0); }
        }
        const float finv = __builtin_amdgcn_exp2f(R2);
        const bool diag = (j == jd);
#pragma unroll
        for (int kh = 0; kh < 2; ++kh)
#pragma unroll
            for (int r = 0; r < 16; ++r) { float s = p[kh][r]; s = s < 60.f ? s : 60.f; float u = __builtin_amdgcn_exp2f(s);
                if (diag) { const bool valid = (p0 + 32 * kh + crow(r, hi)) < (qpos0 + r32); u = valid ? u : 0.f; }
                p[kh][r] = u; }
        float gp[16];
#pragma unroll
        for (int kh = 0; kh < 2; ++kh)
#pragma unroll
            for (int a = 0; a < 4; ++a) { const float g = ((1.0f + p[kh][4 * a]) * (1.0f + p[kh][4 * a + 1])) * ((1.0f + p[kh][4 * a + 2]) * (1.0f + p[kh][4 * a + 3])); const float og = __shfl_xor(g, 32);
                gp[8 * kh + 2 * a] = hi ? og : g; gp[8 * kh + 2 * a + 1] = hi ? g : og; }
        float E[16]; E[15] = finv;
#pragma unroll
        for (int G = 14; G >= 0; --G) E[G] = E[G + 1] * gp[G + 1];
        const float T = E[0] * gp[0];
#pragma unroll
        for (int kh = 0; kh < 2; ++kh)
#pragma unroll
            for (int a = 0; a < 4; ++a) { const float e = hi ? E[8 * kh + 2 * a + 1] : E[8 * kh + 2 * a];
                const float D3 = e * (1.0f + p[kh][4 * a + 3]), D2 = D3 * (1.0f + p[kh][4 * a + 2]), D1 = D2 * (1.0f + p[kh][4 * a + 1]), D0 = D1 * (1.0f + p[kh][4 * a]);
                p[kh][4 * a + 3] = p[kh][4 * a + 3] * __builtin_amdgcn_rcpf(D3); p[kh][4 * a + 2] = p[kh][4 * a + 2] * __builtin_amdgcn_rcpf(D2);
                p[kh][4 * a + 1] = p[kh][4 * a + 1] * __builtin_amdgcn_rcpf(D1); p[kh][4 * a] = p[kh][4 * a] * __builtin_amdgcn_rcpf(D0); }
        R2 = __builtin_amdgcn_logf(T);
#pragma unroll
        for (int s = 0; s < 4; ++s) {
            const int kh = s >> 1, rb = 8 * (s & 1);
            v4u pw; pw.x = cvtpk(p[kh][rb], p[kh][rb + 1]); pw.y = cvtpk(p[kh][rb + 2], p[kh][rb + 3]); pw.z = cvtpk(p[kh][rb + 4], p[kh][rb + 5]); pw.w = cvtpk(p[kh][rb + 6], p[kh][rb + 7]);
            const pg8::bf16x8 pf = __builtin_bit_cast(pg8::bf16x8, pw);
            const LAS unsigned char* vbase = wl + 8192 + (16 * s + 4 * hi + ((lane & 15) >> 2)) * 128 + ((lane >> 4) & 1) * 32 + (lane & 3) * 8;
#pragma unroll
            for (int dh = 0; dh < 2; ++dh) { const s16x4 lo = vtr(vbase + dh * 64), h4 = vtr(vbase + dh * 64 + 8 * 128);
                const pg8::bf16x8 vf = (pg8::bf16x8){lo[0], lo[1], lo[2], lo[3], h4[0], h4[1], h4[2], h4[3]};
                if (dh == 0) o0 = __builtin_amdgcn_mfma_f32_32x32x16_bf16(pf, vf, o0, 0, 0, 0); else o1 = __builtin_amdgcn_mfma_f32_32x32x16_bf16(pf, vf, o1, 0, 0, 0); }
        }
        asm volatile("" ::: "memory");
    }
    bf16* yp = Y + (size_t)qrow0 * 512 + h * 64 + r32;
#pragma unroll
    for (int r = 0; r < 16; ++r) { bf16* q = yp + (size_t)crow(r, hi) * 512; q[0] = (bf16)(cvtpk(o0[r], 0.f) & 0xffffu); q[32] = (bf16)(cvtpk(o1[r], 0.f) & 0xffffu); }
}

__device__ __forceinline__ void gmlp_unit(LAS unsigned char* wl, int lane, int L, int unit) {
    KParams P = params_ptr(); asm volatile("" : "+v"(lane));
    const bf16* gub = (const bf16*)(P->ws + WS_GUB); const bf16* gvb = (const bf16*)(P->ws + WS_GVB); bf16* Y = (bf16*)(P->ws + WS_AB) + (size_t)2 * M * 512;
    int row0, ntok, g, cb;
    if (unit < 4096) { const int ch = unit >> 4; g = (unit >> 2) & 3; cb = unit & 3; row0 = ch * 128; ntok = 128; }
    else { const int r = unit - 4096, b = r >> 4; g = (r >> 2) & 3; cb = r & 3; row0 = MP + b * 32; ntok = 32; }
    const bf16* wm = (const bf16*)(P->ws + WS_W + (size_t)L * LW + OWM) + (size_t)g * 128 * 128; const float* bs = P->in[I_GB] + ((size_t)L * 4 + g) * 128;
    const int r32 = lane & 31, hi = lane >> 5; const int colb = g * 128 + cb * 32;
    for (int i = 0; i < ntok / 16; ++i) { const int r = (lane >> 2) + 16 * i; *(LAS v4u*)(wl + r * 80 + (lane & 3) * 16) = *(const GAS v4u*)(gvb + (size_t)(row0 + r) * 512 + colb + (lane & 3) * 8); }
    asm volatile("" ::: "memory");
    const int nib = ntok / 32;
    for (int ib = 0; ib < nib; ++ib) {
        f32x16 acc;
#pragma unroll
        for (int r = 0; r < 16; ++r) acc[r] = 0.f;
        const int ns = ntok == 32 ? 2 : (ib < 2 ? 4 : 8);
        pg8::bf16x8 af[8]; bf16 guv[16]; float bsv[16];
#pragma unroll
        for (int s = 0; s < 8; ++s) if (s < ns) af[s] = *(const GAS pg8::bf16x8*)(wm + (size_t)(32 * ib + r32) * 128 + 16 * s + 8 * hi);
#pragma unroll
        for (int r = 0; r < 16; ++r) { const int i = 32 * ib + crow(r, hi); guv[r] = gub[(size_t)(row0 + i) * 512 + colb + r32]; bsv[r] = bs[i]; }
#pragma unroll
        for (int s = 0; s < 8; ++s) if (s < ns) {
            const LAS unsigned char* bb = wl + (16 * s + 8 * hi + ((lane & 15) >> 2)) * 80 + ((lane >> 4) & 1) * 32 + (lane & 3) * 8;
            const s16x4 lo = vtr(bb), h4 = vtr(bb + 4 * 80);
            const pg8::bf16x8 bfr = (pg8::bf16x8){lo[0], lo[1], lo[2], lo[3], h4[0], h4[1], h4[2], h4[3]};
            acc = __builtin_amdgcn_mfma_f32_32x32x16_bf16(af[s], bfr, acc, 0, 0, 0);
        }
#pragma unroll
        for (int r = 0; r < 16; ++r) { const int i = 32 * ib + crow(r, hi); const size_t off = (size_t)(row0 + i) * 512 + colb + r32;
            Y[off] = (bf16)(cvtpk(bf1(guv[r]) * (acc[r] + bsv[r]), 0.f) & 0xffffu); }
    }
    asm volatile("" ::: "memory");
}

__device__ __forceinline__ void gla_ids(int cid, int& row0, int& ntok, int& h) {
    if (cid < 2048) { const int sq = cid >> 6, c = cid & 63; h = sq & 3; row0 = (sq >> 2) * 4096 + c * 64; ntok = 64; }
    else { const int sq = cid - 2048; h = sq & 3; row0 = MP + (sq >> 2) * 32; ntok = 32; }
}
struct GlaInA { v4u la; v4u q, k, v0, v1; };
__device__ __forceinline__ GlaInA gla_a_issue(KParams P, int L, int cid, int tid) {
    int row0, ntok, h; gla_ids(cid, row0, ntok, h);
    const int t = tid >> 3, q8 = tid & 7; const bool live = t < ntok; GlaInA r;
    const bf16* lab = (const bf16*)(P->ws + WS_LAB); const bf16* lqb = (const bf16*)(P->ws + WS_LQB); const bf16* lkb = (const bf16*)(P->ws + WS_LKB); const bf16* lvb = (const bf16*)(P->ws + WS_LVB);
    const v4u z = (v4u){0u, 0u, 0u, 0u}; r.la = z; r.q = z; r.k = z; r.v0 = z; r.v1 = z;
    { const int ar = 32 * ((tid >> 6) & 1) + (tid & 31); if (ar < ntok) r.la = *(const GAS v4u*)(lab + (size_t)(row0 + ar) * 256 + 8 * ((tid >> 5) & 1)); }
    if (live) { r.q = *(const GAS v4u*)(lqb + (size_t)(row0 + t) * 256 + h * 64 + 8 * q8); r.k = *(const GAS v4u*)(lkb + (size_t)(row0 + t) * 256 + h * 64 + 8 * q8);
                r.v0 = *(const GAS v4u*)(lvb + (size_t)(row0 + t) * 512 + h * 128 + 16 * q8); r.v1 = *(const GAS v4u*)(lvb + (size_t)(row0 + t) * 512 + h * 128 + 16 * q8 + 8); }
    return r;
}
__device__ __forceinline__ void gla_pass_a_loop(LAS unsigned char* lds, int L, int vcu, int G, int tid) {
    asm volatile("" : "+v"(tid)); const int lane = tid & 63, wave = __builtin_amdgcn_readfirstlane(tid >> 6);
    LAS float* LA = (LAS float*)lds;
    LAS float* WA = LA + 64 * 17;
    LAS float* BA = WA + 16 * 64;
    LAS float* SEG = BA + 64;
    LAS float* LAMS = SEG + 8 * 64;
    LAS float* Gt = LAMS + 64;
    LAS unsigned char* KT = (LAS unsigned char*)(Gt + 64 * 65);
    LAS unsigned char* VT = KT + 64 * 144;
    int seg = vcu; if (seg >= NSEG) return; int ci = 0;
    int c = seg < 256 ? seg * 8 : 2048 + (seg - 256);
    const int t = tid >> 3, q8 = tid & 7, r32 = lane & 31, hi = lane >> 5;
    f32x16 Srun; float Lrun = 1.0f;
#pragma unroll
    for (int r = 0; r < 16; ++r) Srun[r] = 0.f;
    GlaInA in = gla_a_issue(params_ptr(), L, c, tid);
    int seg1 = seg, ci1 = 1; if (ci1 >= (seg < 256 ? 8 : 1)) { seg1 = seg + G; ci1 = 0; }
    bool has1 = seg1 < NSEG; int c1 = has1 ? (seg1 < 256 ? seg1 * 8 + ci1 : 2048 + (seg1 - 256)) : c;
    GlaInA in2 = in; if (has1) in2 = gla_a_issue(params_ptr(), L, c1, tid);
    v4u bhi = (v4u){0u, 0u, 0u, 0u}, blo = bhi; float bcol = 0.f;
    auto step = [&](GlaInA& in) -> bool {
        KParams P = params_ptr(); const int nch = seg < 256 ? 8 : 1;
        int row0, ntok, h; gla_ids(c, row0, ntok, h); const bool live = t < ntok;
        if (ci == 0) {
            const float* wa = P->in[I_WA2] + ((size_t)L * 16 + 8 * hi) * 256 + h * 64 + 32 * ((wave >> 1) & 1) + r32; float w[8];
#pragma unroll
            for (int i = 0; i < 8; ++i) w[i] = wa[(size_t)i * 256];
            bcol = P->in[I_BA][L * 256 + h * 64 + 32 * ((wave >> 1) & 1) + r32];
            bhi.x = cvtpk(w[0], w[1]); bhi.y = cvtpk(w[2], w[3]); bhi.z = cvtpk(w[4], w[5]); bhi.w = cvtpk(w[6], w[7]);
            blo.x = cvtpk(w[0] - bflo(bhi.x), w[1] - bfhi(bhi.x)); blo.y = cvtpk(w[2] - bflo(bhi.y), w[3] - bfhi(bhi.y)); blo.z = cvtpk(w[4] - bflo(bhi.z), w[5] - bfhi(bhi.z)); blo.w = cvtpk(w[6] - bflo(bhi.w), w[7] - bfhi(bhi.w)); }
        *(LAS v4u*)(VT + t * 272 + q8 * 32) = in.v0; *(LAS v4u*)(VT + t * 272 + q8 * 32 + 16) = in.v1;
        const v4u qraw = in.q, kraw = in.k; const pg8::bf16x8 afr = __builtin_bit_cast(pg8::bf16x8, in.la);
        int seg2 = seg1, ci2 = ci1 + 1; if (ci2 >= (seg1 < 256 ? 8 : 1)) { seg2 = seg1 + G; ci2 = 0; }
        const bool has2 = has1 && seg2 < NSEG; const int c2 = has2 ? (seg2 < 256 ? seg2 * 8 + ci2 : 2048 + (seg2 - 256)) : c1;
        if (has2) in = gla_a_issue(P, L, c2, tid);
        { f32x16 xg;
#pragma unroll
          for (int r = 0; r < 16; ++r) xg[r] = bcol;
          xg = __builtin_amdgcn_mfma_f32_32x32x16_bf16(afr, __builtin_bit_cast(pg8::bf16x8, bhi), xg, 0, 0, 0);
          xg = __builtin_amdgcn_mfma_f32_32x32x16_bf16(afr, __builtin_bit_cast(pg8::bf16x8, blo), xg, 0, 0, 0);
          const int tb_ = wave & 1, kb_ = (wave >> 1) & 1, half = wave >> 2;
#pragma unroll
          for (int r8 = 0; r8 < 8; ++r8) { const float x = half ? xg[8 + r8] : xg[r8]; const int tt = 32 * tb_ + crow(r8, hi) + 16 * half;
              const float ax = __builtin_fabsf(x); const float l2 = 1.4426950408889634f * (x < 0.f ? x : 0.f) - __builtin_amdgcn_logf(1.0f + __builtin_amdgcn_exp2f(-1.4426950408889634f * ax));
              Gt[tt * 65 + 32 * kb_ + r32] = tt < ntok ? l2 * (1.0f / 16.0f) : 0.f; } }
        __syncthreads();
        { float g[8], sg[7];
#pragma unroll
          for (int s = 0; s < 8; ++s) g[s] = Gt[(8 * wave + s) * 65 + lane];
#pragma unroll
          for (int s = 1; s < 8; ++s) g[s] += g[s - 1];
          SEG[wave * 64 + lane] = g[7];
          __syncthreads();
#pragma unroll
          for (int w = 0; w < 7; ++w) sg[w] = SEG[w * 64 + lane];
          float off = 0.f;
#pragma unroll
          for (int w = 0; w < 7; ++w) off += (w < wave) ? sg[w] : 0.f;
#pragma unroll
          for (int s = 0; s < 8; ++s) Gt[(8 * wave + s) * 65 + lane] = g[s] + off; }
        __syncthreads();
        { const float qin[8] = {bflo(qraw.x), bfhi(qraw.x), bflo(qraw.y), bfhi(qraw.y), bflo(qraw.z), bfhi(qraw.z), bflo(qraw.w), bfhi(qraw.w)};
          const float kin[8] = {bflo(kraw.x), bfhi(kraw.x), bflo(kraw.y), bfhi(kraw.y), bflo(kraw.z), bfhi(kraw.z), bflo(kraw.w), bfhi(kraw.w)};
          float qo[8], ko[8];
          float bb[8];
#pragma unroll
          for (int kk = 0; kk < 8; ++kk) bb[kk] = Gt[t * 65 + 8 * q8 + kk];
#pragma unroll
          for (int kk = 0; kk < 8; ++kk) { float b2 = bb[kk]; b2 = b2 > -120.f ? b2 : -120.f; qo[kk] = qin[kk] * __builtin_amdgcn_exp2f(b2) * 0.125f; ko[kk] = kin[kk] * __builtin_amdgcn_exp2f(-b2); }
          v4u qw, kw; qw.x = cvtpk(qo[0], qo[1]); qw.y = cvtpk(qo[2], qo[3]); qw.z = cvtpk(qo[4], qo[5]); qw.w = cvtpk(qo[6], qo[7]); kw.x = cvtpk(ko[0], ko[1]); kw.y = cvtpk(ko[2], ko[3]); kw.z = cvtpk(ko[4], ko[5]); kw.w = cvtpk(ko[6], ko[7]);
          *(LAS v4u*)(KT + t * 144 + q8 * 16) = kw;
          if (live) { *(GAS v4u*)((bf16*)(P->ws + WS_QT) + (size_t)(row0 + t) * 256 + h * 64 + 8 * q8) = qw; *(GAS v4u*)((bf16*)(P->ws + WS_KT) + (size_t)(row0 + t) * 256 + h * 64 + 8 * q8) = kw; } }
        if (tid < 64) { float b2 = Gt[63 * 65 + tid]; b2 = b2 > -120.f ? b2 : -120.f; const float lamv = __builtin_amdgcn_exp2f(b2); LAMS[tid] = lamv;
            if (ci == 0) Lrun = 1.0f;
            ((float*)(P->ws + WS_LAM))[(size_t)c * 64 + tid] = lamv;
            Lrun *= lamv;
            if (ci == nch - 1) ((float*)(P->ws + WS_SC) + (size_t)NSEG * 8192)[(size_t)seg * 64 + tid] = Lrun; }
        __syncthreads();
        { const int kb = wave & 1, vb = wave >> 1;
          f32x16 acc;
#pragma unroll
          for (int r = 0; r < 16; ++r) acc[r] = 0.f;
          const LAS unsigned char* ka = KT + (8 * hi + ((lane & 15) >> 2)) * 144 + (32 * kb + 16 * ((lane >> 4) & 1) + 4 * (lane & 3)) * 2;
          const LAS unsigned char* va = VT + (8 * hi + ((lane & 15) >> 2)) * 272 + (32 * vb + 16 * ((lane >> 4) & 1) + 4 * (lane & 3)) * 2;
#pragma unroll
          for (int s4 = 0; s4 < 4; ++s4) { const s16x4 a0 = vtr(ka + s4 * 16 * 144), a1 = vtr(ka + s4 * 16 * 144 + 4 * 144), b0 = vtr(va + s4 * 16 * 272), b1 = vtr(va + s4 * 16 * 272 + 4 * 272);
              const pg8::bf16x8 af = (pg8::bf16x8){a0[0], a0[1], a0[2], a0[3], a1[0], a1[1], a1[2], a1[3]}, bfr = (pg8::bf16x8){b0[0], b0[1], b0[2], b0[3], b1[0], b1[1], b1[2], b1[3]};
              acc = __builtin_amdgcn_mfma_f32_32x32x16_bf16(af, bfr, acc, 0, 0, 0); }
          if (ci == 0) {
#pragma unroll
              for (int r = 0; r < 16; ++r) Srun[r] = 0.f; }
#pragma unroll
          for (int r = 0; r < 16; ++r) Srun[r] = LAMS[32 * kb + crow(r, hi)] * (Srun[r] + acc[r]);
          if (ci == nch - 1) { float* sg = (float*)(P->ws + WS_SC) + (size_t)seg * 8192;
#pragma unroll
              for (int r = 0; r < 16; ++r) sg[(32 * kb + crow(r, hi)) * 128 + 32 * vb + r32] = Srun[r]; } }
        __syncthreads();
        if (!has1) return false;
        seg = seg1; ci = ci1; c = c1; seg1 = seg2; ci1 = ci2; c1 = c2; has1 = has2;
        return true;
    };
    for (;;) { if (!step(in)) break; if (!step(in2)) break; }
}
struct GlaInC { v4u q, k, v0, v1, l0, l1; float lc; };
__device__ __forceinline__ GlaInC gla_c_issue(KParams P, int cid, int tid) {
    int row0, ntok, h; gla_ids(cid, row0, ntok, h);
    const int t = tid >> 3, q8 = tid & 7; const bool live = t < ntok; GlaInC r;
    const v4u z = (v4u){0u, 0u, 0u, 0u}; r.q = z; r.k = z; r.v0 = z; r.v1 = z; r.l0 = z; r.l1 = z;
    if (live) { r.q = *(const GAS v4u*)((const bf16*)(P->ws + WS_QT) + (size_t)(row0 + t) * 256 + h * 64 + 8 * q8); r.k = *(const GAS v4u*)((const bf16*)(P->ws + WS_KT) + (size_t)(row0 + t) * 256 + h * 64 + 8 * q8);
                const bf16* lv = (const bf16*)(P->ws + WS_LVB) + (size_t)(row0 + t) * 512 + h * 128 + 16 * q8; r.v0 = *(const GAS v4u*)lv; r.v1 = *(const GAS v4u*)(lv + 8);
                const bf16* lr = (const bf16*)(P->ws + WS_LRB) + (size_t)(row0 + t) * 512 + h * 128 + 16 * q8; r.l0 = *(const GAS v4u*)lr; r.l1 = *(const GAS v4u*)(lr + 8); }
    r.lc = ((const float*)(P->ws + WS_LAM))[(size_t)cid * 64 + (tid & 63)];
    return r;
}
__device__ __forceinline__ void gla_pass_c_loop(LAS unsigned char* lds, int L, int vcu, int G, int tid) {
    asm volatile("" : "+v"(tid)); const int lane = tid & 63, wave = __builtin_amdgcn_readfirstlane(tid >> 6);
    LAS unsigned char* QT = lds;
    LAS unsigned char* KT = QT + 64 * 144;
    LAS unsigned char* VT = KT + 64 * 144;
    LAS unsigned char* ST = VT + 64 * 272;
    LAS float* O = (LAS float*)(ST + 64 * 272);
    LAS float* LAMS = O + 64 * 128;
    int seg = vcu; if (seg >= NSEG) return; int ci = 0;
    int c = seg < 256 ? seg * 8 : 2048 + (seg - 256);
    const int t = tid >> 3, q8 = tid & 7, r32 = lane & 31, hi = lane >> 5;
    const int so = (32 * (wave & 1) + 4 * hi) * 128 + 32 * (wave >> 1) + r32;
    f32x16 S0;
#pragma unroll
    for (int j = 0; j < 16; ++j) S0[j] = 0.f;
    float gon[16];
    { const float* gp = params_ptr()->in[I_GON] + L * 128 + 16 * q8;
#pragma unroll
      for (int j = 0; j < 4; ++j) { const f32x4 g4 = *(const f32x4*)(gp + 4 * j); gon[4 * j] = g4[0]; gon[4 * j + 1] = g4[1]; gon[4 * j + 2] = g4[2]; gon[4 * j + 3] = g4[3]; } }
    GlaInC in = gla_c_issue(params_ptr(), c, tid);
    int seg1 = seg, ci1 = 1; if (ci1 >= (seg < 256 ? 8 : 1)) { seg1 = seg + G; ci1 = 0; }
    bool has1 = seg1 < NSEG; int c1 = has1 ? (seg1 < 256 ? seg1 * 8 + ci1 : 2048 + (seg1 - 256)) : c;
    GlaInC in2 = in; if (has1) in2 = gla_c_issue(params_ptr(), c1, tid);
    auto step = [&](GlaInC& in) -> bool {
        KParams P = params_ptr(); const int nch = seg < 256 ? 8 : 1;
        const float* SSEG = (const float*)(P->ws + WS_SC); const float* LSEG = SSEG + (size_t)NSEG * 8192;
        if (ci == 0) {
            if (seg >= 256) { const float* sg = P->in[I_SGLA] + ((size_t)L * 64 + (seg - 256)) * 8192 + so;
#pragma unroll
                for (int r = 0; r < 16; ++r) S0[r] = sg[((r & 3) + 8 * (r >> 2)) * 128]; }
            else { const int jn = seg & 7, sb = seg - jn;
#pragma unroll
                for (int j = 0; j < 16; ++j) S0[j] = 0.f;
#pragma unroll 1
                for (int j0 = 0; j0 < jn; j0 += 2) {
                    float sv[2][16], lv[2][16];
#pragma unroll
                    for (int jj = 0; jj < 2; ++jj) if (j0 + jj < jn) { const float* sp = SSEG + (size_t)(sb + j0 + jj) * 8192 + so; const float* lp = LSEG + (size_t)(sb + j0 + jj) * 64 + 32 * (wave & 1) + 4 * hi;
#pragma unroll
                        for (int r = 0; r < 16; ++r) { sv[jj][r] = sp[((r & 3) + 8 * (r >> 2)) * 128]; lv[jj][r] = lp[(r & 3) + 8 * (r >> 2)]; } }
#pragma unroll
                    for (int jj = 0; jj < 2; ++jj) if (j0 + jj < jn) {
#pragma unroll
                        for (int r = 0; r < 16; ++r) S0[r] = lv[jj][r] * S0[r] + sv[jj][r]; }
                }
            }
        }
        int row0, ntok, h; gla_ids(c, row0, ntok, h); const bool live = t < ntok;
        *(LAS v4u*)(QT + t * 144 + q8 * 16) = in.q; *(LAS v4u*)(KT + t * 144 + q8 * 16) = in.k;
        *(LAS v4u*)(VT + t * 272 + q8 * 32) = in.v0; *(LAS v4u*)(VT + t * 272 + q8 * 32 + 16) = in.v1;
#pragma unroll
        for (int r = 0; r < 16; ++r) *(LAS unsigned short*)(ST + (32 * (wave & 1) + crow(r, hi)) * 272 + (32 * (wave >> 1) + r32) * 2) = (unsigned short)(cvtpk(S0[r], 0.f) & 0xffffu);
        if (tid < 64) LAMS[tid] = in.lc;
        const v4u l0 = in.l0, l1 = in.l1;
        int seg2 = seg1, ci2 = ci1 + 1; if (ci2 >= (seg1 < 256 ? 8 : 1)) { seg2 = seg1 + G; ci2 = 0; }
        const bool has2 = has1 && seg2 < NSEG; const int c2 = has2 ? (seg2 < 256 ? seg2 * 8 + ci2 : 2048 + (seg2 - 256)) : c1;
        if (has2) in = gla_c_issue(P, c2, tid);
        __syncthreads();
        { const int tb = wave & 1, vb = wave >> 1;
          pg8::bf16x8 qf[4];
#pragma unroll
          for (int k4 = 0; k4 < 4; ++k4) qf[k4] = *(const LAS pg8::bf16x8*)(QT + (32 * tb + r32) * 144 + (16 * k4 + 8 * hi) * 2);
          f32x16 o;
#pragma unroll
          for (int r = 0; r < 16; ++r) o[r] = 0.f;
          const LAS unsigned char* sa = ST + (8 * hi + ((lane & 15) >> 2)) * 272 + (32 * vb + 16 * ((lane >> 4) & 1) + 4 * (lane & 3)) * 2;
#pragma unroll
          for (int k4 = 0; k4 < 4; ++k4) { const s16x4 b0 = vtr(sa + k4 * 16 * 272), b1 = vtr(sa + k4 * 16 * 272 + 4 * 272);
              o = __builtin_amdgcn_mfma_f32_32x32x16_bf16(qf[k4], (pg8::bf16x8){b0[0], b0[1], b0[2], b0[3], b1[0], b1[1], b1[2], b1[3]}, o, 0, 0, 0); }
#pragma unroll
          for (int sb = 0; sb < 2; ++sb) if (sb <= tb) {
              f32x16 at;
#pragma unroll
              for (int r = 0; r < 16; ++r) at[r] = 0.f;
#pragma unroll
              for (int k4 = 0; k4 < 4; ++k4) at = __builtin_amdgcn_mfma_f32_32x32x16_bf16(*(const LAS pg8::bf16x8*)(KT + (32 * sb + r32) * 144 + (16 * k4 + 8 * hi) * 2), qf[k4], at, 0, 0, 0);
              if (sb == tb) {
#pragma unroll
                  for (int r = 0; r < 16; ++r) at[r] = (crow(r, hi) <= r32) ? at[r] : 0.f; }
              const LAS unsigned char* va = VT + (32 * sb + 4 * hi + ((lane & 15) >> 2)) * 272 + (32 * vb + 16 * ((lane >> 4) & 1) + 4 * (lane & 3)) * 2;
#pragma unroll
              for (int s2 = 0; s2 < 2; ++s2) { v4u pw; pw.x = cvtpk(at[8 * s2], at[8 * s2 + 1]); pw.y = cvtpk(at[8 * s2 + 2], at[8 * s2 + 3]); pw.z = cvtpk(at[8 * s2 + 4], at[8 * s2 + 5]); pw.w = cvtpk(at[8 * s2 + 6], at[8 * s2 + 7]);
                  const s16x4 b0 = vtr(va + s2 * 16 * 272), b1 = vtr(va + s2 * 16 * 272 + 8 * 272);
                  o = __builtin_amdgcn_mfma_f32_32x32x16_bf16(__builtin_bit_cast(pg8::bf16x8, pw), (pg8::bf16x8){b0[0], b0[1], b0[2], b0[3], b1[0], b1[1], b1[2], b1[3]}, o, 0, 0, 0); }
          }
#pragma unroll
          for (int r = 0; r < 16; ++r) O[(32 * tb + crow(r, hi)) * 128 + 32 * vb + r32] = o[r];
          { f32x16 acc;
#pragma unroll
            for (int r = 0; r < 16; ++r) acc[r] = 0.f;
            const LAS unsigned char* ka = KT + (8 * hi + ((lane & 15) >> 2)) * 144 + (32 * tb + 16 * ((lane >> 4) & 1) + 4 * (lane & 3)) * 2;
            const LAS unsigned char* vd = VT + (8 * hi + ((lane & 15) >> 2)) * 272 + (32 * vb + 16 * ((lane >> 4) & 1) + 4 * (lane & 3)) * 2;
#pragma unroll
            for (int s4 = 0; s4 < 4; ++s4) { const s16x4 a0 = vtr(ka + s4 * 16 * 144), a1 = vtr(ka + s4 * 16 * 144 + 4 * 144), b0 = vtr(vd + s4 * 16 * 272), b1 = vtr(vd + s4 * 16 * 272 + 4 * 272);
                const pg8::bf16x8 af = (pg8::bf16x8){a0[0], a0[1], a0[2], a0[3], a1[0], a1[1], a1[2], a1[3]}, bfr = (pg8::bf16x8){b0[0], b0[1], b0[2], b0[3], b1[0], b1[1], b1[2], b1[3]};
                acc = __builtin_amdgcn_mfma_f32_32x32x16_bf16(af, bfr, acc, 0, 0, 0); }
#pragma unroll
            for (int r = 0; r < 16; ++r) S0[r] = LAMS[32 * tb + crow(r, hi)] * (S0[r] + acc[r]); }
          if (ci == nch - 1 && (seg >= 256 || (seg & 7) == 7)) {
              float* op = (seg >= 256 ? P->out + O_GLAS + ((size_t)L * 64 + (seg - 256)) * 8192 : P->out + O_GLAP + ((size_t)L * 32 + (seg >> 3)) * 8192) + so;
#pragma unroll
              for (int r = 0; r < 16; ++r) op[((r & 3) + 8 * (r >> 2)) * 128] = S0[r]; } }
        __syncthreads();
        { float v[16]; float ss = 0.f;
#pragma unroll
          for (int j = 0; j < 16; ++j) { v[j] = O[t * 128 + 16 * q8 + j]; ss += v[j] * v[j]; }
          ss += __shfl_xor(ss, 1); ss += __shfl_xor(ss, 2); ss += __shfl_xor(ss, 4);
          const float rs = __builtin_amdgcn_rsqf(ss * (1.0f / 128.0f) + 1e-6f);
          if (live) {
              const float lr[16] = {bflo(l0.x), bfhi(l0.x), bflo(l0.y), bfhi(l0.y), bflo(l0.z), bfhi(l0.z), bflo(l0.w), bfhi(l0.w), bflo(l1.x), bfhi(l1.x), bflo(l1.y), bfhi(l1.y), bflo(l1.z), bfhi(l1.z), bflo(l1.w), bfhi(l1.w)};
              float y[16];
#pragma unroll
              for (int j = 0; j < 16; ++j) y[j] = v[j] * rs * gon[j] * lr[j];
              bf16* yo = (bf16*)(P->ws + WS_AB) + (size_t)3 * M * 512 + (size_t)(row0 + t) * 512 + h * 128 + 16 * q8;
              v4u w0, w1; w0.x = cvtpk(y[0], y[1]); w0.y = cvtpk(y[2], y[3]); w0.z = cvtpk(y[4], y[5]); w0.w = cvtpk(y[6], y[7]); w1.x = cvtpk(y[8], y[9]); w1.y = cvtpk(y[10], y[11]); w1.z = cvtpk(y[12], y[13]); w1.w = cvtpk(y[14], y[15]);
              *(GAS v4u*)yo = w0; *(GAS v4u*)(yo + 8) = w1; } }
        if (!has1) return false;
        seg = seg1; ci = ci1; c = c1; seg1 = seg2; ci1 = ci2; c1 = c2; has1 = has2;
        return true;
    };
    for (;;) { if (!step(in)) break; if (!step(in2)) break; }
}

template <int U> __device__ __forceinline__ void sg_batch(f32x16& c0, f32x16& c1, const GAS pg8::bf16x8* ap, const GAS pg8::bf16x8* b0, const GAS pg8::bf16x8* b1, int s) {
    pg8::bf16x8 a[U], w0[U], w1[U];
#pragma unroll
    for (int i = 0; i < U; ++i) { a[i] = ap[2 * (s + i)]; w0[i] = b0[2 * (s + i)]; w1[i] = b1[2 * (s + i)]; }
#pragma unroll
    for (int i = 0; i < U; ++i) { c0 = __builtin_amdgcn_mfma_f32_32x32x16_bf16(w0[i], a[i], c0, 0, 0, 0); c1 = __builtin_amdgcn_mfma_f32_32x32x16_bf16(w1[i], a[i], c1, 0, 0, 0); }
}
template <int B1OFF = 32> __device__ __forceinline__ void sg_accum(f32x16& c0, f32x16& c1, const bf16* A, int lda, const bf16* Bt, int ldb, int row0, int col0, int kbeg, int nsteps, int lane) {
    const int r32 = lane & 31, hi = lane >> 5;
    const GAS pg8::bf16x8* ap = (const GAS pg8::bf16x8*)(A + (size_t)(row0 + r32) * lda + kbeg + 8 * hi);
    const GAS pg8::bf16x8* b0 = (const GAS pg8::bf16x8*)(Bt + (size_t)(col0 + r32) * ldb + kbeg + 8 * hi);
    const GAS pg8::bf16x8* b1 = (const GAS pg8::bf16x8*)(Bt + (size_t)(col0 + B1OFF + r32) * ldb + kbeg + 8 * hi);
    asm volatile("" : "+s"(nsteps));
    int s = 0;
#pragma unroll 1
    for (; s + 8 <= nsteps; s += 8) sg_batch<8>(c0, c1, ap, b0, b1, s);
    if (nsteps & 4) { sg_batch<4>(c0, c1, ap, b0, b1, s); s += 4; }
    if (nsteps & 2) sg_batch<2>(c0, c1, ap, b0, b1, s);
}
__device__ __forceinline__ void sg_zero(f32x16& c) {
#pragma unroll
    for (int r = 0; r < 16; ++r) c[r] = 0.f;
}
__device__ __forceinline__ void sample_up_tiles(int L, int xc, int second, int gw, int NGW, int lane) {
    asm volatile("" : "+v"(lane)); const int r32 = lane & 31, hi = lane >> 5;
    for (int t = gw; t < 16 * 88; t += NGW) {
        KParams P = params_ptr(); unsigned char* ws = P->ws; const bf16* Bt = (const bf16*)(ws + WS_W + (size_t)L * LW + (second ? OW13B : OW13A));
        const int row0 = MP + 32 * (t / 88), hc = 32 * (t % 88), brow = (hc >> 7) * 256 + (hc & 127);
        f32x16 c0, c1; sg_zero(c0); sg_zero(c1);
        sg_accum<128>(c0, c1, (const bf16*)(ws + (xc ? WS_XB1 : WS_XB0)), DM, Bt, DM, row0, brow, 0, 64, lane);
        const int row = row0 + r32; const float rs = pg8::row_rstd((const float*)(ws + WS_SSQ0), row);
        bf16* hp = (bf16*)(ws + WS_HB) + (size_t)row * DFF + hc + 4 * hi;
#pragma unroll
        for (int a = 0; a < 4; ++a) { float h[4];
#pragma unroll
            for (int i = 0; i < 4; ++i) h[i] = pg8::silu_f(c0[4 * a + i] * rs) * (c1[4 * a + i] * rs);
            u32x2 w; w.x = cvtpk(h[0], h[1]); w.y = cvtpk(h[2], h[3]); *(GAS u32x2*)(hp + 8 * a) = w; }
    }
}
template <int MODE> __device__ __forceinline__ void sample_tiles(LAS unsigned char* lds, int L, int xc, int second, float alpha, int sq_out, int vcu, int G, int tid, int fin = 0) {
    asm volatile("" : "+v"(tid)); const int lane = tid & 63, wave = __builtin_amdgcn_readfirstlane(tid >> 6), r32 = lane & 31, hi = lane >> 5;
    LAS float* part = (LAS float*)lds;
    LAS float* part2 = part + 16384; asm volatile("" : "+v"(part2));
    for (int t = vcu; t < 256; t += G) {
        KParams P = params_ptr(); unsigned char* ws = P->ws; unsigned char* wl = ws + WS_W + (size_t)L * LW;
        const int row0 = MP + 32 * (t >> 4), tc = t & 15, col0 = 64 * tc;
        f32x16 c0, c1, d0, d1; sg_zero(c0); sg_zero(c1); sg_zero(d0); sg_zero(d1);
        if (MODE == 0) {
            if (sq_out == 1) sg_accum(c0, c1, (const bf16*)(ws + WS_HB), DFF, (const bf16*)(wl + (second ? OW2B : OW2A)), DFF, row0, col0, wave * 352, 22, lane);
            else sg_accum(c0, c1, (const bf16*)(ws + WS_MB), DM, (const bf16*)(wl + OWOUT), DM, row0, col0, wave * 128, 8, lane);
        } else if (MODE == 1) {
            sg_accum(c0, c1, (const bf16*)(ws + (xc ? WS_XB1 : WS_XB0)), DM, (const bf16*)(wl + OWPG), DM, row0, col0, wave * 128, 8, lane);
            sg_accum(d0, d1, (const bf16*)(ws + WS_PB) + (size_t)L * M * 256, 256, (const bf16*)(wl + OWPP), 256, row0, col0, wave * 32, 2, lane);
        } else {
            const unsigned char* gbp = ws + WS_GB + (size_t)(row0 + r32) * 4096 + col0 + 4 * hi;
            for (int b = 0; b < 4; ++b) {
                sg_zero(d0); sg_zero(d1);
                sg_accum(d0, d1, (const bf16*)(ws + WS_AB) + (size_t)b * M * 512, 512, (const bf16*)(wl + OWBR) + (size_t)b * 1024 * 512, 512, row0, col0, wave * 64, 4, lane);
#pragma unroll
                for (int a = 0; a < 4; ++a) { const unsigned g0 = *(const GAS unsigned*)(gbp + b * 1024 + 8 * a), g1 = *(const GAS unsigned*)(gbp + b * 1024 + 32 + 8 * a);
#pragma unroll
                    for (int i = 0; i < 4; ++i) { float f0 = (float)((g0 >> (8 * i)) & 255u), f1 = (float)((g1 >> (8 * i)) & 255u); f0 = (f0 > 1.0f ? f0 : 1.0f) * (1.0f / 255.0f); f1 = (f1 > 1.0f ? f1 : 1.0f) * (1.0f / 255.0f);
                        c0[4 * a + i] += f0 * d0[4 * a + i]; c1[4 * a + i] += f1 * d1[4 * a + i]; } }
            }
        }
#pragma unroll
        for (int r = 0; r < 16; ++r) { part[((wave * 32 + r) * 64) + lane] = c0[r]; part[((wave * 32 + 16 + r) * 64) + lane] = c1[r]; }
        if (MODE == 1) {
#pragma unroll
            for (int r = 0; r < 16; ++r) { part2[((wave * 32 + r) * 64) + lane] = d0[r]; part2[((wave * 32 + 16 + r) * 64) + lane] = d1[r]; }
        }
        __syncthreads();
        if (wave == 0) {
#pragma unroll 1
            for (int w = 1; w < 8; ++w) {
                const LAS float* pw_ = part + w * 2048 + lane;
#pragma unroll
                for (int r = 0; r < 16; ++r) { c0[r] += pw_[r * 64]; c1[r] += pw_[(16 + r) * 64]; }
                if (MODE == 1) { const LAS float* pd_ = part2 + w * 2048 + lane;
#pragma unroll
                    for (int r = 0; r < 16; ++r) { d0[r] += pd_[r * 64]; d1[r] += pd_[(16 + r) * 64]; } }
            }
            const int row = row0 + r32; const size_t rb = (size_t)row * 1024 + col0 + 4 * hi;
            if (MODE == 2) {
                bf16* mb = (bf16*)(ws + WS_MB) + rb;
#pragma unroll
                for (int a = 0; a < 4; ++a) { u32x2 w0, w1; w0.x = cvtpk(c0[4 * a], c0[4 * a + 1]); w0.y = cvtpk(c0[4 * a + 2], c0[4 * a + 3]); w1.x = cvtpk(c1[4 * a], c1[4 * a + 1]); w1.y = cvtpk(c1[4 * a + 2], c1[4 * a + 3]);
                    *(GAS u32x2*)(mb + 8 * a) = w0; *(GAS u32x2*)(mb + 32 + 8 * a) = w1; }
            } else {
                float* X = P->out + O_X + rb; bf16* XB = (bf16*)(ws + ((MODE == 1 ? (xc ^ 1) : xc) ? WS_XB1 : WS_XB0)) + rb; const bf16* XI = (const bf16*)(ws + (xc ? WS_XB1 : WS_XB0)) + rb; bf16* XL = (bf16*)(ws + WS_XL) + rb;
                float rs = 0.f; if (MODE == 1) rs = pg8::row_rstd((const float*)(ws + (sq_out ? WS_SSQ0 : WS_SSQ1)), row);
                float ss = 0.f;
#pragma unroll
                for (int j = 0; j < 2; ++j)
#pragma unroll
                    for (int a = 0; a < 4; ++a) { f32x4 v; const u32x2 h2 = *(const GAS u32x2*)(XI + 32 * j + 8 * a); u32x2 l2 = (u32x2){0u, 0u}; if (USE_XL) l2 = *(const GAS u32x2*)(XL + 32 * j + 8 * a);
                        f32x4 xo = (f32x4){bflo(h2.x) + bflo(l2.x), bfhi(h2.x) + bfhi(l2.x), bflo(h2.y) + bflo(l2.y), bfhi(h2.y) + bfhi(l2.y)};
#pragma unroll
                        for (int i = 0; i < 4; ++i) { const float cv = j ? c1[4 * a + i] : c0[4 * a + i]; if (MODE == 1) { const float dv = j ? d1[4 * a + i] : d0[4 * a + i]; v[i] = pg8::sigm(cv * rs) * dv * ((PROBE_DUP & 8192) ? alpha : 1.0f); } else v[i] = cv * alpha; }
                        xo = xo + v; if (fin) *(GAS f32x4*)(X + 32 * j + 8 * a) = xo; u32x2 w; w.x = cvtpk(xo[0], xo[1]); w.y = cvtpk(xo[2], xo[3]); *(GAS u32x2*)(XB + 32 * j + 8 * a) = w;
                        if (USE_XL) { u32x2 l; l.x = cvtpk(xo[0] - bflo(w.x), xo[1] - bfhi(w.x)); l.y = cvtpk(xo[2] - bflo(w.y), xo[3] - bfhi(w.y)); *(GAS u32x2*)(XL + 32 * j + 8 * a) = l; }
                        ss += (xo[0] * xo[0] + xo[1] * xo[1]) + (xo[2] * xo[2] + xo[3] * xo[3]); }
                ss += __shfl_xor(ss, 32);
                if (hi == 0) ((float*)(ws + (sq_out ? WS_SSQ1 : WS_SSQ0)))[(size_t)row * 16 + tc] = ss;
            }
        }
        __syncthreads();
    }
}

struct WaveQ { unsigned* heads; int n, s, tries; };
__device__ __forceinline__ int q_pull(WaveQ& q, int lane) {
    for (;;) {
        unsigned v = 0u; if (lane == 0) v = __hip_atomic_fetch_add(q.heads + 64 * q.s, 1u, __ATOMIC_RELAXED, __HIP_MEMORY_SCOPE_AGENT);
        const int u = (int)__builtin_amdgcn_readfirstlane(v) * 8 + q.s;
        if (u < q.n) return u;
        if (++q.tries >= 8) return q.n;
        q.s = (q.s + 1) & 7;
    }
}
__global__ void __launch_bounds__(NWAVES * 64, 2) hybrid_fwd(Params Pargs) {
    extern __shared__ __attribute__((aligned(16))) unsigned char lds_raw[];
    LAS unsigned char* lds = (LAS unsigned char*)lds_raw;
    const int tid = threadIdx.x, lane = tid & 63, wave = __builtin_amdgcn_readfirstlane(tid >> 6);
    const int G = gridDim.x, bx = blockIdx.x;
    const int vcu = (G % 8 == 0) ? (bx % 8) * (G / 8) + bx / 8 : bx;
    const int gw = vcu * NWAVES + wave, NGW = G * NWAVES;
    for (int u = tid; u < (LDS_BYTES - RING_BYTES) / 4; u += NWAVES * 64) ((LAS unsigned*)(lds + RING_BYTES))[u] = 0u;
    __syncthreads();
    (void)xcd_barrier_post((unsigned*)(params_ptr()->ws + WS_CTL) + CW_BAR, (volatile LAS unsigned*)(lds + MISC_OFF) + 8);
#define GRID_BAR() do { XcdBarrier b_; b_.bar = (unsigned*)(params_ptr()->ws + WS_CTL) + CW_BAR; b_.x = xb_xcc_id(); b_.st = (volatile LAS unsigned*)(lds + MISC_OFF) + 8; xcd_barrier(b_); } while (0)

    prologue(lds, gw, NGW, wave, lane);
    GRID_BAR();
#if PROBE_DUP & 16
    prologue(lds, gw, NGW, wave, lane);
    GRID_BAR();
#endif

    for (int hl = 0; hl < 2 * NL; ++hl) {
        const int L = hl >> 1, second = hl & 1, xc = L & 1;
        for (int rep_ = 0; rep_ < ((PROBE_DUP & 1) ? 2 : 1); ++rep_) {
        { KParams P = params_ptr(); unsigned char* ws = P->ws; unsigned char* wl = ws + WS_W + (size_t)L * LW;
          pg8::Gemm g{(const bf16*)(ws + (xc ? WS_XB1 : WS_XB0)), (const bf16*)(wl + (second ? OW13B : OW13A)), MP, 5632, DM}; pg8::RstdOrder S; S.init(MP, 5632, G, bx, WGM_UP); S.kp = P; S.sq = 0; S.rl = (LAS float*)(lds + RSTD_OFF); S.nd = 0; S.started = false;
          pg8::EpiSwiGLU E{P, (const LAS float*)(lds + RSTD_OFF)};
          pg8::gemm_phase<pg8::EpiSwiGLU, pg8::RstdOrder, true, true>(lds, g, S, E); }
        sample_up_tiles(L, xc, second, gw, NGW, lane);
        GRID_BAR();
        }
        for (int rep_ = 0; rep_ < ((PROBE_DUP & 2048) ? 2 : 1); ++rep_) {
        { KParams P = params_ptr(); unsigned char* ws = P->ws; unsigned char* wl = ws + WS_W + (size_t)L * LW;
          pg8::Gemm g{(const bf16*)(ws + WS_HB), (const bf16*)(wl + (second ? OW2B : OW2A)), MP, DM, DFF}; pg8::StaticOrder S; S.init(MP, DM, G, bx, WGM_X);
          pg8::EpiX<false> E{P, xc, xc, 1, (PROBE_DUP & 2048) ? 0.25f : 0.5f, nullptr, 0};
          pg8::gemm_phase<pg8::EpiX<false>, pg8::StaticOrder, true, true>(lds, g, S, E); }
        sample_tiles<0>(lds, L, xc, second, (PROBE_DUP & 2048) ? 0.25f : 0.5f, 1, vcu, G, tid);
        GRID_BAR();
        }
        if (!second) {
            for (int rep_ = 0; rep_ < ((PROBE_DUP & 2) ? 2 : 1); ++rep_) {
            { KParams P = params_ptr(); unsigned char* ws = P->ws; unsigned char* wl = ws + WS_W + (size_t)L * LW;
              pg8::Gemm g{(const bf16*)(ws + (xc ? WS_XB1 : WS_XB0)), (const bf16*)(wl + OWIN), M, NIN, DM}; pg8::RstdOrder S; S.init(M, NIN, G, bx, WGM_IN); S.kp = P; S.sq = 1; S.rl = (LAS float*)(lds + RSTD_OFF); S.nd = 0; S.started = false;
              pg8::EpiIn E{P, L, (const LAS float*)(lds + RSTD_OFF)};
              pg8::gemm_phase<pg8::EpiIn, pg8::RstdOrder, true, true>(lds, g, S, E); }
            GRID_BAR();
            }
            for (int rep_ = 0; rep_ < ((PROBE_DUP & 4) ? 2 : 1); ++rep_) {
#if PROBE_DUP & 262144
            { const unsigned long long t0_ = wall_clock64(); while (wall_clock64() - t0_ < 25000ull) __builtin_amdgcn_s_sleep(64); }
#endif
            for (int rq_ = 0; rq_ < ((PROBE_DUP & 32) ? 2 : 1); ++rq_) gla_pass_a_loop(lds, L, vcu, G, tid);
            for (int rq_ = 0; rq_ < ((PROBE_DUP & (64 | 256)) ? 2 : 1); ++rq_)
            { const int qn_ = (rq_ && (PROBE_DUP & 64)) ? 128 + 8192 : 128 + 8192 + M / 8 + 4096 + 256;
              WaveQ q{(unsigned*)(params_ptr()->ws + WS_CTL) + CW_Q + 512 * (2 * L) + 8192 * rq_, qn_, (int)(xb_xcc_id() & 7u), 0};
              int u = q_pull(q, lane);
              while (u < qn_) { const int un = q_pull(q, lane);
                  if (u < 128) sb_unit<true>(lds + wave * 16384, lane, L, 8192 + u);
                  else { const int k = u - 128;
                      if (k < 6 * 2048) { const int g6 = k / 6, r6 = k - 6 * g6; if (r6 < 4) sb_unit<false>(lds + wave * 16384, lane, L, 4 * g6 + r6); else pool_unit(L, 2 * g6 + (r6 - 4), lane); }
                      else { const int k2 = k - 6 * 2048;
                          if (k2 < 4096 + 256) gmlp_unit(lds + wave * 16384, lane, L, k2); else pool_unit(L, 4096 + (k2 - (4096 + 256)), lane); } }
                  u = un; } }
            GRID_BAR();
            for (int rq_ = 0; rq_ < ((PROBE_DUP & 512) ? 2 : 1); ++rq_) gla_pass_c_loop(lds, L, vcu, G, tid);
            GRID_BAR();
            }
            for (int rep_ = 0; rep_ < ((PROBE_DUP & 8) ? 2 : 1); ++rep_) {
            { KParams P = params_ptr(); unsigned char* ws = P->ws; unsigned char* wl = ws + WS_W + (size_t)L * LW;
              pg8::Gemm g{(const bf16*)(ws + WS_AB), (const bf16*)(wl + OWBR), 4 * M, 4 * DM, 512}; pg8::BranchOrder S{G, vcu};
              pg8::EpiBranch E{P};
              pg8::gemm_phase<pg8::EpiBranch, pg8::BranchOrder, true, true>(lds, g, S, E); }
            sample_tiles<2>(lds, L, xc, 0, 1.0f, 0, vcu, G, tid);
            GRID_BAR();
            }
            for (int rep_ = 0; rep_ < ((PROBE_DUP & 4096) ? 2 : 1); ++rep_) {
            { KParams P = params_ptr(); unsigned char* ws = P->ws; unsigned char* wl = ws + WS_W + (size_t)L * LW;
              pg8::Gemm g{(const bf16*)(ws + WS_MB), (const bf16*)(wl + OWOUT), MP, DM, DM}; pg8::StaticOrder S; S.init(MP, DM, G, bx, WGM_X);
              pg8::EpiX<false> E{P, xc, xc, 0, (PROBE_DUP & 4096) ? 0.5f : 1.0f, nullptr, 0};
              pg8::gemm_phase<pg8::EpiX<false>, pg8::StaticOrder, true, true>(lds, g, S, E); }
            sample_tiles<0>(lds, L, xc, 0, (PROBE_DUP & 4096) ? 0.5f : 1.0f, 0, vcu, G, tid);
            { KParams P = params_ptr(); unsigned char* ws = P->ws; unsigned char* wl = ws + WS_W + (size_t)L * LW;
              pg8::Gemm g{(const bf16*)(ws + WS_PB) + (size_t)L * M * 256, (const bf16*)(wl + OWPP), MP, DM, 256}; pg8::StaticOrder S; S.init(MP, DM, G, bx, WGM_X);
              pg8::EpiPlain E{P};
              pg8::gemm_phase<pg8::EpiPlain, pg8::StaticOrder, true, true>(lds, g, S, E); }
            GRID_BAR();
            }
        } else {
            for (int rep_ = 0; rep_ < ((PROBE_DUP & 8192) ? 2 : 1); ++rep_) {
            { KParams P = params_ptr(); unsigned char* ws = P->ws; unsigned char* wl = ws + WS_W + (size_t)L * LW;
              pg8::Gemm g{(const bf16*)(ws + (xc ? WS_XB1 : WS_XB0)), (const bf16*)(wl + OWPG), MP, DM, DM}; pg8::RstdOrder S; S.init(MP, DM, G, bx, WGM_X); S.kp = P; S.sq = 1; S.rl = (LAS float*)(lds + RSTD_OFF); S.nd = 0; S.started = false;
              pg8::EpiX<true> E{P, xc, xc ^ 1, 0, (PROBE_DUP & 8192) ? 0.5f : 1.0f, (const LAS float*)(lds + RSTD_OFF), hl == 2 * NL - 1};
              pg8::gemm_phase<pg8::EpiX<true>, pg8::RstdOrder, true, true>(lds, g, S, E); }
            sample_tiles<1>(lds, L, xc, 0, (PROBE_DUP & 8192) ? 0.5f : 1.0f, 0, vcu, G, tid, hl == 2 * NL - 1);
            GRID_BAR();
            }
        }
    }
#undef GRID_BAR
}

extern "C" void kernel_launch(void* const* d_in, const int* in_sizes, int n_in, void* d_out, int out_size, void* d_ws, size_t ws_size, hipStream_t stream) {
    static int grid = 0;
    if (grid == 0) {
        if (n_in != 32 || (size_t)out_size != O_END || ws_size < WS_END) { fprintf(stderr, "kernel_launch: unexpected shapes: n_in %d out %d ws %zu (want 32, %zu, >= %zu)\n", n_in, out_size, ws_size, (size_t)O_END, (size_t)WS_END); grid = -1; return; }
        int dev = 0, cus = 0, per_cu = 0;
        if (hipGetDevice(&dev) != hipSuccess || hipDeviceGetAttribute(&cus, hipDeviceAttributeMultiprocessorCount, dev) != hipSuccess) { grid = -1; return; }
        if (hipFuncSetAttribute((const void*)hybrid_fwd, hipFuncAttributeMaxDynamicSharedMemorySize, LDS_BYTES) != hipSuccess) { fprintf(stderr, "kernel_launch: hipFuncSetAttribute failed\n"); grid = -1; return; }
        if (hipOccupancyMaxActiveBlocksPerMultiprocessor(&per_cu, (const void*)hybrid_fwd, NWAVES * 64, LDS_BYTES) != hipSuccess || per_cu < 1) fprintf(stderr, "kernel_launch: occupancy query reports %d\n", per_cu);
        (void)hipGetLastError();
        grid = cus;
    }
    if (grid < 0) return;
    if (hipMemsetAsync((char*)d_ws + WS_CTL, 0, CTL_ZERO_BYTES, stream) != hipSuccess) return;
    Params p{};
    for (int i = 0; i < 32; ++i) p.in[i] = (const float*)d_in[i];
    p.out = (float*)d_out; p.ws = (unsigned char*)d_ws;
    hipLaunchKernelGGL(hybrid_fwd, dim3(grid), dim3(NWAVES * 64), LDS_BYTES, stream, p);
    const hipError_t le = hipPeekAtLastError();
    if (le != hipSuccess) fprintf(stderr, "kernel_launch: launch failed: %s\n", hipGetErrorName(le));
}
```

```cpp
#include <hip/hip_runtime.h>
#include <cstdio>
#include <cstdint>
#define GAS __attribute__((address_space(1)))
#define LAS __attribute__((address_space(3)))
typedef unsigned short bf16;
#ifndef PROBE_DUP
#define PROBE_DUP 0
#endif

constexpr int NWAVES = 8;
constexpr int DM = 1024, MP = 32768, MS = 512, M = MP + MS, NL = 4, DFF = 2816, NIN = 8960;
constexpr int NCHUNK = 2048 + 64;
constexpr int NSEQ = 32 + 64;
constexpr int NSEG = 256 + 64;
constexpr size_t O_X = 0, O_KP = (size_t)M * DM, O_VP = O_KP + (size_t)NL * MP * 512, O_POOLP = O_VP + (size_t)NL * MP * 512, O_GLAP = O_POOLP + (size_t)NL * 8 * 15 * 512,
    O_KS = O_GLAP + (size_t)NL * 8 * 4 * 64 * 128, O_VS = O_KS + (size_t)NL * MS * 512, O_POOLS = O_VS + (size_t)NL * MS * 512, O_GLAS = O_POOLS + (size_t)NL * 16 * 15 * 512,
    O_GVS = O_GLAS + (size_t)NL * 16 * 4 * 64 * 128, O_END = O_GVS + (size_t)NL * MS * 512;
constexpr size_t MiB = 1u << 20;
constexpr size_t WS_CTL = 0, CTL_ZERO_BYTES = 1 * MiB;
constexpr size_t WS_W = 2 * MiB, LW = 60 * MiB;
constexpr size_t OW13A = 0, OW2A = 11 * MiB, OW13B = 16 * MiB + MiB / 2, OW2B = 27 * MiB + MiB / 2, OWIN = 33 * MiB, OWBR = 50 * MiB + MiB / 2, OWOUT = 54 * MiB + MiB / 2, OWPG = 56 * MiB + MiB / 2,
    OWPP = 58 * MiB + MiB / 2, OWM = 59 * MiB;
constexpr size_t WS_XB0 = 242 * MiB, WS_XB1 = 307 * MiB, WS_SSQ0 = 372 * MiB, WS_SSQ1 = 375 * MiB, WS_HB = 378 * MiB;
constexpr size_t WS_XPB = 557 * MiB, WS_QB = 590 * MiB, WS_KB = 623 * MiB, WS_VB = 656 * MiB, WS_GUB = 689 * MiB, WS_GVB = 722 * MiB, WS_LVB = 755 * MiB, WS_LRB = 788 * MiB;
constexpr size_t WS_LQB = 821 * MiB, WS_LKB = 838 * MiB, WS_LAB = 855 * MiB, WS_GB = 872 * MiB, WS_AB = 1132 * MiB, WS_MB = 1262 * MiB, WS_PPB = 1327 * MiB, WS_PB = 1392 * MiB;
constexpr size_t WS_QT = 1457 * MiB, WS_KT = 1490 * MiB, WS_DS = 1523 * MiB, WS_SC = 1589 * MiB, WS_LAM = 1655 * MiB, WS_XL = 1656 * MiB, WS_END = 1721 * MiB;
static_assert(OW13A + (size_t)5632 * 1024 * 2 <= OW2A && OW2A + (size_t)1024 * 2816 * 2 <= OW13B && OW13B + (size_t)5632 * 1024 * 2 <= OW2B && OW2B + (size_t)1024 * 2816 * 2 <= OWIN &&
              OWIN + (size_t)NIN * 1024 * 2 <= OWBR && OWBR + (size_t)4 * 1024 * 512 * 2 <= OWOUT && OWOUT + 2 * MiB <= OWPG && OWPG + 2 * MiB <= OWPP && OWPP + MiB / 2 <= OWM && OWM + 131072 <= LW, "weight map");
static_assert(WS_W + NL * LW <= WS_XB0 && WS_XB0 + (size_t)M * DM * 2 <= WS_XB1 && WS_XB1 + (size_t)M * DM * 2 <= WS_SSQ0 && WS_SSQ0 + (size_t)M * 64 <= WS_SSQ1 && WS_SSQ1 + (size_t)M * 64 <= WS_HB &&
              WS_HB + (size_t)M * DFF * 2 <= WS_XPB && WS_XPB + (size_t)M * 1024 <= WS_QB && WS_LRB + (size_t)M * 1024 <= WS_LQB && WS_LQB + (size_t)M * 512 <= WS_LKB && WS_LAB + (size_t)M * 512 <= WS_GB &&
              WS_GB + (size_t)M * 8192 <= WS_AB && WS_AB + (size_t)4 * M * 1024 <= WS_MB && WS_MB + (size_t)M * 2048 <= WS_PPB && WS_PPB + (size_t)M * 2048 <= WS_PB && WS_PB + (size_t)4 * M * 512 <= WS_QT &&
              WS_QT + (size_t)M * 1024 <= WS_KT && WS_KT + (size_t)M * 1024 <= WS_DS && WS_DS + (size_t)NCHUNK * 32768 <= WS_SC && WS_SC + (size_t)NCHUNK * 32768 <= WS_LAM && WS_LAM + (size_t)NCHUNK * 256 <= WS_XL && WS_XL + (size_t)M * DM * 2 <= WS_END, "ws map");
constexpr int WGM_UP = 8, WGM_IN = 8, WGM_X = 8;
constexpr float SB_CUT = 48.f;
constexpr bool USE_XL = false;
constexpr int CW_BAR = 4096;
constexpr int CW_Q = 8192;
constexpr int RING_BYTES = 131072, MISC_OFF = RING_BYTES + 320, RSTD_OFF = RING_BYTES + 2048  , LDS_BYTES = 147456;

typedef float f32x16 __attribute__((ext_vector_type(16)));
typedef short s16x4 __attribute__((ext_vector_type(4)));
typedef short v4i16_t __attribute__((ext_vector_type(4)));
typedef unsigned u32x2 __attribute__((ext_vector_type(2)));

struct Params { const float* in[32]; float* out; unsigned char* ws; };
enum { I_XP = 0, I_XS, I_PP, I_PS, I_CK, I_CV, I_SPOOL, I_SGLA, I_N1, I_F1W1, I_F1W3, I_F1W2, I_NM, I_WIN, I_POOLW, I_POOLS, I_QN, I_KN, I_GWS, I_GB, I_WA2, I_BA, I_GON, I_WBR, I_WOUT, I_N2, I_F2W1,
       I_F2W3, I_F2W2, I_NPL, I_WPG, I_WPP };


typedef const __attribute__((address_space(4))) Params* KParams;
__device__ __forceinline__ KParams params_ptr() { KParams p = (KParams)__builtin_amdgcn_kernarg_segment_ptr(); asm volatile("" : "+s"(p)); return p; }
namespace pg8 {
#define PG8_LAS __attribute__((address_space(3)))
typedef unsigned short bf16_t;
typedef short bf16x8 __attribute__((ext_vector_type(8)));
typedef float f32x4 __attribute__((ext_vector_type(4)));
typedef unsigned u32x4 __attribute__((ext_vector_type(4)));
constexpr int BM = 256, BK = 64, HALF = 128, HTB = HALF * BK * 2  , STAGE_BYTES = 8 * HTB, NXCD = 8, WGM = 8;

__host__ __device__ __forceinline__ int lds_byte(int r, int c) { const int st = (r >> 4) * 2 + (c >> 5), rr = r & 15, cc = c & 31, ob = rr * 64 + cc * 2; return st * 1024 + (ob ^ (((ob >> 9) & 1) << 5)); }
__host__ __device__ __forceinline__ void stage_rc(int b, int& R, int& C) { const int st = b / 1024, sb = b % 1024, swz = sb ^ (((sb >> 9) & 1) << 5); R = (st >> 1) * 16 + swz / 64; C = (st & 1) * 32 + (swz % 64) / 2; }
__host__ __device__ __forceinline__ int perm32(int rho) { const int n = rho >> 4, i = rho & 15; return 8 * (i >> 2) + 4 * n + (i & 3); }

struct Unit { int pm, pn, slot; };
struct Gemm { const bf16_t* A; const bf16_t* Bt; int M, N, K; };

struct StaticOrder {
    int nM, nN, nwg, G, c, wgm;
    __host__ __device__ void init(int M, int N, int G_, int c_, int wgm_ = WGM) { nM = M / BM; nN = N / BM; nwg = nM * nN; G = G_; c = c_; wgm = wgm_; }
    __host__ __device__ bool next(int i, Unit& u) const {
        const long L = (long)i * G + c; if (L >= nwg) return false;
        int wgid = (int)L; { const int q = nwg / NXCD, r = nwg % NXCD, xcd = wgid % NXCD, off = wgid / NXCD; wgid = (xcd < r ? xcd * (q + 1) : r * (q + 1) + (xcd - r) * q) + off; }
        const int nig = wgm * nN, gid = wgid / nig, fm = gid * wgm, gsz = (nM - fm) < wgm ? (nM - fm) : wgm;
        u.pm = fm + ((wgid % nig) % gsz); u.pn = (wgid % nig) / gsz; u.slot = i & 1; return true;
    }
    __device__ __forceinline__ void a_ready(const Unit&) const {}
    __device__ __forceinline__ void done(const Unit&) const {}
};

typedef float f32x2 __attribute__((ext_vector_type(2)));
typedef __bf16 bf16x2_t __attribute__((ext_vector_type(2)));
__device__ __forceinline__ unsigned cvt_pk_bf16(float lo, float hi) { const bf16x2_t r = __builtin_convertvector((f32x2){lo, hi}, bf16x2_t); return __builtin_bit_cast(unsigned, r); }
__device__ __forceinline__ float sigm(float t) { return __builtin_amdgcn_rcpf(1.0f + __builtin_amdgcn_exp2f(-1.4426950408889634f * t)); }
__device__ __forceinline__ float silu_f(float t) { return t * sigm(t); }
__device__ __forceinline__ float gelu_tanh_f(float t) { return t * sigm(1.5957691216057308f * (t + 0.044715f * t * t * t)); }
__device__ __forceinline__ f32x2 sigm_arg2(f32x2 a) { const f32x2 d = (f32x2){__builtin_amdgcn_exp2f(a[0]), __builtin_amdgcn_exp2f(a[1])} + (f32x2){1.0f, 1.0f}; return (f32x2){__builtin_amdgcn_rcpf(d[0]), __builtin_amdgcn_rcpf(d[1])}; }
__device__ __forceinline__ f32x2 silu2(f32x2 t) { return t * sigm_arg2(t * (f32x2){-1.4426950408889634f, -1.4426950408889634f}); }
__device__ __forceinline__ f32x2 gelu_tanh2(f32x2 t) { constexpr float k0 = -1.4426950408889634f * 1.5957691216057308f, k1 = k0 * 0.044715f;
    return t * sigm_arg2(t * ((t * t) * (f32x2){k1, k1} + (f32x2){k0, k0})); }
__device__ __forceinline__ float bf_lo(unsigned w) { return __uint_as_float(w << 16); }
__device__ __forceinline__ float bf_hi(unsigned w) { return __uint_as_float(w & 0xffff0000u); }
__device__ __forceinline__ float row_rstd(const float* ssq, int row) {
    const f32x4* p = (const f32x4*)(ssq + (size_t)row * 16); const f32x4 a = p[0], b = p[1], c = p[2], d = p[3];
    const float s = (((a[0] + a[1]) + (a[2] + a[3])) + ((b[0] + b[1]) + (b[2] + b[3]))) + (((c[0] + c[1]) + (c[2] + c[3])) + ((d[0] + d[1]) + (d[2] + d[3])));
    return __builtin_amdgcn_rsqf(s * (1.0f / 1024.0f) + 1e-6f);
}
struct RstdOrder : StaticOrder {
    KParams kp; int sq; PG8_LAS float* rl; mutable int nd; mutable bool started;
    __device__ __forceinline__ bool next(int i, Unit& u) const { return StaticOrder::next(i, u); }
    __device__ __forceinline__ void fill(const Unit& u) const {
        int t = threadIdx.x; asm volatile("" : "+v"(t));
        if (t < 256) { KParams q = kp; asm volatile("" : "+s"(q)); rl[u.slot * 256 + t] = row_rstd((const float*)(q->ws + (sq ? WS_SSQ1 : WS_SSQ0)), u.pm * BM + t); }
    }
    __device__ __forceinline__ void a_ready(const Unit& u) const { if (!started) { started = true; fill(u); } }
    __device__ __forceinline__ void done(const Unit&) const { ++nd; Unit n; if (next(nd, n)) fill(n); }
};
__device__ __forceinline__ u32x4 pack8(const f32x4 a, const f32x4 b) { u32x4 w; w.x = cvt_pk_bf16(a[0], a[1]); w.y = cvt_pk_bf16(a[2], a[3]); w.z = cvt_pk_bf16(b[0], b[1]); w.w = cvt_pk_bf16(b[2], b[3]); return w; }

struct EpiSwiGLU {
    static constexpr bool PERM = true, AFTER_DRAIN = false, HAS_INIT = false;
    KParams kp; const PG8_LAS float* rl;
    __device__ __forceinline__ void operator()(const f32x4 (&acc)[2][2][4][2], const Unit& u, int wr, int wc, int fr, int fq) const {
        KParams q = kp; asm volatile("" : "+s"(q)); unsigned char* ws = q->ws;
        bf16_t* H = (bf16_t*)(ws + WS_HB); const PG8_LAS float* rt = rl + u.slot * 256 + wr * 64 + fr;
        const int col0 = u.pn * 128 + wc * 32 + 8 * fq;
#pragma unroll
        for (int ai = 0; ai < 2; ++ai)
#pragma unroll
            for (int m = 0; m < 4; ++m) {
                const int row = u.pm * BM + ai * HALF + wr * 64 + m * 16 + fr; const float rs = rt[ai * HALF + m * 16]; const float cexp = -1.4426950408889634f * rs, rs2 = rs * rs;
                const f32x2 c2 = (f32x2){cexp, cexp}, r2 = (f32x2){rs2, rs2};
                f32x4 h0, h1;
#pragma unroll
                for (int n = 0; n < 2; ++n)
#pragma unroll
                    for (int p2 = 0; p2 < 2; ++p2) { const f32x4 g4 = acc[ai][0][m][n], u4 = acc[ai][1][m][n];
                        const f32x2 g = p2 ? (f32x2){g4[2], g4[3]} : (f32x2){g4[0], g4[1]}, u = p2 ? (f32x2){u4[2], u4[3]} : (f32x2){u4[0], u4[1]};
                        const f32x2 t = g * c2; f32x2 d = (f32x2){__builtin_amdgcn_exp2f(t[0]), __builtin_amdgcn_exp2f(t[1])} + (f32x2){1.0f, 1.0f};
                        const f32x2 r = (f32x2){__builtin_amdgcn_rcpf(d[0]), __builtin_amdgcn_rcpf(d[1])}; const f32x2 hh = (g * u) * (r * r2);
                        if (n == 0) { h0[2 * p2] = hh[0]; h0[2 * p2 + 1] = hh[1]; } else { h1[2 * p2] = hh[0]; h1[2 * p2 + 1] = hh[1]; } }
                *(u32x4*)(H + (size_t)row * 2816 + col0) = pack8(h0, h1);
                if (m & 1) asm volatile("" ::: "memory");
            }
    }
};

template <bool PLE> struct EpiX {
    static constexpr bool PERM = true, AFTER_DRAIN = false, HAS_INIT = false;
    static constexpr int NB = PLE ? 2 : 1, MB_ = 4 / NB;
    KParams kp; int xc_in, xc_out, sq_out; float alpha; const PG8_LAS float* rl; int fin;
    __device__ __forceinline__ void init(f32x4 (&)[2][2][4][2], const Unit&, int, int, int, int) const {}
    __device__ __forceinline__ void operator()(const f32x4 (&acc)[2][2][4][2], const Unit& u, int wr, int wc, int fr, int fq) const {
        KParams q = kp; asm volatile("" : "+s"(q)); unsigned char* ws = q->ws; float* X = q->out + O_X;
        const bf16_t* XI = (const bf16_t*)(ws + (xc_in ? WS_XB1 : WS_XB0)); bf16_t* XB = (bf16_t*)(ws + (xc_out ? WS_XB1 : WS_XB0)); bf16_t* XL = (bf16_t*)(ws + WS_XL); bf16_t* ssq_dummy = nullptr; (void)ssq_dummy;
        float* ssq_out = (float*)(ws + (sq_out ? WS_SSQ1 : WS_SSQ0));
        const bf16_t* PP = (const bf16_t*)(ws + WS_PPB);
        const size_t off0 = (size_t)(u.pm * BM + wr * 64 + fr) * 1024 + u.pn * BM + wc * 32 + 8 * fq;
#pragma unroll
        for (int ab = 0; ab < 2 * NB; ++ab) { const int ai = ab / NB, mb = (ab % NB) * MB_;
            u32x4 xh[4][2], xl[4][2], pw[4][2];
#pragma unroll
            for (int m = mb; m < mb + MB_; ++m)
#pragma unroll
                for (int bj = 0; bj < 2; ++bj) { const size_t off = off0 + (size_t)(ai * HALF + m * 16) * 1024 + bj * HALF;
                    xh[m][bj] = *(const u32x4*)(XI + off); if (USE_XL) xl[m][bj] = *(const u32x4*)(XL + off); if (PLE) pw[m][bj] = *(const u32x4*)(PP + off); }
#pragma unroll
            for (int m = mb; m < mb + MB_; ++m) {
                float s = 0.f; float rs = 0.f; if (PLE) rs = rl[u.slot * 256 + ai * HALF + wr * 64 + m * 16 + fr];
#pragma unroll
                for (int bj = 0; bj < 2; ++bj) { const size_t off = off0 + (size_t)(ai * HALF + m * 16) * 1024 + bj * HALF;
                    f32x4 a0 = acc[ai][bj][m][0], a1 = acc[ai][bj][m][1];
                    if (PLE) { const u32x4 p4 = pw[m][bj];
                        a0[0] = sigm(a0[0] * rs) * bf_lo(p4.x); a0[1] = sigm(a0[1] * rs) * bf_hi(p4.x); a0[2] = sigm(a0[2] * rs) * bf_lo(p4.y); a0[3] = sigm(a0[3] * rs) * bf_hi(p4.y);
                        a1[0] = sigm(a1[0] * rs) * bf_lo(p4.z); a1[1] = sigm(a1[1] * rs) * bf_hi(p4.z); a1[2] = sigm(a1[2] * rs) * bf_lo(p4.w); a1[3] = sigm(a1[3] * rs) * bf_hi(p4.w);
#if PROBE_DUP & 8192
                        a0 = a0 * alpha; a1 = a1 * alpha;
#endif
                    } else { a0 = a0 * alpha; a1 = a1 * alpha; }
                    const u32x4 h4 = xh[m][bj]; u32x4 l4 = (u32x4){0u, 0u, 0u, 0u}; if (USE_XL) l4 = xl[m][bj];
                    const f32x4 x0 = (f32x4){bf_lo(h4.x) + bf_lo(l4.x), bf_hi(h4.x) + bf_hi(l4.x), bf_lo(h4.y) + bf_lo(l4.y), bf_hi(h4.y) + bf_hi(l4.y)} + a0;
                    const f32x4 x1 = (f32x4){bf_lo(h4.z) + bf_lo(l4.z), bf_hi(h4.z) + bf_hi(l4.z), bf_lo(h4.w) + bf_lo(l4.w), bf_hi(h4.w) + bf_hi(l4.w)} + a1;
                    const u32x4 hw = pack8(x0, x1);
                    const f32x4 r0 = x0 - (f32x4){bf_lo(hw.x), bf_hi(hw.x), bf_lo(hw.y), bf_hi(hw.y)}, r1 = x1 - (f32x4){bf_lo(hw.z), bf_hi(hw.z), bf_lo(hw.w), bf_hi(hw.w)};
                    *(u32x4*)(XB + off) = hw; if (USE_XL) *(u32x4*)(XL + off) = pack8(r0, r1);
                    if (fin) { *(f32x4*)(X + off) = x0; *(f32x4*)(X + off + 4) = x1; }
                    s += ((x0[0] * x0[0] + x0[1] * x0[1]) + (x0[2] * x0[2] + x0[3] * x0[3])) + ((x1[0] * x1[0] + x1[1] * x1[1]) + (x1[2] * x1[2] + x1[3] * x1[3]));
                }
                s += __shfl_xor(s, 16); s += __shfl_xor(s, 32);
                if (fq == 0) ssq_out[(size_t)(u.pm * BM + ai * HALF + wr * 64 + m * 16 + fr) * 16 + u.pn * 4 + wc] = s;
            }
            asm volatile("" ::: "memory");
        }
    }
};

struct EpiIn {
    static constexpr bool PERM = true, AFTER_DRAIN = false, HAS_INIT = false;
    KParams kp; int L; const PG8_LAS float* rl;
    __device__ __forceinline__ void operator()(const f32x4 (&acc)[2][2][4][2], const Unit& u, int wr, int wc, int fr, int fq) const {
        KParams q = kp; asm volatile("" : "+s"(q)); unsigned char* ws = q->ws; float* out = q->out;
        const PG8_LAS float* rt = rl + u.slot * 256 + wr * 64 + fr;
        const int t = u.pn; const bool samp = u.pm >= 128;
        if (t >= 2 && t < 6) {
            const bool isk = t >= 4; const float* gn = q->in[isk ? I_KN : I_QN] + L * 64; bf16_t* dst = (bf16_t*)(ws + (isk ? WS_KB : WS_QB));
            float* fo = isk ? (samp ? out + O_KS + (size_t)L * MS * 512 - (size_t)32768 * 512 : out + O_KP + (size_t)L * MP * 512) : nullptr;
            const float sc = isk ? 1.0f : 0.125f * 1.4426950408889634f;
            f32x4 g[2][2];
#pragma unroll
            for (int bj = 0; bj < 2; ++bj)
#pragma unroll
                for (int n = 0; n < 2; ++n) g[bj][n] = *(const f32x4*)(gn + 32 * bj + 8 * fq + 4 * n) * sc;
            const int hcol = (4 * (t & 1) + wc) * 64 + 8 * fq;
#pragma unroll
            for (int ai = 0; ai < 2; ++ai)
#pragma unroll
                for (int m = 0; m < 4; ++m) {
                    const int row = u.pm * BM + ai * HALF + wr * 64 + m * 16 + fr; const float rs = rt[ai * HALF + m * 16];
                    f32x4 v[2][2]; float ss = 0.f;
#pragma unroll
                    for (int bj = 0; bj < 2; ++bj)
#pragma unroll
                        for (int n = 0; n < 2; ++n) { v[bj][n] = acc[ai][bj][m][n] * rs; ss += (v[bj][n][0] * v[bj][n][0] + v[bj][n][1] * v[bj][n][1]) + (v[bj][n][2] * v[bj][n][2] + v[bj][n][3] * v[bj][n][3]); }
                    ss += __shfl_xor(ss, 16); ss += __shfl_xor(ss, 32);
                    const float hr = __builtin_amdgcn_rsqf(ss * (1.0f / 64.0f) + 1e-6f);
#pragma unroll
                    for (int bj = 0; bj < 2; ++bj) { const f32x4 o0 = v[bj][0] * hr * g[bj][0], o1 = v[bj][1] * hr * g[bj][1];
                        const size_t off = (size_t)row * 512 + hcol + 32 * bj;
                        *(u32x4*)(dst + off) = pack8(o0, o1);
                        if (fo) { __builtin_nontemporal_store(o0, (f32x4*)(fo + off)); __builtin_nontemporal_store(o1, (f32x4*)(fo + off + 4)); }   }
                    asm volatile("" ::: "memory");
                }
            return;
        }
        if (t >= 18 && t < 34) {
            unsigned char* g8 = ws + WS_GB + (size_t)(256 * (t - 18)) + wc * 32 + 8 * fq;
#pragma unroll
            for (int ai = 0; ai < 2; ++ai)
#pragma unroll
                for (int m = 0; m < 4; ++m) {
                    const int row = u.pm * BM + ai * HALF + wr * 64 + m * 16 + fr; const float cexp = -1.4426950408889634f * rt[ai * HALF + m * 16];
#pragma unroll
                    for (int bj = 0; bj < 2; ++bj) { unsigned w0 = 0u, w1 = 0u;
#pragma unroll
                        for (int n = 0; n < 2; ++n)
#pragma unroll
                            for (int p2 = 0; p2 < 2; ++p2) {
                                const f32x4 a4 = acc[ai][bj][m][n]; const f32x2 a = p2 ? (f32x2){a4[2], a4[3]} : (f32x2){a4[0], a4[1]};
                                const f32x2 tt = a * (f32x2){cexp, cexp}; const f32x2 e = (f32x2){__builtin_amdgcn_exp2f(tt[0]), __builtin_amdgcn_exp2f(tt[1])};
                                const f32x2 d = e * (f32x2){1.0f / 255.0f, 1.0f / 255.0f} + (f32x2){1.0f / 255.0f, 1.0f / 255.0f};
                                const float y0 = __builtin_amdgcn_rcpf(d[0]), y1 = __builtin_amdgcn_rcpf(d[1]);
                                if (n == 0) { w0 = __builtin_amdgcn_cvt_pk_u8_f32(y0, 2 * p2, w0); w0 = __builtin_amdgcn_cvt_pk_u8_f32(y1, 2 * p2 + 1, w0); }
                                else { w1 = __builtin_amdgcn_cvt_pk_u8_f32(y0, 2 * p2, w1); w1 = __builtin_amdgcn_cvt_pk_u8_f32(y1, 2 * p2 + 1, w1); } }
                        typedef unsigned u32x2e __attribute__((ext_vector_type(2)));
                        __builtin_nontemporal_store((u32x2e){w0, w1}, (u32x2e*)(g8 + (size_t)row * 4096 + bj * HALF)); }
                    asm volatile("" ::: "memory");
                }
            return;
        }
        bf16_t* dst; int ld, dcol, act = 0; float* fo = nullptr;
        size_t wo;
        if (t < 2) { wo = WS_XPB; ld = 512; dcol = 256 * t; }
        else if (t < 8) { wo = WS_VB; ld = 512; dcol = 256 * (t - 6); fo = samp ? out + O_VS + (size_t)L * MS * 512 - (size_t)32768 * 512 : out + O_VP + (size_t)L * MP * 512; }
        else if (t < 10) { wo = WS_GUB; ld = 512; dcol = 256 * (t - 8); act = 1; }
        else if (t < 12) { wo = WS_GVB; ld = 512; dcol = 256 * (t - 10); act = 1; fo = samp ? out + O_GVS + (size_t)L * MS * 512 - (size_t)32768 * 512 : nullptr; }
        else if (t == 12) { wo = WS_LQB; ld = 256; dcol = 0; }
        else if (t == 13) { wo = WS_LKB; ld = 256; dcol = 0; }
        else if (t < 16) { wo = WS_LVB; ld = 512; dcol = 256 * (t - 14); }
        else if (t < 18) { wo = WS_LRB; ld = 512; dcol = 256 * (t - 16); act = 2; }
        else { wo = WS_LAB; ld = 256; dcol = 0; }
        dst = (bf16_t*)(ws + wo);
#pragma unroll
        for (int ai = 0; ai < 2; ++ai)
#pragma unroll
            for (int m = 0; m < 4; ++m) {
                const int row = u.pm * BM + ai * HALF + wr * 64 + m * 16 + fr; const float rs = rt[ai * HALF + m * 16];
#pragma unroll
                for (int bj = 0; bj < 2; ++bj) {
                    f32x4 v0 = acc[ai][bj][m][0] * rs, v1 = acc[ai][bj][m][1] * rs;
                    if (act == 1) {
#pragma unroll
                        for (int j = 0; j < 4; j += 2) { const f32x2 a = gelu_tanh2((f32x2){v0[j], v0[j + 1]}), b = gelu_tanh2((f32x2){v1[j], v1[j + 1]}); v0[j] = a[0]; v0[j + 1] = a[1]; v1[j] = b[0]; v1[j + 1] = b[1]; }
                    } else if (act == 2) {
#pragma unroll
                        for (int j = 0; j < 4; j += 2) { const f32x2 a = silu2((f32x2){v0[j], v0[j + 1]}), b = silu2((f32x2){v1[j], v1[j + 1]}); v0[j] = a[0]; v0[j + 1] = a[1]; v1[j] = b[0]; v1[j + 1] = b[1]; }
                    }
                    const int col = dcol + bj * HALF + wc * 32 + 8 * fq;
                    __builtin_nontemporal_store(pack8(v0, v1), (u32x4*)(dst + (size_t)row * ld + col));
                    if (fo) { float* f = fo + (size_t)row * 512 + col; __builtin_nontemporal_store(v0, (f32x4*)f); __builtin_nontemporal_store(v1, (f32x4*)(f + 4)); }
                }
                if (m & 1) asm volatile("" ::: "memory");
            }
    }
};

struct EpiBranch {
    static constexpr bool PERM = true, AFTER_DRAIN = false, HAS_INIT = true;
    KParams kp;
    __device__ __forceinline__ void init(f32x4 (&acc)[2][2][4][2], const Unit& u, int, int, int, int) const {
        if (u.pm < 130) {
#pragma unroll
            for (int a = 0; a < 2; ++a)
#pragma unroll
                for (int b = 0; b < 2; ++b)
#pragma unroll
                    for (int m = 0; m < 4; ++m)
#pragma unroll
                        for (int n = 0; n < 2; ++n) acc[a][b][m][n] = (f32x4){0.f, 0.f, 0.f, 0.f};
        }
    }
    __device__ __forceinline__ void operator()(const f32x4 (&acc_)[2][2][4][2], const Unit& u, int wr, int wc, int fr, int fq) const {
        f32x4 (&acc)[2][2][4][2] = const_cast<f32x4 (&)[2][2][4][2]>(acc_);
        KParams q = kp; asm volatile("" : "+s"(q)); unsigned char* ws = q->ws; const unsigned char* G = ws + WS_GB; bf16_t* MB = (bf16_t*)(ws + WS_MB);
        const int b = u.pm / 130, pm = u.pm - b * 130, pn = u.pn & 3;
        const int row0 = pm * BM + wr * 64 + fr, col0 = pn * BM + wc * 32 + 8 * fq;
        typedef unsigned u32x2e __attribute__((ext_vector_type(2)));
#pragma unroll
        for (int ab = 0; ab < 2; ++ab) { const int ai = ab;
            u32x2e gw[4][2], gn[4][2];
#pragma unroll
            for (int m = 0; m < 4; ++m)
#pragma unroll
                for (int bj = 0; bj < 2; ++bj) { const int row = row0 + ai * HALF + m * 16, col = col0 + bj * HALF;
                    gw[m][bj] = *(const u32x2e*)(G + (size_t)row * 4096 + b * 1024 + col); if (b < 3) gn[m][bj] = *(const u32x2e*)(G + (size_t)row * 4096 + (b + 1) * 1024 + col); }
#pragma unroll
            for (int m = 0; m < 4; ++m)
#pragma unroll
                for (int bj = 0; bj < 2; ++bj) { const int row = row0 + ai * HALF + m * 16, col = col0 + bj * HALF; const u32x2e g2 = gw[m][bj];
                    float f[8] = {(float)(g2.x & 255u), (float)((g2.x >> 8) & 255u), (float)((g2.x >> 16) & 255u), (float)(g2.x >> 24), (float)(g2.y & 255u), (float)((g2.y >> 8) & 255u), (float)((g2.y >> 16) & 255u), (float)(g2.y >> 24)};
#pragma unroll
                    for (int j = 0; j < 8; ++j) f[j] = f[j] > 1.0f ? f[j] : 1.0f;
                    if (b < 3) { const u32x2e n2 = gn[m][bj]; const float d[8] = {(float)(n2.x & 255u), (float)((n2.x >> 8) & 255u), (float)((n2.x >> 16) & 255u), (float)(n2.x >> 24), (float)(n2.y & 255u), (float)((n2.y >> 8) & 255u), (float)((n2.y >> 16) & 255u), (float)(n2.y >> 24)};
#pragma unroll
                        for (int j = 0; j < 8; ++j) f[j] *= __builtin_amdgcn_rcpf(d[j] > 1.0f ? d[j] : 1.0f); }
                    else {
#pragma unroll
                        for (int j = 0; j < 8; ++j) f[j] *= (1.0f / 255.0f); }
                    f32x4 v0 = acc[ai][bj][m][0], v1 = acc[ai][bj][m][1];
                    v0[0] *= f[0]; v0[1] *= f[1]; v0[2] *= f[2]; v0[3] *= f[3]; v1[0] *= f[4]; v1[1] *= f[5]; v1[2] *= f[6]; v1[3] *= f[7];
                    if (b < 3) { acc[ai][bj][m][0] = v0; acc[ai][bj][m][1] = v1; }
                    else *(u32x4*)(MB + (size_t)row * 1024 + col) = pack8(v0, v1); }
            asm volatile("" ::: "memory");
        }
    }
};
struct BranchOrder {
    int G, c;
    __device__ __forceinline__ bool next(int i, Unit& u) const { const int tl = (i >> 2) * G + c; if (tl >= 512) return false;   const int b = i & 3; u.pm = b * 130 + (tl >> 2); u.pn = b * 4 + (tl & 3); u.slot = 0; return true; }
    __device__ __forceinline__ void a_ready(const Unit&) const {}
    __device__ __forceinline__ void done(const Unit&) const {}
};
struct EpiPlain {
    static constexpr bool PERM = true, AFTER_DRAIN = false, HAS_INIT = false;
    KParams kp;
    __device__ __forceinline__ void operator()(const f32x4 (&acc)[2][2][4][2], const Unit& u, int wr, int wc, int fr, int fq) const {
        KParams q = kp; asm volatile("" : "+s"(q)); bf16_t* O = (bf16_t*)(q->ws + WS_PPB); const int ldc = 1024;
#pragma unroll
        for (int ai = 0; ai < 2; ++ai)
#pragma unroll
            for (int m = 0; m < 4; ++m) {
                const int row = u.pm * BM + ai * HALF + wr * 64 + m * 16 + fr;
#pragma unroll
                for (int bj = 0; bj < 2; ++bj) *(u32x4*)(O + (size_t)row * ldc + u.pn * BM + bj * HALF + wc * 32 + 8 * fq) = pack8(acc[ai][bj][m][0], acc[ai][bj][m][1]);
            }
    }
};
template <class Epi, class Sched, bool ALIGN_EPI = false, bool SP2 = false>
__device__ __forceinline__ void gemm_phase(PG8_LAS unsigned char* lds, const Gemm g, const Sched& S, const Epi& E) {
    int tid = threadIdx.x; asm volatile("" : "+v"(tid));
    const int wid = __builtin_amdgcn_readfirstlane(tid >> 6), lane = tid & 63, wr = wid >> 2, wc = wid & 3, fr = lane & 15, fq = lane >> 4;
    int K = g.K; asm volatile("" : "+s"(K)); const int nt = K / BK;
    unsigned voffA[2], voffB[2];
#pragma unroll
    for (int i = 0; i < 2; ++i) { int R, C; stage_rc(tid * 16 + i * 8192, R, C); const int Rb = Epi::PERM ? ((R & ~31) + perm32(R & 31)) : R;
        voffA[i] = (unsigned)(R * K + C) * 2u; voffB[i] = (unsigned)(Rb * K + C) * 2u; }
    const size_t kstep = (size_t)(BK * 2);
    const size_t hstep = (size_t)HALF * K * 2;
    const size_t tstep = 2 * hstep;
    const unsigned ldsw = (unsigned)wid * 1024u;
    const int aoff = lds_byte(wr * 64 + fr, fq * 8), boff = lds_byte(wc * 32 + fr, fq * 8);
#define PG8_SA(b, h) (((b) * 2 + (h)) * HTB)
#define PG8_SB(b, h) ((4 + (b) * 2 + (h)) * HTB)
#define PG8_STAGE(bufoff, gbase, voff) do { _Pragma("unroll") for (int _i = 0; _i < 2; ++_i) \
        __builtin_amdgcn_global_load_lds((const unsigned*)((const char*)(gbase) + (voff)[_i]), (PG8_LAS unsigned*)(lds + (bufoff) + ldsw + _i * 8192), 16, 0, 0); } while (0)
#define PG8_LDA(dst, b, h) do { _Pragma("unroll") for (int m = 0; m < 4; ++m) _Pragma("unroll") for (int k = 0; k < 2; ++k) dst[m][k] = *(const PG8_LAS bf16x8*)(lds + PG8_SA(b, h) + aoff + m * 2048 + k * 1024); } while (0)
#define PG8_LDB(dst, b, h) do { _Pragma("unroll") for (int n = 0; n < 2; ++n) _Pragma("unroll") for (int k = 0; k < 2; ++k) dst[n][k] = *(const PG8_LAS bf16x8*)(lds + PG8_SB(b, h) + boff + n * 2048 + k * 1024); } while (0)
#define PG8_MMA(ai, bj, At, Bt) do { __builtin_amdgcn_s_setprio(1); _Pragma("unroll") for (int m = 0; m < 4; ++m) _Pragma("unroll") for (int n = 0; n < 2; ++n) _Pragma("unroll") for (int k = 0; k < 2; ++k) \
        acc[ai][bj][m][n] = __builtin_amdgcn_mfma_f32_16x16x32_bf16(Bt[n][k], At[m][k], acc[ai][bj][m][n], 0, 0, 0); __builtin_amdgcn_s_setprio(0); } while (0)
#define PG8_WAIT_V(n) asm volatile("s_waitcnt vmcnt(" #n ")" ::: "memory")
#define PG8_WAIT_L(n) asm volatile("s_waitcnt lgkmcnt(" #n ")" ::: "memory")
#define PG8_BAR __builtin_amdgcn_s_barrier()
#define PG8_SCHED __builtin_amdgcn_sched_barrier(0)
    Unit cur, nxt; int ui = 0;
    if (!S.next(0, cur)) return;
    f32x4 acc[2][2][4][2];
    if constexpr (Epi::HAS_INIT) E.init(acc, cur, wr, wc, fr, fq);
    else {
#pragma unroll
    for (int a = 0; a < 2; ++a)
#pragma unroll
        for (int b = 0; b < 2; ++b)
#pragma unroll
            for (int m = 0; m < 4; ++m)
#pragma unroll
                for (int n = 0; n < 2; ++n) acc[a][b][m][n] = (f32x4){0.f, 0.f, 0.f, 0.f};
    }
    bf16x8 At[4][2], B0[2][2], B1[2][2];
    const char* cA = (const char*)g.A + (size_t)cur.pm * tstep; const char* cB = (const char*)g.Bt + (size_t)cur.pn * tstep;
    S.a_ready(cur);
    if constexpr (SP2) {
        PG8_STAGE(PG8_SB(0, 0), cB, voffB); PG8_STAGE(PG8_SB(0, 1), cB + hstep, voffB); PG8_STAGE(PG8_SA(0, 0), cA, voffA); PG8_STAGE(PG8_SA(0, 1), cA + hstep, voffA);
        if (wr == 1) PG8_BAR;
        PG8_WAIT_V(2); PG8_BAR;
        PG8_STAGE(PG8_SB(1, 0), cB + kstep, voffB); PG8_STAGE(PG8_SA(1, 0), cA + kstep, voffA); PG8_STAGE(PG8_SB(1, 1), cB + hstep + kstep, voffB);
        PG8_WAIT_V(6); PG8_BAR;
    } else {
        PG8_STAGE(PG8_SB(0, 0), cB, voffB); PG8_STAGE(PG8_SA(0, 0), cA, voffA); PG8_STAGE(PG8_SB(0, 1), cB + hstep, voffB); PG8_STAGE(PG8_SA(0, 1), cA + hstep, voffA);
        if (wr == 1) PG8_BAR;
        PG8_WAIT_V(4); PG8_BAR;
        PG8_STAGE(PG8_SB(1, 0), cB + kstep, voffB); PG8_STAGE(PG8_SA(1, 0), cA + kstep, voffA); PG8_STAGE(PG8_SB(1, 1), cB + hstep + kstep, voffB);
        PG8_WAIT_V(6); PG8_BAR;
    }
    for (;;) {
        const bool has_next = S.next(ui + 1, nxt);
        const char* nA = has_next ? (const char*)g.A + (size_t)nxt.pm * tstep : cA; const char* nB = has_next ? (const char*)g.Bt + (size_t)nxt.pn * tstep : cB;
        for (int t = 0; t < nt; t += 2) {
            const bool last = (t == nt - 2);
            const char* a1 = cA + (size_t)(t + 1) * kstep;
            const char* a2 = last ? nA : cA + (size_t)(t + 2) * kstep; const char* b2 = last ? nB : cB + (size_t)(t + 2) * kstep;
            const char* a3 = a2 + kstep; const char* b3 = b2 + kstep;
            if (last && has_next) S.a_ready(nxt);
            if constexpr (SP2) {
            PG8_LDB(B0, 0, 0); PG8_LDB(B1, 0, 1); PG8_SCHED; PG8_LDA(At, 0, 0); PG8_STAGE(PG8_SA(1, 1), a1 + hstep, voffA);
            PG8_WAIT_V(8); PG8_WAIT_L(0); PG8_BAR; PG8_MMA(0, 0, At, B0); PG8_MMA(0, 1, At, B1); PG8_BAR; PG8_SCHED;
            PG8_LDA(At, 0, 1); PG8_STAGE(PG8_SB(0, 0), b2, voffB); PG8_STAGE(PG8_SB(0, 1), b2 + hstep, voffB); PG8_STAGE(PG8_SA(0, 0), a2, voffA);
            PG8_WAIT_V(8); PG8_WAIT_L(0); PG8_BAR; PG8_MMA(1, 0, At, B0); PG8_MMA(1, 1, At, B1); PG8_BAR; PG8_SCHED;
            PG8_LDB(B0, 1, 0); PG8_LDB(B1, 1, 1); PG8_SCHED; PG8_LDA(At, 1, 0); PG8_STAGE(PG8_SA(0, 1), a2 + hstep, voffA);
            PG8_WAIT_V(8); PG8_WAIT_L(0); PG8_BAR; PG8_MMA(0, 0, At, B0); PG8_MMA(0, 1, At, B1); PG8_BAR; PG8_SCHED;
            PG8_LDA(At, 1, 1); PG8_STAGE(PG8_SB(1, 0), b3, voffB); PG8_STAGE(PG8_SB(1, 1), b3 + hstep, voffB); PG8_STAGE(PG8_SA(1, 0), a3, voffA);
            PG8_WAIT_V(8); PG8_WAIT_L(0); PG8_BAR; PG8_MMA(1, 0, At, B0); PG8_MMA(1, 1, At, B1); PG8_BAR; PG8_SCHED;
            } else {
            PG8_LDB(B0, 0, 0); PG8_SCHED; PG8_LDA(At, 0, 0); PG8_STAGE(PG8_SA(1, 1), a1 + hstep, voffA);
            PG8_WAIT_L(8); PG8_BAR; PG8_WAIT_L(0); PG8_MMA(0, 0, At, B0); PG8_BAR; PG8_SCHED;
            PG8_LDB(B1, 0, 1); PG8_STAGE(PG8_SB(0, 0), b2, voffB);
            PG8_BAR; PG8_WAIT_L(0); PG8_MMA(0, 1, At, B1); PG8_BAR;
            PG8_LDA(At, 0, 1); PG8_STAGE(PG8_SA(0, 0), a2, voffA);
            PG8_BAR; PG8_WAIT_L(0); PG8_MMA(1, 0, At, B0); PG8_BAR; PG8_SCHED;
            PG8_STAGE(PG8_SB(0, 1), b2 + hstep, voffB);
            PG8_WAIT_V(6); PG8_BAR; PG8_MMA(1, 1, At, B1); PG8_BAR;
            PG8_LDB(B0, 1, 0); PG8_SCHED; PG8_LDA(At, 1, 0); PG8_STAGE(PG8_SA(0, 1), a2 + hstep, voffA);
            PG8_WAIT_L(8); PG8_BAR; PG8_WAIT_L(0); PG8_MMA(0, 0, At, B0); PG8_BAR; PG8_SCHED;
            PG8_LDB(B1, 1, 1); PG8_STAGE(PG8_SB(1, 0), b3, voffB);
            PG8_BAR; PG8_WAIT_L(0); PG8_MMA(0, 1, At, B1); PG8_BAR;
            PG8_LDA(At, 1, 1); PG8_STAGE(PG8_SA(1, 0), a3, voffA);
            PG8_BAR; PG8_WAIT_L(0); PG8_MMA(1, 0, At, B0); PG8_BAR; PG8_SCHED;
            PG8_STAGE(PG8_SB(1, 1), b3 + hstep, voffB);
            PG8_WAIT_V(6); PG8_BAR; PG8_MMA(1, 1, At, B1); PG8_BAR;
            }
        }
        if constexpr (ALIGN_EPI) { if (wr == 0) PG8_BAR; }
        if constexpr (!Epi::AFTER_DRAIN) { E(acc, cur, wr, wc, fr, fq); S.done(cur); }
        if (!has_next) break;
        if constexpr (Epi::HAS_INIT) E.init(acc, nxt, wr, wc, fr, fq);
        else {
#pragma unroll
        for (int a = 0; a < 2; ++a)
#pragma unroll
            for (int b = 0; b < 2; ++b)
#pragma unroll
                for (int m = 0; m < 4; ++m)
#pragma unroll
                    for (int n = 0; n < 2; ++n) acc[a][b][m][n] = (f32x4){0.f, 0.f, 0.f, 0.f};
        }
        cur = nxt; cA = nA; cB = nB; ++ui;
        if constexpr (ALIGN_EPI) { if (wr == 1) PG8_BAR; }
    }
    PG8_WAIT_V(0);
    if constexpr (!ALIGN_EPI) { if (wr == 0) PG8_BAR; }
    PG8_BAR;
    if constexpr (Epi::AFTER_DRAIN) { E.fused(acc, cur, wr, wc, fr, fq, lds, wid, lane); S.done(cur); }
#undef PG8_SA
#undef PG8_SB
#undef PG8_STAGE
#undef PG8_LDA
#undef PG8_LDB
#undef PG8_MMA
#undef PG8_WAIT_V
#undef PG8_WAIT_L
#undef PG8_BAR
#undef PG8_SCHED
}
}
typedef unsigned v4u __attribute__((ext_vector_type(4)));
typedef float f32x4 __attribute__((ext_vector_type(4)));
typedef short bf16x8 __attribute__((ext_vector_type(8)));
typedef GAS unsigned gu32;
typedef GAS unsigned long long gu64;
#define RLX_AGENT __ATOMIC_RELAXED, __HIP_MEMORY_SCOPE_AGENT
#define LDS_WAIT() asm volatile("s_waitcnt lgkmcnt(0)" ::: "memory")
#define VM_WAIT() asm volatile("s_waitcnt vmcnt(0)" ::: "memory")
__device__ __forceinline__ unsigned long long rt() { return __builtin_amdgcn_s_memrealtime(); }
__device__ __forceinline__ unsigned f2bf(float f) { unsigned u = __builtin_bit_cast(unsigned, f); return (u + 0x7fffu + ((u >> 16) & 1u)) >> 16; }
__device__ __forceinline__ unsigned pk2(float lo, float hi) { return f2bf(lo) | (f2bf(hi) << 16); }

#define XB_TMO      128
#define XB_XCNT(j)  (256  + 64 * (j))
#define XB_XSUB(j)  (1280 + 64 * (j))
#define XB_XGEN(j)  (2304 + 64 * (j))
#define XB_TOP      3328
#define XB_TOPGEN   3392
#define XCD_BAR_WORDS 3456
#define XB_SPIN_CAP (1u << 18)

__device__ __forceinline__ unsigned xb_ld(unsigned* p)              { return __hip_atomic_load(p, __ATOMIC_RELAXED, __HIP_MEMORY_SCOPE_AGENT); }
__device__ __forceinline__ unsigned xb_add(unsigned* p, unsigned v) { return __hip_atomic_fetch_add(p, v, __ATOMIC_RELAXED, __HIP_MEMORY_SCOPE_AGENT); }
__device__ __forceinline__ unsigned xb_xcc_id() { return (unsigned)__builtin_amdgcn_s_getreg((3 << 11) | 20) & 0xFu; }
#define XB_SPIN(cond, bar) do { unsigned _sp = 0; while (cond) { __builtin_amdgcn_s_sleep(1); \
    if ((++_sp & 255u) == 0u) { if (xb_ld(&(bar)[XB_TMO])) break; if (_sp > XB_SPIN_CAP) { atomicAdd(&(bar)[XB_TMO], 1u); break; } } } } while (0)

struct XcdBarrier {
    unsigned* bar; unsigned x;
    volatile LAS unsigned* st;
};

__device__ __forceinline__ XcdBarrier xcd_barrier_post(unsigned* bar, volatile LAS unsigned* st) {
    XcdBarrier b; b.bar = bar; b.x = xb_xcc_id(); b.st = st;
    if (threadIdx.x == 0) (void)xb_add(&bar[XB_XCNT(b.x)], 1u);
    return b;
}
__device__ __forceinline__ void xcd_barrier_complete(unsigned* bar, unsigned x, unsigned& nloc, unsigned& nx) {
    const unsigned G = gridDim.x * gridDim.y * gridDim.z;
    unsigned sum, cnt, mine, sp = 0u;
    for (;;) {
        sum = 0u; cnt = 0u; mine = 0u;
#pragma unroll
        for (unsigned j = 0; j < 16; ++j) { const unsigned c = xb_ld(&bar[XB_XCNT(j)]); sum += c; cnt += (c > 0u) ? 1u : 0u; mine = (j == x) ? c : mine; }
        if (sum == G) break;
        __builtin_amdgcn_s_sleep(1);
        if ((++sp & 255u) == 0u) { if (xb_ld(&bar[XB_TMO])) break; if (sp > XB_SPIN_CAP) { atomicAdd(&bar[XB_TMO], 1u); break; } }
    }
    nloc = mine > 0u ? mine : 1u; nx = cnt > 0u ? cnt : 1u;
}

__device__ __forceinline__ void xcd_barrier(const XcdBarrier& b) {
    asm volatile("s_waitcnt vmcnt(0)" ::: "memory");
    __syncthreads();
    if (threadIdx.x == 0) {
        unsigned* bar = b.bar;
        __builtin_amdgcn_s_waitcnt(0);
        unsigned nloc = b.st[0], nx = b.st[1];
        if (nloc == 0u) { xcd_barrier_complete(bar, b.x, nloc, nx); b.st[0] = nloc; b.st[1] = nx; }
        const unsigned old = xb_add(&bar[XB_XSUB(b.x)], 1u);
        const unsigned gen = old / nloc;
        if (old + 1u == (gen + 1u) * nloc) {
            __builtin_amdgcn_fence(__ATOMIC_RELEASE, "agent");
            asm volatile("s_waitcnt vmcnt(0)" ::: "memory");
            const unsigned og = xb_add(&bar[XB_TOP], 1u);
            const unsigned tg = og / nx;
            if (og + 1u == (tg + 1u) * nx) xb_add(&bar[XB_TOPGEN], 1u);
            else XB_SPIN(xb_ld(&bar[XB_TOPGEN]) == tg, bar);
            __builtin_amdgcn_fence(__ATOMIC_ACQUIRE, "agent");
            xb_add(&bar[XB_XGEN(b.x)], 1u);
            asm volatile("s_waitcnt vmcnt(0)" ::: "memory");
        } else {
            XB_SPIN(xb_ld(&bar[XB_XGEN(b.x)]) == gen, bar);
            __builtin_amdgcn_fence(__ATOMIC_ACQUIRE, "agent");
            asm volatile("s_waitcnt vmcnt(0)" ::: "memory");
        }
    }
    __syncthreads();
}
__device__ __forceinline__ float wave_sum(float v) {
#pragma unroll
    for (int o = 1; o < 64; o <<= 1) v += __shfl_xor(v, o);
    return v;
}
__device__ __forceinline__ int crow(int r, int hi) { return (r & 3) + 8 * (r >> 2) + 4 * hi; }
__device__ __forceinline__ s16x4 vtr(const LAS unsigned char* p) { return __builtin_bit_cast(s16x4, __builtin_amdgcn_ds_read_tr16_b64_v4i16((LAS v4i16_t*)p)); }
__device__ __forceinline__ unsigned cvtpk(float lo, float hi) { return pg8::cvt_pk_bf16(lo, hi); }
__device__ __forceinline__ float bflo(unsigned w) { return __uint_as_float(w << 16); }
__device__ __forceinline__ float bfhi(unsigned w) { return __uint_as_float(w & 0xffff0000u); }
__device__ __forceinline__ float bf1(bf16 h) { return __uint_as_float((unsigned)h << 16); }

struct TrItem { const float* src; const float* gain; bf16* dst; int ldsrc, nvalid, K; };
__device__ __forceinline__ void tr_load(const TrItem& t, float (&tv)[32], int lane) {
    const bool ok = (lane & 31) < t.nvalid;
#pragma unroll
    for (int i = 0; i < 32; ++i) { const int kk = 2 * i + (lane >> 5); tv[i] = ok ? t.src[(size_t)kk * t.ldsrc + (lane & 31)] : 0.f; }
    if (t.gain) {
#pragma unroll
        for (int i = 0; i < 32; ++i) tv[i] *= t.gain[2 * i + (lane >> 5)]; }
}
__device__ __forceinline__ void tr_store(const TrItem& t, const float (&tv)[32], LAS float* scr, int lane) {
#pragma unroll
    for (int i = 0; i < 32; ++i) scr[(2 * i + (lane >> 5)) * 33 + (lane & 31)] = tv[i];
    LDS_WAIT(); asm volatile("" ::: "memory");
    const int c = lane & 7;
#pragma unroll
    for (int j = 0; j < 4; ++j) { const int n = (lane >> 3) + 8 * j; const LAS float* s = scr + (8 * c) * 33 + n;
        v4u o; o.x = cvtpk(s[0 * 33], s[1 * 33]); o.y = cvtpk(s[2 * 33], s[3 * 33]); o.z = cvtpk(s[4 * 33], s[5 * 33]); o.w = cvtpk(s[6 * 33], s[7 * 33]);
        *(GAS v4u*)(t.dst + (size_t)n * t.K + 8 * c) = o; }
    LDS_WAIT(); asm volatile("" ::: "memory");
}
__device__ __forceinline__ TrItem tr_make(const float* W, int ldsrc, int col0, int nvalid, const float* gain, int K, bf16* dest, int n0, int kb) {
    TrItem t; t.src = W + (size_t)(64 * kb) * ldsrc + col0; t.gain = gain ? gain + 64 * kb : nullptr; t.dst = dest + (size_t)n0 * K + 64 * kb; t.ldsrc = ldsrc; t.nvalid = nvalid; t.K = K; return t;
}
__device__ __forceinline__ int win_src_col(int n0, int& nvalid) {
    const int t = n0 >> 8, j0 = n0 & 255; nvalid = 32;
    if (t < 2) return 256 * t + j0;
    if (t < 6) { const int base = t < 4 ? 512 : 1024, wc = (j0 & 127) >> 5, bj = j0 >> 7; return base + (4 * (t & 1) + wc) * 64 + 32 * bj; }
    if (t < 8) return 1536 + 256 * (t - 6) + j0;
    if (t < 10) return 2048 + 256 * (t - 8) + j0;
    if (t < 12) return 2560 + 256 * (t - 10) + j0;
    if (t == 12) return 3072 + j0;
    if (t == 13) return 3328 + j0;
    if (t < 16) return 3584 + 256 * (t - 14) + j0;
    if (t < 18) return 4112 + 256 * (t - 16) + j0;
    if (t < 34) return 4624 + 256 * (t - 18) + j0;
    nvalid = (j0 == 0) ? 16 : 0; return 4096;
}
__device__ __forceinline__ void prologue(LAS unsigned char* lds, int gw, int NGW, int wave, int lane) {
    asm volatile("" : "+v"(lane));
    LAS float* scr = (LAS float*)(lds + wave * 16384);
    constexpr int I13 = 16 * 176, I2 = 44 * 32, IIN = 16 * 280, IBR = 3 * 8 * 32, IOUT = 16 * 32, IPG = 16 * 32, IPP = 4 * 32, IL = 2 * I13 + 2 * I2 + IIN + IBR + IOUT + IPG + IPP;
    auto decode = [&](int it) -> TrItem {
        KParams P = params_ptr(); const int L = it / IL; int r = it - L * IL; unsigned char* wl = P->ws + WS_W + (size_t)L * LW;
        if (r < 2 * I13) { const int which = r / I13; r -= which * I13; const int kb = r / 176, nb = r % 176, n0 = 32 * nb, tile = n0 >> 8, j0 = n0 & 255;
            const float* w1 = P->in[which ? I_F2W1 : I_F1W1] + (size_t)L * DM * DFF; const float* w3 = P->in[which ? I_F2W3 : I_F1W3] + (size_t)L * DM * DFF; const float* gn = P->in[which ? I_N2 : I_N1] + L * DM;
            return tr_make(j0 < 128 ? w1 : w3, DFF, 128 * tile + (j0 & 127), 32, gn, DM, (bf16*)(wl + (which ? OW13B : OW13A)), n0, kb); }
        r -= 2 * I13;
        if (r < 2 * I2) { const int which = r / I2; r -= which * I2; const int kb = r / 32, nb = r % 32;
            return tr_make(P->in[which ? I_F2W2 : I_F1W2] + (size_t)L * DFF * DM, DM, 32 * nb, 32, nullptr, DFF, (bf16*)(wl + (which ? OW2B : OW2A)), 32 * nb, kb); }
        r -= 2 * I2;
        if (r < IIN) { const int kb = r / 280, nb = r % 280; int nv; const int sc = win_src_col(32 * nb, nv);
            return tr_make(P->in[I_WIN] + (size_t)L * DM * 8720, 8720, sc, nv, P->in[I_NM] + L * DM, DM, (bf16*)(wl + OWIN), 32 * nb, kb); }
        r -= IIN;
        if (r < IBR) { const int b = 1 + r / 256; r &= 255; const int kb = r / 32, nb = r % 32;
            return tr_make(P->in[I_WBR] + ((size_t)L * 4 + b) * 512 * 1024, 1024, 32 * nb, 32, nullptr, 512, (bf16*)(wl + OWBR) + (size_t)b * 1024 * 512, 32 * nb, kb); }
        r -= IBR;
        if (r < IOUT) { const int kb = r / 32, nb = r % 32; return tr_make(P->in[I_WOUT] + (size_t)L * DM * DM, DM, 32 * nb, 32, nullptr, DM, (bf16*)(wl + OWOUT), 32 * nb, kb); }
        r -= IOUT;
        if (r < IPG) { const int kb = r / 32, nb = r % 32; return tr_make(P->in[I_WPG] + (size_t)L * DM * DM, DM, 32 * nb, 32, P->in[I_NPL] + L * DM, DM, (bf16*)(wl + OWPG), 32 * nb, kb); }
        r -= IPG;
        { const int kb = r / 32, nb = r % 32; return tr_make(P->in[I_WPP] + (size_t)L * 256 * DM, DM, 32 * nb, 32, nullptr, 256, (bf16*)(wl + OWPP), 32 * nb, kb); }
    };
    for (int it = gw; it < NL * IL; it += 4 * NGW) {
        const bool h1 = it + NGW < NL * IL, h2 = it + 2 * NGW < NL * IL, h3 = it + 3 * NGW < NL * IL;
        const TrItem ta = decode(it), tb = decode(h1 ? it + NGW : it), tc = decode(h2 ? it + 2 * NGW : it), td = decode(h3 ? it + 3 * NGW : it);
        float va[32], vb[32], vc[32], vd[32];
        tr_load(ta, va, lane); if (h1) tr_load(tb, vb, lane); if (h2) tr_load(tc, vc, lane); if (h3) tr_load(td, vd, lane);
        tr_store(ta, va, scr, lane); if (h1) tr_store(tb, vb, scr, lane); if (h2) tr_store(tc, vc, scr, lane); if (h3) tr_store(td, vd, scr, lane);
    }
    for (int it = gw; it < NL * 64 * 16; it += NGW) {
        KParams P = params_ptr(); unsigned char* ws = P->ws; const int L = it / (64 * 16); const int r = it - L * 64 * 16; const int k0 = (r >> 4) * 8, n = (r & 15) * 64 + lane, g = k0 >> 7;
        const float* pw = P->in[I_POOLW] + ((size_t)L * 512 + k0) * 128; const float* sc = P->in[I_POOLS] + L * 512 + g * 128; const float* wb = P->in[I_WBR] + ((size_t)L * 4) * 512 * 1024 + (size_t)(g * 128) * 1024 + n;
#pragma unroll
        for (int i = 0; i < 16; ++i) { const int e = i * 64 + lane; scr[e] = pw[e] * sc[e & 127]; }
        LDS_WAIT(); asm volatile("" ::: "memory");
        float a[8];
#pragma unroll
        for (int j = 0; j < 8; ++j) a[j] = 0.f;
        for (int d0 = 0; d0 < 128; d0 += 32) {
            float wv[32];
#pragma unroll
            for (int d = 0; d < 32; ++d) wv[d] = wb[(size_t)(d0 + d) * 1024];
#pragma unroll
            for (int d = 0; d < 32; ++d)
#pragma unroll
                for (int j = 0; j < 8; ++j) a[j] += scr[j * 128 + d0 + d] * wv[d];
        }
        v4u o; o.x = cvtpk(a[0], a[1]); o.y = cvtpk(a[2], a[3]); o.z = cvtpk(a[4], a[5]); o.w = cvtpk(a[6], a[7]);
        *(GAS v4u*)((bf16*)(ws + WS_W + (size_t)L * LW + OWBR) + (size_t)n * 512 + k0) = o;
        LDS_WAIT(); asm volatile("" ::: "memory");
    }
    for (int it = gw * 64 + lane; it < NL * 4 * 128 * 128; it += NGW * 64) {
        KParams P = params_ptr(); unsigned char* ws = P->ws; const int L = it >> 16, r = it & 65535, i = (r >> 7) & 127, j = r & 127;
        const float v = ((j >> 6) <= (i >> 6)) ? P->in[I_GWS][it] : 0.f;
        ((bf16*)(ws + WS_W + (size_t)L * LW + OWM))[r] = (bf16)(cvtpk(v, 0.f) & 0xffffu);
    }
    for (int m0 = gw * 4; m0 < M; m0 += NGW * 4) {
        KParams P = params_ptr(); unsigned char* ws = P->ws;
        f32x4 v[4][4];
#pragma unroll
        for (int r = 0; r < 4; ++r) { const int m = m0 + r; const float* src = m < MP ? P->in[I_XP] + (size_t)m * DM : P->in[I_XS] + (size_t)(m - MP) * DM;
#pragma unroll
            for (int j = 0; j < 4; ++j) v[r][j] = ((const GAS f32x4*)src)[lane + 64 * j]; }
#pragma unroll
        for (int r = 0; r < 4; ++r) { const int m = m0 + r; float s = 0.f;
#pragma unroll
            for (int j = 0; j < 4; ++j) s += (v[r][j].x * v[r][j].x + v[r][j].y * v[r][j].y) + (v[r][j].z * v[r][j].z + v[r][j].w * v[r][j].w);
            s = wave_sum(s);
            GAS u32x2* bo = (GAS u32x2*)((bf16*)(ws + WS_XB0) + (size_t)m * DM) + lane; GAS u32x2* lo = (GAS u32x2*)((bf16*)(ws + WS_XL) + (size_t)m * DM) + lane;
#pragma unroll
            for (int j = 0; j < 4; ++j) { u32x2 w; w.x = cvtpk(v[r][j].x, v[r][j].y); w.y = cvtpk(v[r][j].z, v[r][j].w); bo[64 * j] = w;
                if (USE_XL) { u32x2 l; l.x = cvtpk(v[r][j].x - bflo(w.x), v[r][j].y - bfhi(w.x)); l.y = cvtpk(v[r][j].z - bflo(w.y), v[r][j].w - bfhi(w.y)); lo[64 * j] = l; } }
            if (lane < 16) ((float*)(ws + WS_SSQ0))[(size_t)m * 16 + lane] = lane == 0 ? s : 0.f; }
    }
    for (int it0 = gw * 8; it0 < NL * M; it0 += NGW * 8) {
        KParams P = params_ptr(); unsigned char* ws = P->ws; f32x4 v[8];
#pragma unroll
        for (int j = 0; j < 8; ++j) { const int it = it0 + j, L = it / M, m = it - L * M;
            const float* src = m < MP ? P->in[I_PP] + ((size_t)L * MP + m) * 256 : P->in[I_PS] + ((size_t)L * MS + (m - MP)) * 256; v[j] = ((const GAS f32x4*)src)[lane]; }
#pragma unroll
        for (int j = 0; j < 8; ++j) { u32x2 w; w.x = cvtpk(v[j].x, v[j].y); w.y = cvtpk(v[j].z, v[j].w); ((GAS u32x2*)((bf16*)(ws + WS_PB) + (size_t)(it0 + j) * 256))[lane] = w; }
    }
}

template <int W> __device__ __forceinline__ void pool_rows(KParams P, int L, int rblk, int g, int lane) {
    const bf16* xpb = (const bf16*)(P->ws + WS_XPB); bf16* D = (bf16*)(P->ws + WS_AB);
    const int row0 = rblk * 32; const bool prompt = row0 < MP;
    int rowbase, t0; const float* hist = nullptr; float* pout; int pfirst;
    if (prompt) { const int b = row0 >> 12; rowbase = b << 12; t0 = row0 & 4095; pout = P->out + O_POOLP + ((size_t)L * 8 + b) * 15 * 512; pfirst = 4081; }
    else { const int b = (row0 - MP) >> 5; rowbase = MP + (b << 5); t0 = 0; hist = P->in[I_SPOOL] + ((size_t)L * 16 + b) * 15 * 512; pout = P->out + O_POOLS + ((size_t)L * 16 + b) * 15 * 512; pfirst = 17; }
    const int tb = t0 + 8 * (lane >> 4), c0 = g * 128 + (lane & 15) * 8;
    v4u x[W + 7];
#pragma unroll
    for (int i = 0; i < W + 7; ++i) { const int t = tb - (W - 1) + i; x[i] = *(const GAS v4u*)(xpb + (size_t)(rowbase + (t > 0 ? t : 0)) * 512 + c0); }
    if (prompt) {
#pragma unroll
        for (int i = 0; i < W - 1; ++i) { const int t = tb - (W - 1) + i; if (t < 0) x[i] = (v4u){0u, 0u, 0u, 0u}; }
    } else {
        v4u hx[W - 1];
#pragma unroll
        for (int i = 0; i < W - 1; ++i) { const int t = tb - (W - 1) + i; int hr = 15 + t; hr = hr < 0 ? 0 : (hr > 14 ? 14 : hr); const float* h = hist + (size_t)hr * 512 + c0;
            hx[i] = pg8::pack8(*(const f32x4*)h, *(const f32x4*)(h + 4)); }
#pragma unroll
        for (int i = 0; i < W - 1; ++i) { const int t = tb - (W - 1) + i; if (t < 0) x[i] = hx[i]; }
    }
    f32x4 s0 = (f32x4){0.f, 0.f, 0.f, 0.f}, s1 = s0;
#pragma unroll
    for (int i = 0; i < W - 1; ++i) { s0 = s0 + (f32x4){bflo(x[i].x), bfhi(x[i].x), bflo(x[i].y), bfhi(x[i].y)}; s1 = s1 + (f32x4){bflo(x[i].z), bfhi(x[i].z), bflo(x[i].w), bfhi(x[i].w)}; }
#pragma unroll
    for (int j = 0; j < 8; ++j) { const int t = tb + j; const v4u xn = x[j + W - 1], xo = x[j];
        const f32x4 a = (f32x4){bflo(xn.x), bfhi(xn.x), bflo(xn.y), bfhi(xn.y)}, b = (f32x4){bflo(xn.z), bfhi(xn.z), bflo(xn.w), bfhi(xn.w)};
        s0 = s0 + a; s1 = s1 + b;
        const int cnt = prompt ? (t + 1 < W ? t + 1 : W) : W; const float inv = 1.0f / (float)cnt;
        *(GAS v4u*)(D + (size_t)(rowbase + t) * 512 + c0) = pg8::pack8(s0 * inv - a, s1 * inv - b);
        if (t >= pfirst) { float* po = pout + (size_t)(t - pfirst) * 512 + c0; *(f32x4*)po = a; *(f32x4*)(po + 4) = b; }
        s0 = s0 - (f32x4){bflo(xo.x), bfhi(xo.x), bflo(xo.y), bfhi(xo.y)}; s1 = s1 - (f32x4){bflo(xo.z), bfhi(xo.z), bflo(xo.w), bfhi(xo.w)}; }
}
__device__ __forceinline__ void pool_unit(int L, int unit, int lane) {
    KParams P = params_ptr(); asm volatile("" : "+v"(lane));
    const int g = unit & 3, rblk = unit >> 2;
    if (g == 0) pool_rows<2>(P, L, rblk, 0, lane); else if (g == 1) pool_rows<4>(P, L, rblk, 1, lane); else if (g == 2) pool_rows<8>(P, L, rblk, 2, lane); else pool_rows<16>(P, L, rblk, 3, lane);
}

template <bool SAMPLE> __device__ __forceinline__ void sb_unit(LAS unsigned char* wl, int lane, int L, int unit) {
    KParams P = params_ptr(); asm volatile("" : "+v"(lane));
    const bf16* Qb = (const bf16*)(P->ws + WS_QB); const bf16* Kb = (const bf16*)(P->ws + WS_KB); const bf16* Vb = (const bf16*)(P->ws + WS_VB); bf16* Y = (bf16*)(P->ws + WS_AB) + (size_t)M * 512;
    int newrow0, nnew, npast, qidx0, h; const float* ck = nullptr; const float* cv = nullptr;
    if (!SAMPLE) { const int b = unit >> 10, r = unit & 1023; h = r >> 7; qidx0 = (r & 127) * 32; newrow0 = b << 12; nnew = 4096; npast = 0; }
    else { const int r = unit - 8192, b = r >> 3; h = r & 7; qidx0 = 0; newrow0 = MP + (b << 5); nnew = 32; npast = 4096;
        ck = P->in[I_CK] + ((size_t)L * 16 + b) * 4096 * 512; cv = P->in[I_CV] + ((size_t)L * 16 + b) * 4096 * 512; }
    const int r32 = lane & 31, hi = lane >> 5; const int qrow0 = newrow0 + qidx0;
    pg8::bf16x8 qf[4];
    { const bf16* qp = Qb + (size_t)(qrow0 + r32) * 512 + h * 64 + hi * 8;
#pragma unroll
      for (int d0 = 0; d0 < 4; ++d0) qf[d0] = *(const GAS pg8::bf16x8*)(qp + d0 * 16); }
    f32x16 o0, o1;
#pragma unroll
    for (int r = 0; r < 16; ++r) { o0[r] = 0.f; o1[r] = 0.f; }
    float R2 = 0.f;
    const int qpos0 = npast + qidx0, jd = qpos0 >> 6;
    v4u kv[8], vv[8];
    auto issue_new = [&](int jj) {
#pragma unroll
        for (int i = 0; i < 8; ++i) { const int r = (lane >> 3) + 8 * i; int idx = 64 * jj - npast + r; idx = idx < nnew ? idx : nnew - 1;
            const size_t off = (size_t)(newrow0 + idx) * 512 + h * 64 + (lane & 7) * 8; kv[i] = *(const GAS v4u*)(Kb + off); vv[i] = *(const GAS v4u*)(Vb + off); }
    };
    if (!SAMPLE) issue_new(jd);
    for (int j = jd; j >= 0; --j) {
        if (__all(R2 >= SB_CUT)) break;
        const int p0 = 64 * j; const bool isnew = !SAMPLE || p0 >= npast;
        if (isnew) {
            if (SAMPLE) issue_new(j);
#pragma unroll
            for (int i = 0; i < 8; ++i) { const int r = (lane >> 3) + 8 * i;
                *(LAS v4u*)(wl + r * 128 + (((lane & 7) ^ (r & 7)) * 16)) = kv[i]; *(LAS v4u*)(wl + 8192 + r * 128 + (lane & 7) * 16) = vv[i]; }
            if (!SAMPLE && j > 0) issue_new(j - 1);
        } else {
#pragma unroll
            for (int hf = 0; hf < 2; ++hf) {
                f32x4 kk[8], vf[8];
#pragma unroll
                for (int i = 0; i < 8; ++i) { const int r = (lane >> 4) + 4 * (8 * hf + i); const size_t off = ((size_t)(p0 + r) * 8 + h) * 64 + (lane & 15) * 4; kk[i] = *(const GAS f32x4*)(ck + off); vf[i] = *(const GAS f32x4*)(cv + off); }
#pragma unroll
                for (int i = 0; i < 8; ++i) { const int r = (lane >> 4) + 4 * (8 * hf + i); u32x2 a, b; a.x = cvtpk(kk[i].x, kk[i].y); a.y = cvtpk(kk[i].z, kk[i].w); b.x = cvtpk(vf[i].x, vf[i].y); b.y = cvtpk(vf[i].z, vf[i].w);
                    *(LAS u32x2*)(wl + r * 128 + ((((lane & 15) >> 1) ^ (r & 7)) * 16) + (lane & 1) * 8) = a; *(LAS u32x2*)(wl + 8192 + r * 128 + (lane & 15) * 8) = b; }
            }
        }
        asm volatile("" ::: "memory");
        f32x16 p[2];
#pragma unroll
        for (int kh = 0; kh < 2; ++kh) {
#pragma unroll
            for (int r = 0; r < 16; ++r) p[kh][r] = 0.f;
#pragma unroll
            for (int d0 = 0; d0 < 4; ++d0) { const int row = 32 * kh + r32; const pg8::bf16x8 kf = *(const LAS pg8::bf16x8*)(wl + row * 128 + (((2 * d0 + hi) ^ (row & 7)) * 16));
                p[kh] = __builtin_amdgcn_mfma_f32_32x32x16_bf16(kf, qf[d0], p[kh], 0, 0, 0); }
        }
        const float finv = __builtin_amdgcn_exp2f(R2);
        const bool diag = (j == jd);
#pragma unroll
        for (int kh = 0; kh < 2; ++kh)
#pragma unroll
            for (int r = 0; r < 16; ++r) { float s = p[kh][r]; s = s < 60.f ? s : 60.f; float u = __builtin_amdgcn_exp2f(s);
                if (diag) { const bool valid = (p0 + 32 * kh + crow(r, hi)) < (qpos0 + r32); u = valid ? u : 0.f; }
                p[kh][r] = u; }
        float gp[16];
#pragma unroll
        for (int kh = 0; kh < 2; ++kh)
#pragma unroll
            for (int a = 0; a < 4; ++a) { const float g = ((1.0f + p[kh][4 * a]) * (1.0f + p[kh][4 * a + 1])) * ((1.0f + p[kh][4 * a + 2]) * (1.0f + p[kh][4 * a + 3])); const float og = __shfl_xor(g, 32);
                gp[8 * kh + 2 * a] = hi ? og : g; gp[8 * kh + 2 * a + 1] = hi ? g : og; }
        float E[16]; E[15] = finv;
#pragma unroll
        for (int G = 14; G >= 0; --G) E[G] = E[G + 1] * gp[G + 1];
        const float T = E[0] * gp[0];
#pragma unroll
        for (int kh = 0; kh < 2; ++kh)
#pragma unroll
            for (int a = 0; a < 4; ++a) { const float e = hi ? E[8 * kh + 2 * a + 1] : E[8 * kh + 2 * a];
                const float D3 = e * (1.0f + p[kh][4 * a + 3]), D2 = D3 * (1.0f + p[kh][4 * a + 2]), D1 = D2 * (1.0f + p[kh][4 * a + 1]), D0 = D1 * (1.0f + p[kh][4 * a]);
                p[kh][4 * a + 3] = p[kh][4 * a + 3] * __builtin_amdgcn_rcpf(D3); p[kh][4 * a + 2] = p[kh][4 * a + 2] * __builtin_amdgcn_rcpf(D2);
                p[kh][4 * a + 1] = p[kh][4 * a + 1] * __builtin_amdgcn_rcpf(D1); p[kh][4 * a] = p[kh][4 * a] * __builtin_amdgcn_rcpf(D0); }
        R2 = __builtin_amdgcn_logf(T);
#pragma unroll
        for (int s = 0; s < 4; ++s) {
            const int kh = s >> 1, rb = 8 * (s & 1);
            v4u pw; pw.x = cvtpk(p[kh][rb], p[kh][rb + 1]); pw.y = cvtpk(p[kh][rb + 2], p[kh][rb + 3]); pw.z = cvtpk(p[kh][rb + 4], p[kh][rb + 5]); pw.w = cvtpk(p[kh][rb + 6], p[kh][rb + 7]);
            const pg8::bf16x8 pf = __builtin_bit_cast(pg8::bf16x8, pw);
            const LAS unsigned char* vbase = wl + 8192 + (16 * s + 4 * hi + ((lane & 15) >> 2)) * 128 + ((lane >> 4) & 1) * 32 + (lane & 3) * 8;
#pragma unroll
            for (int dh = 0; dh < 2; ++dh) { const s16x4 lo = vtr(vbase + dh * 64), h4 = vtr(vbase + dh * 64 + 8 * 128);
                const pg8::bf16x8 vf = (pg8::bf16x8){lo[0], lo[1], lo[2], lo[3], h4[0], h4[1], h4[2], h4[3]};
                if (dh == 0) o0 = __builtin_amdgcn_mfma_f32_32x32x16_bf16(pf, vf, o0, 0, 0, 0); else o1 = __builtin_amdgcn_mfma_f32_32x32x16_bf16(pf, vf, o1, 0, 0, 0); }
        }
        asm volatile("" ::: "memory");
    }
    bf16* yp = Y + (size_t)qrow0 * 512 + h * 64 + r32;
#pragma unroll
    for (int r = 0; r < 16; ++r) { bf16* q = yp + (size_t)crow(r, hi) * 512; q[0] = (bf16)(cvtpk(o0[r], 0.f) & 0xffffu); q[32] = (bf16)(cvtpk(o1[r], 0.f) & 0xffffu); }
}

__device__ __forceinline__ void gmlp_unit(LAS unsigned char* wl, int lane, int L, int unit) {
    KParams P = params_ptr(); asm volatile("" : "+v"(lane));
    const bf16* gub = (const bf16*)(P->ws + WS_GUB); const bf16* gvb = (const bf16*)(P->ws + WS_GVB); bf16* Y = (bf16*)(P->ws + WS_AB) + (size_t)2 * M * 512;
    int row0, ntok, g, cb;
    if (unit < 4096) { const int ch = unit >> 4; g = (unit >> 2) & 3; cb = unit & 3; row0 = ch * 128; ntok = 128; }
    else { const int r = unit - 4096, b = r >> 4; g = (r >> 2) & 3; cb = r & 3; row0 = MP + b * 32; ntok = 32; }
    const bf16* wm = (const bf16*)(P->ws + WS_W + (size_t)L * LW + OWM) + (size_t)g * 128 * 128; const float* bs = P->in[I_GB] + ((size_t)L * 4 + g) * 128;
    const int r32 = lane & 31, hi = lane >> 5; const int colb = g * 128 + cb * 32;
    for (int i = 0; i < ntok / 16; ++i) { const int r = (lane >> 2) + 16 * i; *(LAS v4u*)(wl + r * 80 + (lane & 3) * 16) = *(const GAS v4u*)(gvb + (size_t)(row0 + r) * 512 + colb + (lane & 3) * 8); }
    asm volatile("" ::: "memory");
    const int nib = ntok / 32;
    for (int ib = 0; ib < nib; ++ib) {
        f32x16 acc;
#pragma unroll
        for (int r = 0; r < 16; ++r) acc[r] = 0.f;
        const int ns = ntok == 32 ? 2 : (ib < 2 ? 4 : 8);
        pg8::bf16x8 af[8]; bf16 guv[16]; float bsv[16];
#pragma unroll
        for (int s = 0; s < 8; ++s) if (s < ns) af[s] = *(const GAS pg8::bf16x8*)(wm + (size_t)(32 * ib + r32) * 128 + 16 * s + 8 * hi);
#pragma unroll
        for (int r = 0; r < 16; ++r) { const int i = 32 * ib + crow(r, hi); guv[r] = gub[(size_t)(row0 + i) * 512 + colb + r32]; bsv[r] = bs[i]; }
#pragma unroll
        for (int s = 0; s < 8; ++s) if (s < ns) {
            const LAS unsigned char* bb = wl + (16 * s + 8 * hi + ((lane & 15) >> 2)) * 80 + ((lane >> 4) & 1) * 32 + (lane & 3) * 8;
            const s16x4 lo = vtr(bb), h4 = vtr(bb + 4 * 80);
            const pg8::bf16x8 bfr = (pg8::bf16x8){lo[0], lo[1], lo[2], lo[3], h4[0], h4[1], h4[2], h4[3]};
            acc = __builtin_amdgcn_mfma_f32_32x32x16_bf16(af[s], bfr, acc, 0, 0, 0);
        }
#pragma unroll
        for (int r = 0; r < 16; ++r) { const int i = 32 * ib + crow(r, hi); const size_t off = (size_t)(row0 + i) * 512 + colb + r32;
            Y[off] = (bf16)(cvtpk(bf1(guv[r]) * (acc[r] + bsv[r]), 0.f) & 0xffffu); }
    }
    asm volatile("" ::: "memory");
}

__device__ __forceinline__ void gla_ids(int cid, int& row0, int& ntok, int& h) {
    if (cid < 2048) { const int sq = cid >> 6, c = cid & 63; h = sq & 3; row0 = (sq >> 2) * 4096 + c * 64; ntok = 64; }
    else { const int sq = cid - 2048; h = sq & 3; row0 = MP + (sq >> 2) * 32; ntok = 32; }
}
struct GlaInA { v4u la; v4u q, k, v0, v1; };
__device__ __forceinline__ GlaInA gla_a_issue(KParams P, int L, int cid, int tid) {
    int row0, ntok, h; gla_ids(cid, row0, ntok, h);
    const int t = tid >> 3, q8 = tid & 7; const bool live = t < ntok; GlaInA r;
    const bf16* lab = (const bf16*)(P->ws + WS_LAB); const bf16* lqb = (const bf16*)(P->ws + WS_LQB); const bf16* lkb = (const bf16*)(P->ws + WS_LKB); const bf16* lvb = (const bf16*)(P->ws + WS_LVB);
    const v4u z = (v4u){0u, 0u, 0u, 0u}; r.la = z; r.q = z; r.k = z; r.v0 = z; r.v1 = z;
    { const int ar = 32 * ((tid >> 6) & 1) + (tid & 31); if (ar < ntok) r.la = *(const GAS v4u*)(lab + (size_t)(row0 + ar) * 256 + 8 * ((tid >> 5) & 1)); }
    if (live) { r.q = *(const GAS v4u*)(lqb + (size_t)(row0 + t) * 256 + h * 64 + 8 * q8); r.k = *(const GAS v4u*)(lkb + (size_t)(row0 + t) * 256 + h * 64 + 8 * q8);
                r.v0 = *(const GAS v4u*)(lvb + (size_t)(row0 + t) * 512 + h * 128 + 16 * q8); r.v1 = *(const GAS v4u*)(lvb + (size_t)(row0 + t) * 512 + h * 128 + 16 * q8 + 8); }
    return r;
}
__device__ __forceinline__ void gla_pass_a_loop(LAS unsigned char* lds, int L, int vcu, int G, int tid) {
    asm volatile("" : "+v"(tid)); const int lane = tid & 63, wave = __builtin_amdgcn_readfirstlane(tid >> 6);
    LAS float* LA = (LAS float*)lds;
    LAS float* WA = LA + 64 * 17;
    LAS float* BA = WA + 16 * 64;
    LAS float* SEG = BA + 64;
    LAS float* LAMS = SEG + 8 * 64;
    LAS float* Gt = LAMS + 64;
    LAS unsigned char* KT = (LAS unsigned char*)(Gt + 64 * 65);
    LAS unsigned char* VT0 = KT + 64 * 144;
    int vpar = 0;
    int seg = vcu; if (seg >= NSEG) return; int ci = 0;
    int c = seg < 256 ? seg * 8 : 2048 + (seg - 256);
    const int t = tid >> 3, q8 = tid & 7, r32 = lane & 31, hi = lane >> 5;
    f32x16 Srun; float Lrun = 1.0f;
#pragma unroll
    for (int r = 0; r < 16; ++r) Srun[r] = 0.f;
    GlaInA in = gla_a_issue(params_ptr(), L, c, tid);
    int seg1 = seg, ci1 = 1; if (ci1 >= (seg < 256 ? 8 : 1)) { seg1 = seg + G; ci1 = 0; }
    bool has1 = seg1 < NSEG; int c1 = has1 ? (seg1 < 256 ? seg1 * 8 + ci1 : 2048 + (seg1 - 256)) : c;
    GlaInA in2 = in; if (has1) in2 = gla_a_issue(params_ptr(), L, c1, tid);
    v4u bhi = (v4u){0u, 0u, 0u, 0u}, blo = bhi; float bcol = 0.f;
    auto step = [&](GlaInA& in) -> bool {
        KParams P = params_ptr(); const int nch = seg < 256 ? 8 : 1;
        int row0, ntok, h; gla_ids(c, row0, ntok, h); const bool live = t < ntok;
        LAS unsigned char* VT = VT0 + vpar * (64 * 272); vpar ^= 1;
        if (ci == 0) {
            const float* wa = P->in[I_WA2] + ((size_t)L * 16 + 8 * hi) * 256 + h * 64 + 32 * ((wave >> 1) & 1) + r32; float w[8];
#pragma unroll
            for (int i = 0; i < 8; ++i) w[i] = wa[(size_t)i * 256];
            bcol = P->in[I_BA][L * 256 + h * 64 + 32 * ((wave >> 1) & 1) + r32];
            bhi.x = cvtpk(w[0], w[1]); bhi.y = cvtpk(w[2], w[3]); bhi.z = cvtpk(w[4], w[5]); bhi.w = cvtpk(w[6], w[7]);
            blo.x = cvtpk(w[0] - bflo(bhi.x), w[1] - bfhi(bhi.x)); blo.y = cvtpk(w[2] - bflo(bhi.y), w[3] - bfhi(bhi.y)); blo.z = cvtpk(w[4] - bflo(bhi.z), w[5] - bfhi(bhi.z)); blo.w = cvtpk(w[6] - bflo(bhi.w), w[7] - bfhi(bhi.w)); }
        *(LAS v4u*)(VT + t * 272 + q8 * 32) = in.v0; *(LAS v4u*)(VT + t * 272 + q8 * 32 + 16) = in.v1;
        const v4u qraw = in.q, kraw = in.k; const pg8::bf16x8 afr = __builtin_bit_cast(pg8::bf16x8, in.la);
        int seg2 = seg1, ci2 = ci1 + 1; if (ci2 >= (seg1 < 256 ? 8 : 1)) { seg2 = seg1 + G; ci2 = 0; }
        const bool has2 = has1 && seg2 < NSEG; const int c2 = has2 ? (seg2 < 256 ? seg2 * 8 + ci2 : 2048 + (seg2 - 256)) : c1;
        if (has2) in = gla_a_issue(P, L, c2, tid);
        { f32x16 xg;
#pragma unroll
          for (int r = 0; r < 16; ++r) xg[r] = bcol;
          xg = __builtin_amdgcn_mfma_f32_32x32x16_bf16(afr, __builtin_bit_cast(pg8::bf16x8, bhi), xg, 0, 0, 0);
          xg = __builtin_amdgcn_mfma_f32_32x32x16_bf16(afr, __builtin_bit_cast(pg8::bf16x8, blo), xg, 0, 0, 0);
          const int tb_ = wave & 1, kb_ = (wave >> 1) & 1, half = wave >> 2;
#pragma unroll
          for (int r8 = 0; r8 < 8; ++r8) { const float x = half ? xg[8 + r8] : xg[r8]; const int tt = 32 * tb_ + crow(r8, hi) + 16 * half;
              const float ax = __builtin_fabsf(x); const float l2 = 1.4426950408889634f * (x < 0.f ? x : 0.f) - __builtin_amdgcn_logf(1.0f + __builtin_amdgcn_exp2f(-1.4426950408889634f * ax));
              Gt[tt * 65 + 32 * kb_ + r32] = tt < ntok ? l2 * (1.0f / 16.0f) : 0.f; } }
        __syncthreads();
        { float g[8], sg[7];
#pragma unroll
          for (int s = 0; s < 8; ++s) g[s] = Gt[(8 * wave + s) * 65 + lane];
#pragma unroll
          for (int s = 1; s < 8; ++s) g[s] += g[s - 1];
          SEG[wave * 64 + lane] = g[7];
          __syncthreads();
#pragma unroll
          for (int w = 0; w < 7; ++w) sg[w] = SEG[w * 64 + lane];
          float off = 0.f;
#pragma unroll
          for (int w = 0; w < 7; ++w) off += (w < wave) ? sg[w] : 0.f;
#pragma unroll
          for (int s = 0; s < 8; ++s) Gt[(8 * wave + s) * 65 + lane] = g[s] + off; }
        __syncthreads();
        { const float qin[8] = {bflo(qraw.x), bfhi(qraw.x), bflo(qraw.y), bfhi(qraw.y), bflo(qraw.z), bfhi(qraw.z), bflo(qraw.w), bfhi(qraw.w)};
          const float kin[8] = {bflo(kraw.x), bfhi(kraw.x), bflo(kraw.y), bfhi(kraw.y), bflo(kraw.z), bfhi(kraw.z), bflo(kraw.w), bfhi(kraw.w)};
          float qo[8], ko[8];
          float bb[8];
#pragma unroll
          for (int kk = 0; kk < 8; ++kk) bb[kk] = Gt[t * 65 + 8 * q8 + kk];
#pragma unroll
          for (int kk = 0; kk < 8; ++kk) { float b2 = bb[kk]; b2 = b2 > -120.f ? b2 : -120.f; qo[kk] = qin[kk] * __builtin_amdgcn_exp2f(b2) * 0.125f; ko[kk] = kin[kk] * __builtin_amdgcn_exp2f(-b2); }
          v4u qw, kw; qw.x = cvtpk(qo[0], qo[1]); qw.y = cvtpk(qo[2], qo[3]); qw.z = cvtpk(qo[4], qo[5]); qw.w = cvtpk(qo[6], qo[7]); kw.x = cvtpk(ko[0], ko[1]); kw.y = cvtpk(ko[2], ko[3]); kw.z = cvtpk(ko[4], ko[5]); kw.w = cvtpk(ko[6], ko[7]);
          *(LAS v4u*)(KT + t * 144 + q8 * 16) = kw;
          if (live) { *(GAS v4u*)((bf16*)(P->ws + WS_QT) + (size_t)(row0 + t) * 256 + h * 64 + 8 * q8) = qw; *(GAS v4u*)((bf16*)(P->ws + WS_KT) + (size_t)(row0 + t) * 256 + h * 64 + 8 * q8) = kw; } }
        if (tid < 64) { float b2 = Gt[63 * 65 + tid]; b2 = b2 > -120.f ? b2 : -120.f; const float lamv = __builtin_amdgcn_exp2f(b2); LAMS[tid] = lamv;
            if (ci == 0) Lrun = 1.0f;
            ((float*)(P->ws + WS_LAM))[(size_t)c * 64 + tid] = lamv;
            Lrun *= lamv;
            if (ci == nch - 1) ((float*)(P->ws + WS_SC) + (size_t)NSEG * 8192)[(size_t)seg * 64 + tid] = Lrun; }
        __syncthreads();
        { const int kb = wave & 1, vb = wave >> 1;
          f32x16 acc;
#pragma unroll
          for (int r = 0; r < 16; ++r) acc[r] = 0.f;
          const LAS unsigned char* ka = KT + (8 * hi + ((lane & 15) >> 2)) * 144 + (32 * kb + 16 * ((lane >> 4) & 1) + 4 * (lane & 3)) * 2;
          const LAS unsigned char* va = VT + (8 * hi + ((lane & 15) >> 2)) * 272 + (32 * vb + 16 * ((lane >> 4) & 1) + 4 * (lane & 3)) * 2;
#pragma unroll
          for (int s4 = 0; s4 < 4; ++s4) { const s16x4 a0 = vtr(ka + s4 * 16 * 144), a1 = vtr(ka + s4 * 16 * 144 + 4 * 144), b0 = vtr(va + s4 * 16 * 272), b1 = vtr(va + s4 * 16 * 272 + 4 * 272);
              const pg8::bf16x8 af = (pg8::bf16x8){a0[0], a0[1], a0[2], a0[3], a1[0], a1[1], a1[2], a1[3]}, bfr = (pg8::bf16x8){b0[0], b0[1], b0[2], b0[3], b1[0], b1[1], b1[2], b1[3]};
              acc = __builtin_amdgcn_mfma_f32_32x32x16_bf16(af, bfr, acc, 0, 0, 0); }
          if (ci == 0) {
#pragma unroll
              for (int r = 0; r < 16; ++r) Srun[r] = 0.f; }
#pragma unroll
          for (int r = 0; r < 16; ++r) Srun[r] = LAMS[32 * kb + crow(r, hi)] * (Srun[r] + acc[r]);
          if (ci == nch - 1) { float* sg = (float*)(P->ws + WS_SC) + (size_t)seg * 8192;
#pragma unroll
              for (int r = 0; r < 16; ++r) sg[(32 * kb + crow(r, hi)) * 128 + 32 * vb + r32] = Srun[r]; } }
        if (!has1) return false;
        seg = seg1; ci = ci1; c = c1; seg1 = seg2; ci1 = ci2; c1 = c2; has1 = has2;
        return true;
    };
    for (;;) { if (!step(in)) break; if (!step(in2)) break; }
    __syncthreads();
}
struct GlaInC { v4u q, k, v0, v1, l0, l1; float lc; };
__device__ __forceinline__ GlaInC gla_c_issue(KParams P, int cid, int tid) {
    int row0, ntok, h; gla_ids(cid, row0, ntok, h);
    const int t = tid >> 3, q8 = tid & 7; const bool live = t < ntok; GlaInC r;
    const v4u z = (v4u){0u, 0u, 0u, 0u}; r.q = z; r.k = z; r.v0 = z; r.v1 = z; r.l0 = z; r.l1 = z;
    if (live) { r.q = *(const GAS v4u*)((const bf16*)(P->ws + WS_QT) + (size_t)(row0 + t) * 256 + h * 64 + 8 * q8); r.k = *(const GAS v4u*)((const bf16*)(P->ws + WS_KT) + (size_t)(row0 + t) * 256 + h * 64 + 8 * q8);
                const bf16* lv = (const bf16*)(P->ws + WS_LVB) + (size_t)(row0 + t) * 512 + h * 128 + 16 * q8; r.v0 = *(const GAS v4u*)lv; r.v1 = *(const GAS v4u*)(lv + 8);
                const bf16* lr = (const bf16*)(P->ws + WS_LRB) + (size_t)(row0 + t) * 512 + h * 128 + 16 * q8; r.l0 = *(const GAS v4u*)lr; r.l1 = *(const GAS v4u*)(lr + 8); }
    r.lc = ((const float*)(P->ws + WS_LAM))[(size_t)cid * 64 + (tid & 63)];
    return r;
}
__device__ __forceinline__ void gla_pass_c_loop(LAS unsigned char* lds, int L, int vcu, int G, int tid) {
    asm volatile("" : "+v"(tid)); const int lane = tid & 63, wave = __builtin_amdgcn_readfirstlane(tid >> 6);
    LAS unsigned char* QT = lds;
    LAS unsigned char* KT = QT + 64 * 144;
    LAS unsigned char* VT = KT + 64 * 144;
    LAS unsigned char* ST = VT + 64 * 272;
    LAS float* O = (LAS float*)(ST + 64 * 272);
    LAS float* LAMS = O + 64 * 128;
    int seg = vcu; if (seg >= NSEG) return; int ci = 0;
    int c = seg < 256 ? seg * 8 : 2048 + (seg - 256);
    const int t = tid >> 3, q8 = tid & 7, r32 = lane & 31, hi = lane >> 5;
    const int so = (32 * (wave & 1) + 4 * hi) * 128 + 32 * (wave >> 1) + r32;
    f32x16 S0;
#pragma unroll
    for (int j = 0; j < 16; ++j) S0[j] = 0.f;
    float gon[16];
    { const float* gp = params_ptr()->in[I_GON] + L * 128 + 16 * q8;
#pragma unroll
      for (int j = 0; j < 4; ++j) { const f32x4 g4 = *(const f32x4*)(gp + 4 * j); gon[4 * j] = g4[0]; gon[4 * j + 1] = g4[1]; gon[4 * j + 2] = g4[2]; gon[4 * j + 3] = g4[3]; } }
    GlaInC in = gla_c_issue(params_ptr(), c, tid);
    int seg1 = seg, ci1 = 1; if (ci1 >= (seg < 256 ? 8 : 1)) { seg1 = seg + G; ci1 = 0; }
    bool has1 = seg1 < NSEG; int c1 = has1 ? (seg1 < 256 ? seg1 * 8 + ci1 : 2048 + (seg1 - 256)) : c;
    GlaInC in2 = in; if (has1) in2 = gla_c_issue(params_ptr(), c1, tid);
    auto step = [&](GlaInC& in) -> bool {
        KParams P = params_ptr(); const int nch = seg < 256 ? 8 : 1;
        const float* SSEG = (const float*)(P->ws + WS_SC); const float* LSEG = SSEG + (size_t)NSEG * 8192;
        if (ci == 0) {
            if (seg >= 256) { const float* sg = P->in[I_SGLA] + ((size_t)L * 64 + (seg - 256)) * 8192 + so;
#pragma unroll
                for (int r = 0; r < 16; ++r) S0[r] = sg[((r & 3) + 8 * (r >> 2)) * 128]; }
            else { const int jn = seg & 7, sb = seg - jn;
#pragma unroll
                for (int j = 0; j < 16; ++j) S0[j] = 0.f;
#pragma unroll 1
                for (int j0 = 0; j0 < jn; j0 += 2) {
                    float sv[2][16], lv[2][16];
#pragma unroll
                    for (int jj = 0; jj < 2; ++jj) if (j0 + jj < jn) { const float* sp = SSEG + (size_t)(sb + j0 + jj) * 8192 + so; const float* lp = LSEG + (size_t)(sb + j0 + jj) * 64 + 32 * (wave & 1) + 4 * hi;
#pragma unroll
                        for (int r = 0; r < 16; ++r) { sv[jj][r] = sp[((r & 3) + 8 * (r >> 2)) * 128]; lv[jj][r] = lp[(r & 3) + 8 * (r >> 2)]; } }
#pragma unroll
                    for (int jj = 0; jj < 2; ++jj) if (j0 + jj < jn) {
#pragma unroll
                        for (int r = 0; r < 16; ++r) S0[r] = lv[jj][r] * S0[r] + sv[jj][r]; }
                }
            }
        }
        int row0, ntok, h; gla_ids(c, row0, ntok, h); const bool live = t < ntok;
        *(LAS v4u*)(QT + t * 144 + q8 * 16) = in.q; *(LAS v4u*)(KT + t * 144 + q8 * 16) = in.k;
        *(LAS v4u*)(VT + t * 272 + q8 * 32) = in.v0; *(LAS v4u*)(VT + t * 272 + q8 * 32 + 16) = in.v1;
#pragma unroll
        for (int r = 0; r < 16; ++r) *(LAS unsigned short*)(ST + (32 * (wave & 1) + crow(r, hi)) * 272 + (32 * (wave >> 1) + r32) * 2) = (unsigned short)(cvtpk(S0[r], 0.f) & 0xffffu);
        if (tid < 64) LAMS[tid] = in.lc;
        const v4u l0 = in.l0, l1 = in.l1;
        int seg2 = seg1, ci2 = ci1 + 1; if (ci2 >= (seg1 < 256 ? 8 : 1)) { seg2 = seg1 + G; ci2 = 0; }
        const bool has2 = has1 && seg2 < NSEG; const int c2 = has2 ? (seg2 < 256 ? seg2 * 8 + ci2 : 2048 + (seg2 - 256)) : c1;
        if (has2) in = gla_c_issue(P, c2, tid);
        __syncthreads();
        { const int tb = wave & 1, vb = wave >> 1;
          pg8::bf16x8 qf[4];
#pragma unroll
          for (int k4 = 0; k4 < 4; ++k4) qf[k4] = *(const LAS pg8::bf16x8*)(QT + (32 * tb + r32) * 144 + (16 * k4 + 8 * hi) * 2);
          f32x16 o;
#pragma unroll
          for (int r = 0; r < 16; ++r) o[r] = 0.f;
          const LAS unsigned char* sa = ST + (8 * hi + ((lane & 15) >> 2)) * 272 + (32 * vb + 16 * ((lane >> 4) & 1) + 4 * (lane & 3)) * 2;
#pragma unroll
          for (int k4 = 0; k4 < 4; ++k4) { const s16x4 b0 = vtr(sa + k4 * 16 * 272), b1 = vtr(sa + k4 * 16 * 272 + 4 * 272);
              o = __builtin_amdgcn_mfma_f32_32x32x16_bf16(qf[k4], (pg8::bf16x8){b0[0], b0[1], b0[2], b0[3], b1[0], b1[1], b1[2], b1[3]}, o, 0, 0, 0); }
#pragma unroll
          for (int sb = 0; sb < 2; ++sb) if (sb <= tb) {
              f32x16 at;
#pragma unroll
              for (int r = 0; r < 16; ++r) at[r] = 0.f;
#pragma unroll
              for (int k4 = 0; k4 < 4; ++k4) at = __builtin_amdgcn_mfma_f32_32x32x16_bf16(*(const LAS pg8::bf16x8*)(KT + (32 * sb + r32) * 144 + (16 * k4 + 8 * hi) * 2), qf[k4], at, 0, 0, 0);
              if (sb == tb) {
#pragma unroll
                  for (int r = 0; r < 16; ++r) at[r] = (crow(r, hi) <= r32) ? at[r] : 0.f; }
              const LAS unsigned char* va = VT + (32 * sb + 4 * hi + ((lane & 15) >> 2)) * 272 + (32 * vb + 16 * ((lane >> 4) & 1) + 4 * (lane & 3)) * 2;
#pragma unroll
              for (int s2 = 0; s2 < 2; ++s2) { v4u pw; pw.x = cvtpk(at[8 * s2], at[8 * s2 + 1]); pw.y = cvtpk(at[8 * s2 + 2], at[8 * s2 + 3]); pw.z = cvtpk(at[8 * s2 + 4], at[8 * s2 + 5]); pw.w = cvtpk(at[8 * s2 + 6], at[8 * s2 + 7]);
                  const s16x4 b0 = vtr(va + s2 * 16 * 272), b1 = vtr(va + s2 * 16 * 272 + 8 * 272);
                  o = __builtin_amdgcn_mfma_f32_32x32x16_bf16(__builtin_bit_cast(pg8::bf16x8, pw), (pg8::bf16x8){b0[0], b0[1], b0[2], b0[3], b1[0], b1[1], b1[2], b1[3]}, o, 0, 0, 0); }
          }
#pragma unroll
          for (int r = 0; r < 16; ++r) O[(32 * tb + crow(r, hi)) * 128 + 32 * vb + r32] = o[r];
          { f32x16 acc;
#pragma unroll
            for (int r = 0; r < 16; ++r) acc[r] = 0.f;
            const LAS unsigned char* ka = KT + (8 * hi + ((lane & 15) >> 2)) * 144 + (32 * tb + 16 * ((lane >> 4) & 1) + 4 * (lane & 3)) * 2;
            const LAS unsigned char* vd = VT + (8 * hi + ((lane & 15) >> 2)) * 272 + (32 * vb + 16 * ((lane >> 4) & 1) + 4 * (lane & 3)) * 2;
#pragma unroll
            for (int s4 = 0; s4 < 4; ++s4) { const s16x4 a0 = vtr(ka + s4 * 16 * 144), a1 = vtr(ka + s4 * 16 * 144 + 4 * 144), b0 = vtr(vd + s4 * 16 * 272), b1 = vtr(vd + s4 * 16 * 272 + 4 * 272);
                const pg8::bf16x8 af = (pg8::bf16x8){a0[0], a0[1], a0[2], a0[3], a1[0], a1[1], a1[2], a1[3]}, bfr = (pg8::bf16x8){b0[0], b0[1], b0[2], b0[3], b1[0], b1[1], b1[2], b1[3]};
                acc = __builtin_amdgcn_mfma_f32_32x32x16_bf16(af, bfr, acc, 0, 0, 0); }
#pragma unroll
            for (int r = 0; r < 16; ++r) S0[r] = LAMS[32 * tb + crow(r, hi)] * (S0[r] + acc[r]); }
          if (ci == nch - 1 && (seg >= 256 || (seg & 7) == 7)) {
              float* op = (seg >= 256 ? P->out + O_GLAS + ((size_t)L * 64 + (seg - 256)) * 8192 : P->out + O_GLAP + ((size_t)L * 32 + (seg >> 3)) * 8192) + so;
#pragma unroll
              for (int r = 0; r < 16; ++r) op[((r & 3) + 8 * (r >> 2)) * 128] = S0[r]; } }
        __syncthreads();
        { float v[16]; float ss = 0.f;
#pragma unroll
          for (int j = 0; j < 16; ++j) { v[j] = O[t * 128 + 16 * q8 + j]; ss += v[j] * v[j]; }
          ss += __shfl_xor(ss, 1); ss += __shfl_xor(ss, 2); ss += __shfl_xor(ss, 4);
          const float rs = __builtin_amdgcn_rsqf(ss * (1.0f / 128.0f) + 1e-6f);
          if (live) {
              const float lr[16] = {bflo(l0.x), bfhi(l0.x), bflo(l0.y), bfhi(l0.y), bflo(l0.z), bfhi(l0.z), bflo(l0.w), bfhi(l0.w), bflo(l1.x), bfhi(l1.x), bflo(l1.y), bfhi(l1.y), bflo(l1.z), bfhi(l1.z), bflo(l1.w), bfhi(l1.w)};
              float y[16];
#pragma unroll
              for (int j = 0; j < 16; ++j) y[j] = v[j] * rs * gon[j] * lr[j];
              bf16* yo = (bf16*)(P->ws + WS_AB) + (size_t)3 * M * 512 + (size_t)(row0 + t) * 512 + h * 128 + 16 * q8;
              v4u w0, w1; w0.x = cvtpk(y[0], y[1]); w0.y = cvtpk(y[2], y[3]); w0.z = cvtpk(y[4], y[5]); w0.w = cvtpk(y[6], y[7]); w1.x = cvtpk(y[8], y[9]); w1.y = cvtpk(y[10], y[11]); w1.z = cvtpk(y[12], y[13]); w1.w = cvtpk(y[14], y[15]);
              *(GAS v4u*)yo = w0; *(GAS v4u*)(yo + 8) = w1; } }
        if (!has1) return false;
        seg = seg1; ci = ci1; c = c1; seg1 = seg2; ci1 = ci2; c1 = c2; has1 = has2;
        return true;
    };
    for (;;) { if (!step(in)) break; if (!step(in2)) break; }
}

template <int U> __device__ __forceinline__ void sg_batch(f32x16& c0, f32x16& c1, const GAS pg8::bf16x8* ap, const GAS pg8::bf16x8* b0, const GAS pg8::bf16x8* b1, int s) {
    pg8::bf16x8 a[U], w0[U], w1[U];
#pragma unroll
    for (int i = 0; i < U; ++i) { a[i] = ap[2 * (s + i)]; w0[i] = b0[2 * (s + i)]; w1[i] = b1[2 * (s + i)]; }
#pragma unroll
    for (int i = 0; i < U; ++i) { c0 = __builtin_amdgcn_mfma_f32_32x32x16_bf16(w0[i], a[i], c0, 0, 0, 0); c1 = __builtin_amdgcn_mfma_f32_32x32x16_bf16(w1[i], a[i], c1, 0, 0, 0); }
}
template <int B1OFF = 32> __device__ __forceinline__ void sg_accum(f32x16& c0, f32x16& c1, const bf16* A, int lda, const bf16* Bt, int ldb, int row0, int col0, int kbeg, int nsteps, int lane) {
    const int r32 = lane & 31, hi = lane >> 5;
    const GAS pg8::bf16x8* ap = (const GAS pg8::bf16x8*)(A + (size_t)(row0 + r32) * lda + kbeg + 8 * hi);
    const GAS pg8::bf16x8* b0 = (const GAS pg8::bf16x8*)(Bt + (size_t)(col0 + r32) * ldb + kbeg + 8 * hi);
    const GAS pg8::bf16x8* b1 = (const GAS pg8::bf16x8*)(Bt + (size_t)(col0 + B1OFF + r32) * ldb + kbeg + 8 * hi);
    asm volatile("" : "+s"(nsteps));
    int s = 0;
#pragma unroll 1
    for (; s + 8 <= nsteps; s += 8) sg_batch<8>(c0, c1, ap, b0, b1, s);
    if (nsteps & 4) { sg_batch<4>(c0, c1, ap, b0, b1, s); s += 4; }
    if (nsteps & 2) sg_batch<2>(c0, c1, ap, b0, b1, s);
}
__device__ __forceinline__ void sg_zero(f32x16& c) {
#pragma unroll
    for (int r = 0; r < 16; ++r) c[r] = 0.f;
}
__device__ __forceinline__ void sample_up_tiles(int L, int xc, int second, int gw, int NGW, int lane) {
    asm volatile("" : "+v"(lane)); const int r32 = lane & 31, hi = lane >> 5;
    for (int t = gw; t < 16 * 88; t += NGW) {
        KParams P = params_ptr(); unsigned char* ws = P->ws; const bf16* Bt = (const bf16*)(ws + WS_W + (size_t)L * LW + (second ? OW13B : OW13A));
        const int row0 = MP + 32 * (t / 88), hc = 32 * (t % 88), brow = (hc >> 7) * 256 + (hc & 127);
        f32x16 c0, c1; sg_zero(c0); sg_zero(c1);
        sg_accum<128>(c0, c1, (const bf16*)(ws + (xc ? WS_XB1 : WS_XB0)), DM, Bt, DM, row0, brow, 0, 64, lane);
        const int row = row0 + r32; const float rs = pg8::row_rstd((const float*)(ws + WS_SSQ0), row);
        bf16* hp = (bf16*)(ws + WS_HB) + (size_t)row * DFF + hc + 4 * hi;
#pragma unroll
        for (int a = 0; a < 4; ++a) { float h[4];
#pragma unroll
            for (int i = 0; i < 4; ++i) h[i] = pg8::silu_f(c0[4 * a + i] * rs) * (c1[4 * a + i] * rs);
            u32x2 w; w.x = cvtpk(h[0], h[1]); w.y = cvtpk(h[2], h[3]); *(GAS u32x2*)(hp + 8 * a) = w; }
    }
}
template <int MODE> __device__ __forceinline__ void sample_tiles(LAS unsigned char* lds, int L, int xc, int second, float alpha, int sq_out, int vcu, int G, int tid, int fin = 0) {
    asm volatile("" : "+v"(tid)); const int lane = tid & 63, wave = __builtin_amdgcn_readfirstlane(tid >> 6), r32 = lane & 31, hi = lane >> 5;
    LAS float* part = (LAS float*)lds;
    LAS float* part2 = part + 16384; asm volatile("" : "+v"(part2));
    for (int t = vcu; t < 256; t += G) {
        KParams P = params_ptr(); unsigned char* ws = P->ws; unsigned char* wl = ws + WS_W + (size_t)L * LW;
        const int row0 = MP + 32 * (t >> 4), tc = t & 15, col0 = 64 * tc;
        f32x16 c0, c1, d0, d1; sg_zero(c0); sg_zero(c1); sg_zero(d0); sg_zero(d1);
        if (MODE == 0) {
            if (sq_out == 1) sg_accum(c0, c1, (const bf16*)(ws + WS_HB), DFF, (const bf16*)(wl + (second ? OW2B : OW2A)), DFF, row0, col0, wave * 352, 22, lane);
            else sg_accum(c0, c1, (const bf16*)(ws + WS_MB), DM, (const bf16*)(wl + OWOUT), DM, row0, col0, wave * 128, 8, lane);
        } else if (MODE == 1) {
            sg_accum(c0, c1, (const bf16*)(ws + (xc ? WS_XB1 : WS_XB0)), DM, (const bf16*)(wl + OWPG), DM, row0, col0, wave * 128, 8, lane);
            sg_accum(d0, d1, (const bf16*)(ws + WS_PB) + (size_t)L * M * 256, 256, (const bf16*)(wl + OWPP), 256, row0, col0, wave * 32, 2, lane);
        } else {
            const unsigned char* gbp = ws + WS_GB + (size_t)(row0 + r32) * 4096 + col0 + 4 * hi;
            for (int b = 0; b < 4; ++b) {
                sg_zero(d0); sg_zero(d1);
                sg_accum(d0, d1, (const bf16*)(ws + WS_AB) + (size_t)b * M * 512, 512, (const bf16*)(wl + OWBR) + (size_t)b * 1024 * 512, 512, row0, col0, wave * 64, 4, lane);
#pragma unroll
                for (int a = 0; a < 4; ++a) { const unsigned g0 = *(const GAS unsigned*)(gbp + b * 1024 + 8 * a), g1 = *(const GAS unsigned*)(gbp + b * 1024 + 32 + 8 * a);
#pragma unroll
                    for (int i = 0; i < 4; ++i) { float f0 = (float)((g0 >> (8 * i)) & 255u), f1 = (float)((g1 >> (8 * i)) & 255u); f0 = (f0 > 1.0f ? f0 : 1.0f) * (1.0f / 255.0f); f1 = (f1 > 1.0f ? f1 : 1.0f) * (1.0f / 255.0f);
                        c0[4 * a + i] += f0 * d0[4 * a + i]; c1[4 * a + i] += f1 * d1[4 * a + i]; } }
            }
        }
#pragma unroll
        for (int r = 0; r < 16; ++r) { part[((wave * 32 + r) * 64) + lane] = c0[r]; part[((wave * 32 + 16 + r) * 64) + lane] = c1[r]; }
        if (MODE == 1) {
#pragma unroll
            for (int r = 0; r < 16; ++r) { part2[((wave * 32 + r) * 64) + lane] = d0[r]; part2[((wave * 32 + 16 + r) * 64) + lane] = d1[r]; }
        }
        __syncthreads();
        if (wave == 0) {
#pragma unroll 1
            for (int w = 1; w < 8; ++w) {
                const LAS float* pw_ = part + w * 2048 + lane;
#pragma unroll
                for (int r = 0; r < 16; ++r) { c0[r] += pw_[r * 64]; c1[r] += pw_[(16 + r) * 64]; }
                if (MODE == 1) { const LAS float* pd_ = part2 + w * 2048 + lane;
#pragma unroll
                    for (int r = 0; r < 16; ++r) { d0[r] += pd_[r * 64]; d1[r] += pd_[(16 + r) * 64]; } }
            }
            const int row = row0 + r32; const size_t rb = (size_t)row * 1024 + col0 + 4 * hi;
            if (MODE == 2) {
                bf16* mb = (bf16*)(ws + WS_MB) + rb;
#pragma unroll
                for (int a = 0; a < 4; ++a) { u32x2 w0, w1; w0.x = cvtpk(c0[4 * a], c0[4 * a + 1]); w0.y = cvtpk(c0[4 * a + 2], c0[4 * a + 3]); w1.x = cvtpk(c1[4 * a], c1[4 * a + 1]); w1.y = cvtpk(c1[4 * a + 2], c1[4 * a + 3]);
                    *(GAS u32x2*)(mb + 8 * a) = w0; *(GAS u32x2*)(mb + 32 + 8 * a) = w1; }
            } else {
                float* X = P->out + O_X + rb; bf16* XB = (bf16*)(ws + ((MODE == 1 ? (xc ^ 1) : xc) ? WS_XB1 : WS_XB0)) + rb; const bf16* XI = (const bf16*)(ws + (xc ? WS_XB1 : WS_XB0)) + rb; bf16* XL = (bf16*)(ws + WS_XL) + rb;
                float rs = 0.f; if (MODE == 1) rs = pg8::row_rstd((const float*)(ws + (sq_out ? WS_SSQ0 : WS_SSQ1)), row);
                float ss = 0.f;
#pragma unroll
                for (int j = 0; j < 2; ++j)
#pragma unroll
                    for (int a = 0; a < 4; ++a) { f32x4 v; const u32x2 h2 = *(const GAS u32x2*)(XI + 32 * j + 8 * a); u32x2 l2 = (u32x2){0u, 0u}; if (USE_XL) l2 = *(const GAS u32x2*)(XL + 32 * j + 8 * a);
                        f32x4 xo = (f32x4){bflo(h2.x) + bflo(l2.x), bfhi(h2.x) + bfhi(l2.x), bflo(h2.y) + bflo(l2.y), bfhi(h2.y) + bfhi(l2.y)};
#pragma unroll
                        for (int i = 0; i < 4; ++i) { const float cv = j ? c1[4 * a + i] : c0[4 * a + i]; if (MODE == 1) { const float dv = j ? d1[4 * a + i] : d0[4 * a + i]; v[i] = pg8::sigm(cv * rs) * dv * ((PROBE_DUP & 8192) ? alpha : 1.0f); } else v[i] = cv * alpha; }
                        xo = xo + v; if (fin) *(GAS f32x4*)(X + 32 * j + 8 * a) = xo; u32x2 w; w.x = cvtpk(xo[0], xo[1]); w.y = cvtpk(xo[2], xo[3]); *(GAS u32x2*)(XB + 32 * j + 8 * a) = w;
                        if (USE_XL) { u32x2 l; l.x = cvtpk(xo[0] - bflo(w.x), xo[1] - bfhi(w.x)); l.y = cvtpk(xo[2] - bflo(w.y), xo[3] - bfhi(w.y)); *(GAS u32x2*)(XL + 32 * j + 8 * a) = l; }
                        ss += (xo[0] * xo[0] + xo[1] * xo[1]) + (xo[2] * xo[2] + xo[3] * xo[3]); }
                ss += __shfl_xor(ss, 32);
                if (hi == 0) ((float*)(ws + (sq_out ? WS_SSQ1 : WS_SSQ0)))[(size_t)row * 16 + tc] = ss;
            }
        }
        __syncthreads();
    }
}

struct WaveQ { unsigned* heads; int n, s, tries; };
__device__ __forceinline__ int q_pull(WaveQ& q, int lane) {
    for (;;) {
        unsigned v = 0u; if (lane == 0) v = __hip_atomic_fetch_add(q.heads + 64 * q.s, 1u, __ATOMIC_RELAXED, __HIP_MEMORY_SCOPE_AGENT);
        const int u = (int)__builtin_amdgcn_readfirstlane(v) * 8 + q.s;
        if (u < q.n) return u;
        if (++q.tries >= 8) return q.n;
        q.s = (q.s + 1) & 7;
    }
}
__global__ void __launch_bounds__(NWAVES * 64, 2) hybrid_fwd(Params Pargs) {
    extern __shared__ __attribute__((aligned(16))) unsigned char lds_raw[];
    LAS unsigned char* lds = (LAS unsigned char*)lds_raw;
    const int tid = threadIdx.x, lane = tid & 63, wave = __builtin_amdgcn_readfirstlane(tid >> 6);
    const int G = gridDim.x, bx = blockIdx.x;
    const int vcu = (G % 8 == 0) ? (bx % 8) * (G / 8) + bx / 8 : bx;
    const int gw = vcu * NWAVES + wave, NGW = G * NWAVES;
    for (int u = tid; u < (LDS_BYTES - RING_BYTES) / 4; u += NWAVES * 64) ((LAS unsigned*)(lds + RING_BYTES))[u] = 0u;
    __syncthreads();
    (void)xcd_barrier_post((unsigned*)(params_ptr()->ws + WS_CTL) + CW_BAR, (volatile LAS unsigned*)(lds + MISC_OFF) + 8);
#define GRID_BAR() do { XcdBarrier b_; b_.bar = (unsigned*)(params_ptr()->ws + WS_CTL) + CW_BAR; b_.x = xb_xcc_id(); b_.st = (volatile LAS unsigned*)(lds + MISC_OFF) + 8; xcd_barrier(b_); } while (0)

    prologue(lds, gw, NGW, wave, lane);
    GRID_BAR();
#if PROBE_DUP & 16
    prologue(lds, gw, NGW, wave, lane);
    GRID_BAR();
#endif

    for (int hl = 0; hl < 2 * NL; ++hl) {
        const int L = hl >> 1, second = hl & 1, xc = L & 1;
        for (int rep_ = 0; rep_ < ((PROBE_DUP & 1) ? 2 : 1); ++rep_) {
        { KParams P = params_ptr(); unsigned char* ws = P->ws; unsigned char* wl = ws + WS_W + (size_t)L * LW;
          pg8::Gemm g{(const bf16*)(ws + (xc ? WS_XB1 : WS_XB0)), (const bf16*)(wl + (second ? OW13B : OW13A)), MP, 5632, DM}; pg8::RstdOrder S; S.init(MP, 5632, G, bx, WGM_UP); S.kp = P; S.sq = 0; S.rl = (LAS float*)(lds + RSTD_OFF); S.nd = 0; S.started = false;
          pg8::EpiSwiGLU E{P, (const LAS float*)(lds + RSTD_OFF)};
          pg8::gemm_phase<pg8::EpiSwiGLU, pg8::RstdOrder, true, true>(lds, g, S, E); }
        sample_up_tiles(L, xc, second, gw, NGW, lane);
        GRID_BAR();
        }
        for (int rep_ = 0; rep_ < ((PROBE_DUP & 2048) ? 2 : 1); ++rep_) {
        { KParams P = params_ptr(); unsigned char* ws = P->ws; unsigned char* wl = ws + WS_W + (size_t)L * LW;
          pg8::Gemm g{(const bf16*)(ws + WS_HB), (const bf16*)(wl + (second ? OW2B : OW2A)), MP, DM, DFF}; pg8::StaticOrder S; S.init(MP, DM, G, bx, WGM_X);
          pg8::EpiX<false> E{P, xc, xc, 1, (PROBE_DUP & 2048) ? 0.25f : 0.5f, nullptr, 0};
          pg8::gemm_phase<pg8::EpiX<false>, pg8::StaticOrder, true, true>(lds, g, S, E); }
        sample_tiles<0>(lds, L, xc, second, (PROBE_DUP & 2048) ? 0.25f : 0.5f, 1, vcu, G, tid);
        GRID_BAR();
        }
        if (!second) {
            for (int rep_ = 0; rep_ < ((PROBE_DUP & 2) ? 2 : 1); ++rep_) {
            { KParams P = params_ptr(); unsigned char* ws = P->ws; unsigned char* wl = ws + WS_W + (size_t)L * LW;
              pg8::Gemm g{(const bf16*)(ws + (xc ? WS_XB1 : WS_XB0)), (const bf16*)(wl + OWIN), M, NIN, DM}; pg8::RstdOrder S; S.init(M, NIN, G, bx, WGM_IN); S.kp = P; S.sq = 1; S.rl = (LAS float*)(lds + RSTD_OFF); S.nd = 0; S.started = false;
              pg8::EpiIn E{P, L, (const LAS float*)(lds + RSTD_OFF)};
              pg8::gemm_phase<pg8::EpiIn, pg8::RstdOrder, true, true>(lds, g, S, E); }
            GRID_BAR();
            }
            for (int rep_ = 0; rep_ < ((PROBE_DUP & 4) ? 2 : 1); ++rep_) {
#if PROBE_DUP & 262144
            { const unsigned long long t0_ = wall_clock64(); while (wall_clock64() - t0_ < 25000ull) __builtin_amdgcn_s_sleep(64); }
#endif
            for (int rq_ = 0; rq_ < ((PROBE_DUP & 32) ? 2 : 1); ++rq_) gla_pass_a_loop(lds, L, vcu, G, tid);
            for (int rq_ = 0; rq_ < ((PROBE_DUP & (64 | 256)) ? 2 : 1); ++rq_)
            { const int qn_ = (rq_ && (PROBE_DUP & 64)) ? 128 + 8192 : 128 + 8192 + M / 8 + 4096 + 256;
              WaveQ q{(unsigned*)(params_ptr()->ws + WS_CTL) + CW_Q + 512 * (2 * L) + 8192 * rq_, qn_, (int)(xb_xcc_id() & 7u), 0};
              int u = q_pull(q, lane);
              while (u < qn_) { const int un = q_pull(q, lane);
                  if (u < 128) sb_unit<true>(lds + wave * 16384, lane, L, 8192 + u);
                  else { const int k = u - 128;
                      if (k < 6 * 2048) { const int g6 = k / 6, r6 = k - 6 * g6; if (r6 < 4) sb_unit<false>(lds + wave * 16384, lane, L, 4 * g6 + r6); else pool_unit(L, 2 * g6 + (r6 - 4), lane); }
                      else { const int k2 = k - 6 * 2048;
                          if (k2 < 4096 + 256) gmlp_unit(lds + wave * 16384, lane, L, k2); else pool_unit(L, 4096 + (k2 - (4096 + 256)), lane); } }
                  u = un; } }
            GRID_BAR();
            for (int rq_ = 0; rq_ < ((PROBE_DUP & 512) ? 2 : 1); ++rq_) gla_pass_c_loop(lds, L, vcu, G, tid);
            GRID_BAR();
            }
            for (int rep_ = 0; rep_ < ((PROBE_DUP & 8) ? 2 : 1); ++rep_) {
            { KParams P = params_ptr(); unsigned char* ws = P->ws; unsigned char* wl = ws + WS_W + (size_t)L * LW;
              pg8::Gemm g{(const bf16*)(ws + WS_AB), (const bf16*)(wl + OWBR), 4 * M, 4 * DM, 512}; pg8::BranchOrder S{G, vcu};
              pg8::EpiBranch E{P};
              pg8::gemm_phase<pg8::EpiBranch, pg8::BranchOrder, true, true>(lds, g, S, E); }
            sample_tiles<2>(lds, L, xc, 0, 1.0f, 0, vcu, G, tid);
            GRID_BAR();
            }
            for (int rep_ = 0; rep_ < ((PROBE_DUP & 4096) ? 2 : 1); ++rep_) {
            { KParams P = params_ptr(); unsigned char* ws = P->ws; unsigned char* wl = ws + WS_W + (size_t)L * LW;
              pg8::Gemm g{(const bf16*)(ws + WS_MB), (const bf16*)(wl + OWOUT), MP, DM, DM}; pg8::StaticOrder S; S.init(MP, DM, G, bx, WGM_X);
              pg8::EpiX<false> E{P, xc, xc, 0, (PROBE_DUP & 4096) ? 0.5f : 1.0f, nullptr, 0};
              pg8::gemm_phase<pg8::EpiX<false>, pg8::StaticOrder, true, true>(lds, g, S, E); }
            sample_tiles<0>(lds, L, xc, 0, (PROBE_DUP & 4096) ? 0.5f : 1.0f, 0, vcu, G, tid);
            { KParams P = params_ptr(); unsigned char* ws = P->ws; unsigned char* wl = ws + WS_W + (size_t)L * LW;
              pg8::Gemm g{(const bf16*)(ws + WS_PB) + (size_t)L * M * 256, (const bf16*)(wl + OWPP), MP, DM, 256}; pg8::StaticOrder S; S.init(MP, DM, G, bx, WGM_X);
              pg8::EpiPlain E{P};
              pg8::gemm_phase<pg8::EpiPlain, pg8::StaticOrder, true, true>(lds, g, S, E); }
            GRID_BAR();
            }
        } else {
            for (int rep_ = 0; rep_ < ((PROBE_DUP & 8192) ? 2 : 1); ++rep_) {
            { KParams P = params_ptr(); unsigned char* ws = P->ws; unsigned char* wl = ws + WS_W + (size_t)L * LW;
              pg8::Gemm g{(const bf16*)(ws + (xc ? WS_XB1 : WS_XB0)), (const bf16*)(wl + OWPG), MP, DM, DM}; pg8::RstdOrder S; S.init(MP, DM, G, bx, WGM_X); S.kp = P; S.sq = 1; S.rl = (LAS float*)(lds + RSTD_OFF); S.nd = 0; S.started = false;
              pg8::EpiX<true> E{P, xc, xc ^ 1, 0, (PROBE_DUP & 8192) ? 0.5f : 1.0f, (const LAS float*)(lds + RSTD_OFF), hl == 2 * NL - 1};
              pg8::gemm_phase<pg8::EpiX<true>, pg8::RstdOrder, true, true>(lds, g, S, E); }
            sample_tiles<1>(lds, L, xc, 0, (PROBE_DUP & 8192) ? 0.5f : 1.0f, 0, vcu, G, tid, hl == 2 * NL - 1);
            GRID_BAR();
            }
        }
    }
#undef GRID_BAR
}

extern "C" void kernel_launch(void* const* d_in, const int* in_sizes, int n_in, void* d_out, int out_size, void* d_ws, size_t ws_size, hipStream_t stream) {
    static int grid = 0;
    if (grid == 0) {
        if (n_in != 32 || (size_t)out_size != O_END || ws_size < WS_END) { fprintf(stderr, "kernel_launch: unexpected shapes: n_in %d out %d ws %zu (want 32, %zu, >= %zu)\n", n_in, out_size, ws_size, (size_t)O_END, (size_t)WS_END); grid = -1; return; }
        int dev = 0, cus = 0, per_cu = 0;
        if (hipGetDevice(&dev) != hipSuccess || hipDeviceGetAttribute(&cus, hipDeviceAttributeMultiprocessorCount, dev) != hipSuccess) { grid = -1; return; }
        if (hipFuncSetAttribute((const void*)hybrid_fwd, hipFuncAttributeMaxDynamicSharedMemorySize, LDS_BYTES) != hipSuccess) { fprintf(stderr, "kernel_launch: hipFuncSetAttribute failed\n"); grid = -1; return; }
        if (hipOccupancyMaxActiveBlocksPerMultiprocessor(&per_cu, (const void*)hybrid_fwd, NWAVES * 64, LDS_BYTES) != hipSuccess || per_cu < 1) fprintf(stderr, "kernel_launch: occupancy query reports %d\n", per_cu);
        (void)hipGetLastError();
        grid = cus;
    }
    if (grid < 0) return;
    if (hipMemsetAsync((char*)d_ws + WS_CTL, 0, CTL_ZERO_BYTES, stream) != hipSuccess) return;
    Params p{};
    for (int i = 0; i < 32; ++i) p.in[i] = (const float*)d_in[i];
    p.out = (float*)d_out; p.ws = (unsigned char*)d_ws;
    hipLaunchKernelGGL(hybrid_fwd, dim3(grid), dim3(NWAVES * 64), LDS_BYTES, stream, p);
    const hipError_t le = hipPeekAtLastError();
    if (le != hipSuccess) fprintf(stderr, "kernel_launch: launch failed: %s\n", hipGetErrorName(le));
}
```

```cpp
#include <hip/hip_runtime.h>
#include <cstdio>
#include <cstdint>
#define GAS __attribute__((address_space(1)))
#define LAS __attribute__((address_space(3)))
typedef unsigned short bf16;
#ifndef PROBE_DUP
#define PROBE_DUP 0
#endif

constexpr int NWAVES = 8;
constexpr int DM = 1024, MP = 32768, MS = 512, M = MP + MS, NL = 4, DFF = 2816, NIN = 8960;
constexpr int NCHUNK = 2048 + 64;
constexpr int NSEQ = 32 + 64;
constexpr int NSEG = 256 + 64;
constexpr size_t O_X = 0, O_KP = (size_t)M * DM, O_VP = O_KP + (size_t)NL * MP * 512, O_POOLP = O_VP + (size_t)NL * MP * 512, O_GLAP = O_POOLP + (size_t)NL * 8 * 15 * 512,
    O_KS = O_GLAP + (size_t)NL * 8 * 4 * 64 * 128, O_VS = O_KS + (size_t)NL * MS * 512, O_POOLS = O_VS + (size_t)NL * MS * 512, O_GLAS = O_POOLS + (size_t)NL * 16 * 15 * 512,
    O_GVS = O_GLAS + (size_t)NL * 16 * 4 * 64 * 128, O_END = O_GVS + (size_t)NL * MS * 512;
constexpr size_t MiB = 1u << 20;
constexpr size_t WS_CTL = 0, CTL_ZERO_BYTES = 1 * MiB;
constexpr size_t WS_W = 2 * MiB, LW = 60 * MiB;
constexpr size_t OW13A = 0, OW2A = 11 * MiB, OW13B = 16 * MiB + MiB / 2, OW2B = 27 * MiB + MiB / 2, OWIN = 33 * MiB, OWBR = 50 * MiB + MiB / 2, OWOUT = 54 * MiB + MiB / 2, OWPG = 56 * MiB + MiB / 2,
    OWPP = 58 * MiB + MiB / 2, OWM = 59 * MiB;
constexpr size_t WS_XB0 = 242 * MiB, WS_XB1 = 307 * MiB, WS_SSQ0 = 372 * MiB, WS_SSQ1 = 375 * MiB, WS_HB = 378 * MiB;
constexpr size_t WS_XPB = 557 * MiB, WS_QB = 590 * MiB, WS_KB = 623 * MiB, WS_VB = 656 * MiB, WS_GUB = 689 * MiB, WS_GVB = 722 * MiB, WS_LVB = 755 * MiB, WS_LRB = 788 * MiB;
constexpr size_t WS_LQB = 821 * MiB, WS_LKB = 838 * MiB, WS_LAB = 855 * MiB, WS_GB = 872 * MiB, WS_AB = 1132 * MiB, WS_MB = 1262 * MiB, WS_PPB = 1327 * MiB, WS_PB = 1392 * MiB;
constexpr size_t WS_QT = 1457 * MiB, WS_KT = 1490 * MiB, WS_DS = 1523 * MiB, WS_SC = 1589 * MiB, WS_LAM = 1655 * MiB, WS_XL = 1656 * MiB, WS_END = 1721 * MiB;
static_assert(OW13A + (size_t)5632 * 1024 * 2 <= OW2A && OW2A + (size_t)1024 * 2816 * 2 <= OW13B && OW13B + (size_t)5632 * 1024 * 2 <= OW2B && OW2B + (size_t)1024 * 2816 * 2 <= OWIN &&
              OWIN + (size_t)NIN * 1024 * 2 <= OWBR && OWBR + (size_t)4 * 1024 * 512 * 2 <= OWOUT && OWOUT + 2 * MiB <= OWPG && OWPG + 2 * MiB <= OWPP && OWPP + MiB / 2 <= OWM && OWM + 131072 <= LW, "weight map");
static_assert(WS_W + NL * LW <= WS_XB0 && WS_XB0 + (size_t)M * DM * 2 <= WS_XB1 && WS_XB1 + (size_t)M * DM * 2 <= WS_SSQ0 && WS_SSQ0 + (size_t)M * 64 <= WS_SSQ1 && WS_SSQ1 + (size_t)M * 64 <= WS_HB &&
              WS_HB + (size_t)M * DFF * 2 <= WS_XPB && WS_XPB + (size_t)M * 1024 <= WS_QB && WS_LRB + (size_t)M * 1024 <= WS_LQB && WS_LQB + (size_t)M * 512 <= WS_LKB && WS_LAB + (size_t)M * 512 <= WS_GB &&
              WS_GB + (size_t)M * 8192 <= WS_AB && WS_AB + (size_t)4 * M * 1024 <= WS_MB && WS_MB + (size_t)M * 2048 <= WS_PPB && WS_PPB + (size_t)M * 2048 <= WS_PB && WS_PB + (size_t)4 * M * 512 <= WS_QT &&
              WS_QT + (size_t)M * 1024 <= WS_KT && WS_KT + (size_t)M * 1024 <= WS_DS && WS_DS + (size_t)NCHUNK * 32768 <= WS_SC && WS_SC + (size_t)NCHUNK * 32768 <= WS_LAM && WS_LAM + (size_t)NCHUNK * 256 <= WS_XL && WS_XL + (size_t)M * DM * 2 <= WS_END, "ws map");
constexpr int WGM_UP = 8, WGM_IN = 8, WGM_X = 8;
constexpr float SB_CUT = 48.f;
constexpr bool USE_XL = false;
constexpr int CW_BAR = 4096;
constexpr int CW_Q = 8192;
constexpr int RING_BYTES = 131072, MISC_OFF = RING_BYTES + 320, RSTD_OFF = RING_BYTES + 2048  , LDS_BYTES = 147456;

typedef float f32x16 __attribute__((ext_vector_type(16)));
typedef short s16x4 __attribute__((ext_vector_type(4)));
typedef short v4i16_t __attribute__((ext_vector_type(4)));
typedef unsigned u32x2 __attribute__((ext_vector_type(2)));

struct Params { const float* in[32]; float* out; unsigned char* ws; };
enum { I_XP = 0, I_XS, I_PP, I_PS, I_CK, I_CV, I_SPOOL, I_SGLA, I_N1, I_F1W1, I_F1W3, I_F1W2, I_NM, I_WIN, I_POOLW, I_POOLS, I_QN, I_KN, I_GWS, I_GB, I_WA2, I_BA, I_GON, I_WBR, I_WOUT, I_N2, I_F2W1,
       I_F2W3, I_F2W2, I_NPL, I_WPG, I_WPP };


typedef const __attribute__((address_space(4))) Params* KParams;
__device__ __forceinline__ KParams params_ptr() { KParams p = (KParams)__builtin_amdgcn_kernarg_segment_ptr(); asm volatile("" : "+s"(p)); return p; }
namespace pg8 {
#define PG8_LAS __attribute__((address_space(3)))
typedef unsigned short bf16_t;
typedef short bf16x8 __attribute__((ext_vector_type(8)));
typedef float f32x4 __attribute__((ext_vector_type(4)));
typedef unsigned u32x4 __attribute__((ext_vector_type(4)));
constexpr int BM = 256, BK = 64, HALF = 128, HTB = HALF * BK * 2  , STAGE_BYTES = 8 * HTB, NXCD = 8, WGM = 8;

__host__ __device__ __forceinline__ int lds_byte(int r, int c) { const int st = (r >> 4) * 2 + (c >> 5), rr = r & 15, cc = c & 31, ob = rr * 64 + cc * 2; return st * 1024 + (ob ^ (((ob >> 9) & 1) << 5)); }
__host__ __device__ __forceinline__ void stage_rc(int b, int& R, int& C) { const int st = b / 1024, sb = b % 1024, swz = sb ^ (((sb >> 9) & 1) << 5); R = (st >> 1) * 16 + swz / 64; C = (st & 1) * 32 + (swz % 64) / 2; }
__host__ __device__ __forceinline__ int perm32(int rho) { const int n = rho >> 4, i = rho & 15; return 8 * (i >> 2) + 4 * n + (i & 3); }

struct Unit { int pm, pn, slot; };
struct Gemm { const bf16_t* A; const bf16_t* Bt; int M, N, K; };

struct StaticOrder {
    int nM, nN, nwg, G, c, wgm;
    __host__ __device__ void init(int M, int N, int G_, int c_, int wgm_ = WGM) { nM = M / BM; nN = N / BM; nwg = nM * nN; G = G_; c = c_; wgm = wgm_; }
    __host__ __device__ bool next(int i, Unit& u) const {
        const long L = (long)i * G + c; if (L >= nwg) return false;
        int wgid = (int)L; { const int q = nwg / NXCD, r = nwg % NXCD, xcd = wgid % NXCD, off = wgid / NXCD; wgid = (xcd < r ? xcd * (q + 1) : r * (q + 1) + (xcd - r) * q) + off; }
        const int nig = wgm * nN, gid = wgid / nig, fm = gid * wgm, gsz = (nM - fm) < wgm ? (nM - fm) : wgm;
        u.pm = fm + ((wgid % nig) % gsz); u.pn = (wgid % nig) / gsz; u.slot = i & 1; return true;
    }
    __device__ __forceinline__ void a_ready(const Unit&) const {}
    __device__ __forceinline__ void done(const Unit&) const {}
};

typedef float f32x2 __attribute__((ext_vector_type(2)));
typedef __bf16 bf16x2_t __attribute__((ext_vector_type(2)));
__device__ __forceinline__ unsigned cvt_pk_bf16(float lo, float hi) { const bf16x2_t r = __builtin_convertvector((f32x2){lo, hi}, bf16x2_t); return __builtin_bit_cast(unsigned, r); }
__device__ __forceinline__ float sigm(float t) { return __builtin_amdgcn_rcpf(1.0f + __builtin_amdgcn_exp2f(-1.4426950408889634f * t)); }
__device__ __forceinline__ float silu_f(float t) { return t * sigm(t); }
__device__ __forceinline__ float gelu_tanh_f(float t) { return t * sigm(1.5957691216057308f * (t + 0.044715f * t * t * t)); }
__device__ __forceinline__ f32x2 sigm_arg2(f32x2 a) { const f32x2 d = (f32x2){__builtin_amdgcn_exp2f(a[0]), __builtin_amdgcn_exp2f(a[1])} + (f32x2){1.0f, 1.0f}; return (f32x2){__builtin_amdgcn_rcpf(d[0]), __builtin_amdgcn_rcpf(d[1])}; }
__device__ __forceinline__ f32x2 silu2(f32x2 t) { return t * sigm_arg2(t * (f32x2){-1.4426950408889634f, -1.4426950408889634f}); }
__device__ __forceinline__ f32x2 gelu_tanh2(f32x2 t) { constexpr float k0 = -1.4426950408889634f * 1.5957691216057308f, k1 = k0 * 0.044715f;
    return t * sigm_arg2(t * ((t * t) * (f32x2){k1, k1} + (f32x2){k0, k0})); }
__device__ __forceinline__ float bf_lo(unsigned w) { return __uint_as_float(w << 16); }
__device__ __forceinline__ float bf_hi(unsigned w) { return __uint_as_float(w & 0xffff0000u); }
__device__ __forceinline__ float row_rstd(const float* ssq, int row) {
    const f32x4* p = (const f32x4*)(ssq + (size_t)row * 16); const f32x4 a = p[0], b = p[1], c = p[2], d = p[3];
    const float s = (((a[0] + a[1]) + (a[2] + a[3])) + ((b[0] + b[1]) + (b[2] + b[3]))) + (((c[0] + c[1]) + (c[2] + c[3])) + ((d[0] + d[1]) + (d[2] + d[3])));
    return __builtin_amdgcn_rsqf(s * (1.0f / 1024.0f) + 1e-6f);
}
struct RstdOrder : StaticOrder {
    KParams kp; int sq; PG8_LAS float* rl; mutable int nd; mutable bool started;
    __device__ __forceinline__ bool next(int i, Unit& u) const { return StaticOrder::next(i, u); }
    __device__ __forceinline__ void fill(const Unit& u) const {
        int t = threadIdx.x; asm volatile("" : "+v"(t));
        if (t < 256) { KParams q = kp; asm volatile("" : "+s"(q)); rl[u.slot * 256 + t] = row_rstd((const float*)(q->ws + (sq ? WS_SSQ1 : WS_SSQ0)), u.pm * BM + t); }
    }
    __device__ __forceinline__ void a_ready(const Unit& u) const { if (!started) { started = true; fill(u); } }
    __device__ __forceinline__ void done(const Unit&) const { ++nd; Unit n; if (next(nd, n)) fill(n); }
};
__device__ __forceinline__ u32x4 pack8(const f32x4 a, const f32x4 b) { u32x4 w; w.x = cvt_pk_bf16(a[0], a[1]); w.y = cvt_pk_bf16(a[2], a[3]); w.z = cvt_pk_bf16(b[0], b[1]); w.w = cvt_pk_bf16(b[2], b[3]); return w; }

struct EpiSwiGLU {
    static constexpr bool PERM = true, AFTER_DRAIN = false, HAS_INIT = false;
    KParams kp; const PG8_LAS float* rl;
    __device__ __forceinline__ void operator()(const f32x4 (&acc)[2][2][4][2], const Unit& u, int wr, int wc, int fr, int fq) const {
        KParams q = kp; asm volatile("" : "+s"(q)); unsigned char* ws = q->ws;
        bf16_t* H = (bf16_t*)(ws + WS_HB); const PG8_LAS float* rt = rl + u.slot * 256 + wr * 64 + fr;
        const int col0 = u.pn * 128 + wc * 32 + 8 * fq;
#pragma unroll
        for (int ai = 0; ai < 2; ++ai)
#pragma unroll
            for (int m = 0; m < 4; ++m) {
                const int row = u.pm * BM + ai * HALF + wr * 64 + m * 16 + fr; const float rs = rt[ai * HALF + m * 16]; const float cexp = -1.4426950408889634f * rs, rs2 = rs * rs;
                const f32x2 c2 = (f32x2){cexp, cexp}, r2 = (f32x2){rs2, rs2};
                f32x4 h0, h1;
#pragma unroll
                for (int n = 0; n < 2; ++n)
#pragma unroll
                    for (int p2 = 0; p2 < 2; ++p2) { const f32x4 g4 = acc[ai][0][m][n], u4 = acc[ai][1][m][n];
                        const f32x2 g = p2 ? (f32x2){g4[2], g4[3]} : (f32x2){g4[0], g4[1]}, u = p2 ? (f32x2){u4[2], u4[3]} : (f32x2){u4[0], u4[1]};
                        const f32x2 t = g * c2; f32x2 d = (f32x2){__builtin_amdgcn_exp2f(t[0]), __builtin_amdgcn_exp2f(t[1])} + (f32x2){1.0f, 1.0f};
                        const f32x2 r = (f32x2){__builtin_amdgcn_rcpf(d[0]), __builtin_amdgcn_rcpf(d[1])}; const f32x2 hh = (g * u) * (r * r2);
                        if (n == 0) { h0[2 * p2] = hh[0]; h0[2 * p2 + 1] = hh[1]; } else { h1[2 * p2] = hh[0]; h1[2 * p2 + 1] = hh[1]; } }
                *(u32x4*)(H + (size_t)row * 2816 + col0) = pack8(h0, h1);
                if (m & 1) asm volatile("" ::: "memory");
            }
    }
};

template <bool PLE> struct EpiX {
    static constexpr bool PERM = true, AFTER_DRAIN = false, HAS_INIT = false;
    static constexpr int NB = PLE ? 2 : 1, MB_ = 4 / NB;
    KParams kp; int xc_in, xc_out, sq_out; float alpha; const PG8_LAS float* rl; int fin;
    __device__ __forceinline__ void init(f32x4 (&)[2][2][4][2], const Unit&, int, int, int, int) const {}
    __device__ __forceinline__ void operator()(const f32x4 (&acc)[2][2][4][2], const Unit& u, int wr, int wc, int fr, int fq) const {
        KParams q = kp; asm volatile("" : "+s"(q)); unsigned char* ws = q->ws; float* X = q->out + O_X;
        const bf16_t* XI = (const bf16_t*)(ws + (xc_in ? WS_XB1 : WS_XB0)); bf16_t* XB = (bf16_t*)(ws + (xc_out ? WS_XB1 : WS_XB0)); bf16_t* XL = (bf16_t*)(ws + WS_XL); bf16_t* ssq_dummy = nullptr; (void)ssq_dummy;
        float* ssq_out = (float*)(ws + (sq_out ? WS_SSQ1 : WS_SSQ0));
        const bf16_t* PP = (const bf16_t*)(ws + WS_PPB);
        const size_t off0 = (size_t)(u.pm * BM + wr * 64 + fr) * 1024 + u.pn * BM + wc * 32 + 8 * fq;
#pragma unroll
        for (int ab = 0; ab < 2 * NB; ++ab) { const int ai = ab / NB, mb = (ab % NB) * MB_;
            u32x4 xh[4][2], xl[4][2], pw[4][2];
#pragma unroll
            for (int m = mb; m < mb + MB_; ++m)
#pragma unroll
                for (int bj = 0; bj < 2; ++bj) { const size_t off = off0 + (size_t)(ai * HALF + m * 16) * 1024 + bj * HALF;
                    xh[m][bj] = *(const u32x4*)(XI + off); if (USE_XL) xl[m][bj] = *(const u32x4*)(XL + off); if (PLE) pw[m][bj] = *(const u32x4*)(PP + off); }
#pragma unroll
            for (int m = mb; m < mb + MB_; ++m) {
                float s = 0.f; float rs = 0.f; if (PLE) rs = rl[u.slot * 256 + ai * HALF + wr * 64 + m * 16 + fr];
#pragma unroll
                for (int bj = 0; bj < 2; ++bj) { const size_t off = off0 + (size_t)(ai * HALF + m * 16) * 1024 + bj * HALF;
                    f32x4 a0 = acc[ai][bj][m][0], a1 = acc[ai][bj][m][1];
                    if (PLE) { const u32x4 p4 = pw[m][bj];
                        a0[0] = sigm(a0[0] * rs) * bf_lo(p4.x); a0[1] = sigm(a0[1] * rs) * bf_hi(p4.x); a0[2] = sigm(a0[2] * rs) * bf_lo(p4.y); a0[3] = sigm(a0[3] * rs) * bf_hi(p4.y);
                        a1[0] = sigm(a1[0] * rs) * bf_lo(p4.z); a1[1] = sigm(a1[1] * rs) * bf_hi(p4.z); a1[2] = sigm(a1[2] * rs) * bf_lo(p4.w); a1[3] = sigm(a1[3] * rs) * bf_hi(p4.w);
#if PROBE_DUP & 8192
                        a0 = a0 * alpha; a1 = a1 * alpha;
#endif
                    } else { a0 = a0 * alpha; a1 = a1 * alpha; }
                    const u32x4 h4 = xh[m][bj]; u32x4 l4 = (u32x4){0u, 0u, 0u, 0u}; if (USE_XL) l4 = xl[m][bj];
                    const f32x4 x0 = (f32x4){bf_lo(h4.x) + bf_lo(l4.x), bf_hi(h4.x) + bf_hi(l4.x), bf_lo(h4.y) + bf_lo(l4.y), bf_hi(h4.y) + bf_hi(l4.y)} + a0;
                    const f32x4 x1 = (f32x4){bf_lo(h4.z) + bf_lo(l4.z), bf_hi(h4.z) + bf_hi(l4.z), bf_lo(h4.w) + bf_lo(l4.w), bf_hi(h4.w) + bf_hi(l4.w)} + a1;
                    const u32x4 hw = pack8(x0, x1);
                    const f32x4 r0 = x0 - (f32x4){bf_lo(hw.x), bf_hi(hw.x), bf_lo(hw.y), bf_hi(hw.y)}, r1 = x1 - (f32x4){bf_lo(hw.z), bf_hi(hw.z), bf_lo(hw.w), bf_hi(hw.w)};
                    *(u32x4*)(XB + off) = hw; if (USE_XL) *(u32x4*)(XL + off) = pack8(r0, r1);
                    if (fin) { *(f32x4*)(X + off) = x0; *(f32x4*)(X + off + 4) = x1; }
                    s += ((x0[0] * x0[0] + x0[1] * x0[1]) + (x0[2] * x0[2] + x0[3] * x0[3])) + ((x1[0] * x1[0] + x1[1] * x1[1]) + (x1[2] * x1[2] + x1[3] * x1[3]));
                }
                s += __shfl_xor(s, 16); s += __shfl_xor(s, 32);
                if (fq == 0) ssq_out[(size_t)(u.pm * BM + ai * HALF + wr * 64 + m * 16 + fr) * 16 + u.pn * 4 + wc] = s;
            }
            asm volatile("" ::: "memory");
        }
    }
};

struct EpiIn {
    static constexpr bool PERM = true, AFTER_DRAIN = false, HAS_INIT = false;
    KParams kp; int L; const PG8_LAS float* rl;
    __device__ __forceinline__ void operator()(const f32x4 (&acc)[2][2][4][2], const Unit& u, int wr, int wc, int fr, int fq) const {
        KParams q = kp; asm volatile("" : "+s"(q)); unsigned char* ws = q->ws; float* out = q->out;
        const PG8_LAS float* rt = rl + u.slot * 256 + wr * 64 + fr;
        const int t = u.pn; const bool samp = u.pm >= 128;
        if (t >= 2 && t < 6) {
            const bool isk = t >= 4; const float* gn = q->in[isk ? I_KN : I_QN] + L * 64; bf16_t* dst = (bf16_t*)(ws + (isk ? WS_KB : WS_QB));
            float* fo = isk ? (samp ? out + O_KS + (size_t)L * MS * 512 - (size_t)32768 * 512 : out + O_KP + (size_t)L * MP * 512) : nullptr;
            const float sc = isk ? 1.0f : 0.125f * 1.4426950408889634f;
            f32x4 g[2][2];
#pragma unroll
            for (int bj = 0; bj < 2; ++bj)
#pragma unroll
                for (int n = 0; n < 2; ++n) g[bj][n] = *(const f32x4*)(gn + 32 * bj + 8 * fq + 4 * n) * sc;
            const int hcol = (4 * (t & 1) + wc) * 64 + 8 * fq;
#pragma unroll
            for (int ai = 0; ai < 2; ++ai)
#pragma unroll
                for (int m = 0; m < 4; ++m) {
                    const int row = u.pm * BM + ai * HALF + wr * 64 + m * 16 + fr; const float rs = rt[ai * HALF + m * 16];
                    f32x4 v[2][2]; float ss = 0.f;
#pragma unroll
                    for (int bj = 0; bj < 2; ++bj)
#pragma unroll
                        for (int n = 0; n < 2; ++n) { v[bj][n] = acc[ai][bj][m][n] * rs; ss += (v[bj][n][0] * v[bj][n][0] + v[bj][n][1] * v[bj][n][1]) + (v[bj][n][2] * v[bj][n][2] + v[bj][n][3] * v[bj][n][3]); }
                    ss += __shfl_xor(ss, 16); ss += __shfl_xor(ss, 32);
                    const float hr = __builtin_amdgcn_rsqf(ss * (1.0f / 64.0f) + 1e-6f);
#pragma unroll
                    for (int bj = 0; bj < 2; ++bj) { const f32x4 o0 = v[bj][0] * hr * g[bj][0], o1 = v[bj][1] * hr * g[bj][1];
                        const size_t off = (size_t)row * 512 + hcol + 32 * bj;
                        *(u32x4*)(dst + off) = pack8(o0, o1);
                        if (fo) { __builtin_nontemporal_store(o0, (f32x4*)(fo + off)); __builtin_nontemporal_store(o1, (f32x4*)(fo + off + 4)); }   }
                    asm volatile("" ::: "memory");
                }
            return;
        }
        if (t >= 18 && t < 34) {
            unsigned char* g8 = ws + WS_GB + (size_t)(256 * (t - 18)) + wc * 32 + 8 * fq;
#pragma unroll
            for (int ai = 0; ai < 2; ++ai)
#pragma unroll
                for (int m = 0; m < 4; ++m) {
                    const int row = u.pm * BM + ai * HALF + wr * 64 + m * 16 + fr; const float cexp = -1.4426950408889634f * rt[ai * HALF + m * 16];
#pragma unroll
                    for (int bj = 0; bj < 2; ++bj) { unsigned w0 = 0u, w1 = 0u;
#pragma unroll
                        for (int n = 0; n < 2; ++n)
#pragma unroll
                            for (int p2 = 0; p2 < 2; ++p2) {
                                const f32x4 a4 = acc[ai][bj][m][n]; const f32x2 a = p2 ? (f32x2){a4[2], a4[3]} : (f32x2){a4[0], a4[1]};
                                const f32x2 tt = a * (f32x2){cexp, cexp}; const f32x2 e = (f32x2){__builtin_amdgcn_exp2f(tt[0]), __builtin_amdgcn_exp2f(tt[1])};
                                const f32x2 d = e * (f32x2){1.0f / 255.0f, 1.0f / 255.0f} + (f32x2){1.0f / 255.0f, 1.0f / 255.0f};
                                const float y0 = __builtin_amdgcn_rcpf(d[0]), y1 = __builtin_amdgcn_rcpf(d[1]);
                                if (n == 0) { w0 = __builtin_amdgcn_cvt_pk_u8_f32(y0, 2 * p2, w0); w0 = __builtin_amdgcn_cvt_pk_u8_f32(y1, 2 * p2 + 1, w0); }
                                else { w1 = __builtin_amdgcn_cvt_pk_u8_f32(y0, 2 * p2, w1); w1 = __builtin_amdgcn_cvt_pk_u8_f32(y1, 2 * p2 + 1, w1); } }
                        typedef unsigned u32x2e __attribute__((ext_vector_type(2)));
                        __builtin_nontemporal_store((u32x2e){w0, w1}, (u32x2e*)(g8 + (size_t)row * 4096 + bj * HALF)); }
                    asm volatile("" ::: "memory");
                }
            return;
        }
        bf16_t* dst; int ld, dcol, act = 0; float* fo = nullptr;
        size_t wo;
        if (t < 2) { wo = WS_XPB; ld = 512; dcol = 256 * t; }
        else if (t < 8) { wo = WS_VB; ld = 512; dcol = 256 * (t - 6); fo = samp ? out + O_VS + (size_t)L * MS * 512 - (size_t)32768 * 512 : out + O_VP + (size_t)L * MP * 512; }
        else if (t < 10) { wo = WS_GUB; ld = 512; dcol = 256 * (t - 8); act = 1; }
        else if (t < 12) { wo = WS_GVB; ld = 512; dcol = 256 * (t - 10); act = 1; fo = samp ? out + O_GVS + (size_t)L * MS * 512 - (size_t)32768 * 512 : nullptr; }
        else if (t == 12) { wo = WS_LQB; ld = 256; dcol = 0; }
        else if (t == 13) { wo = WS_LKB; ld = 256; dcol = 0; }
        else if (t < 16) { wo = WS_LVB; ld = 512; dcol = 256 * (t - 14); }
        else if (t < 18) { wo = WS_LRB; ld = 512; dcol = 256 * (t - 16); act = 2; }
        else { wo = WS_LAB; ld = 256; dcol = 0; }
        dst = (bf16_t*)(ws + wo);
#pragma unroll
        for (int ai = 0; ai < 2; ++ai)
#pragma unroll
            for (int m = 0; m < 4; ++m) {
                const int row = u.pm * BM + ai * HALF + wr * 64 + m * 16 + fr; const float rs = rt[ai * HALF + m * 16];
#pragma unroll
                for (int bj = 0; bj < 2; ++bj) {
                    f32x4 v0 = acc[ai][bj][m][0] * rs, v1 = acc[ai][bj][m][1] * rs;
                    if (act == 1) {
#pragma unroll
                        for (int j = 0; j < 4; j += 2) { const f32x2 a = gelu_tanh2((f32x2){v0[j], v0[j + 1]}), b = gelu_tanh2((f32x2){v1[j], v1[j + 1]}); v0[j] = a[0]; v0[j + 1] = a[1]; v1[j] = b[0]; v1[j + 1] = b[1]; }
                    } else if (act == 2) {
#pragma unroll
                        for (int j = 0; j < 4; j += 2) { const f32x2 a = silu2((f32x2){v0[j], v0[j + 1]}), b = silu2((f32x2){v1[j], v1[j + 1]}); v0[j] = a[0]; v0[j + 1] = a[1]; v1[j] = b[0]; v1[j + 1] = b[1]; }
                    }
                    const int col = dcol + bj * HALF + wc * 32 + 8 * fq;
                    *(u32x4*)(dst + (size_t)row * ld + col) = pack8(v0, v1);
                    if (fo) { float* f = fo + (size_t)row * 512 + col; __builtin_nontemporal_store(v0, (f32x4*)f); __builtin_nontemporal_store(v1, (f32x4*)(f + 4)); }
                }
                if (m & 1) asm volatile("" ::: "memory");
            }
    }
};

struct EpiBranch {
    static constexpr bool PERM = true, AFTER_DRAIN = false, HAS_INIT = true;
    KParams kp;
    __device__ __forceinline__ void init(f32x4 (&acc)[2][2][4][2], const Unit& u, int, int, int, int) const {
        if (u.pm < 130) {
#pragma unroll
            for (int a = 0; a < 2; ++a)
#pragma unroll
                for (int b = 0; b < 2; ++b)
#pragma unroll
                    for (int m = 0; m < 4; ++m)
#pragma unroll
                        for (int n = 0; n < 2; ++n) acc[a][b][m][n] = (f32x4){0.f, 0.f, 0.f, 0.f};
        }
    }
    __device__ __forceinline__ void operator()(const f32x4 (&acc_)[2][2][4][2], const Unit& u, int wr, int wc, int fr, int fq) const {
        f32x4 (&acc)[2][2][4][2] = const_cast<f32x4 (&)[2][2][4][2]>(acc_);
        KParams q = kp; asm volatile("" : "+s"(q)); unsigned char* ws = q->ws; const unsigned char* G = ws + WS_GB; bf16_t* MB = (bf16_t*)(ws + WS_MB);
        const int b = u.pm / 130, pm = u.pm - b * 130, pn = u.pn & 3;
        const int row0 = pm * BM + wr * 64 + fr, col0 = pn * BM + wc * 32 + 8 * fq;
        typedef unsigned u32x2e __attribute__((ext_vector_type(2)));
#pragma unroll
        for (int ab = 0; ab < 2; ++ab) { const int ai = ab;
            u32x2e gw[4][2], gn[4][2];
#pragma unroll
            for (int m = 0; m < 4; ++m)
#pragma unroll
                for (int bj = 0; bj < 2; ++bj) { const int row = row0 + ai * HALF + m * 16, col = col0 + bj * HALF;
                    gw[m][bj] = *(const u32x2e*)(G + (size_t)row * 4096 + b * 1024 + col); if (b < 3) gn[m][bj] = *(const u32x2e*)(G + (size_t)row * 4096 + (b + 1) * 1024 + col); }
#pragma unroll
            for (int m = 0; m < 4; ++m)
#pragma unroll
                for (int bj = 0; bj < 2; ++bj) { const int row = row0 + ai * HALF + m * 16, col = col0 + bj * HALF; const u32x2e g2 = gw[m][bj];
                    float f[8] = {(float)(g2.x & 255u), (float)((g2.x >> 8) & 255u), (float)((g2.x >> 16) & 255u), (float)(g2.x >> 24), (float)(g2.y & 255u), (float)((g2.y >> 8) & 255u), (float)((g2.y >> 16) & 255u), (float)(g2.y >> 24)};
#pragma unroll
                    for (int j = 0; j < 8; ++j) f[j] = f[j] > 1.0f ? f[j] : 1.0f;
                    if (b < 3) { const u32x2e n2 = gn[m][bj]; const float d[8] = {(float)(n2.x & 255u), (float)((n2.x >> 8) & 255u), (float)((n2.x >> 16) & 255u), (float)(n2.x >> 24), (float)(n2.y & 255u), (float)((n2.y >> 8) & 255u), (float)((n2.y >> 16) & 255u), (float)(n2.y >> 24)};
#pragma unroll
                        for (int j = 0; j < 8; ++j) f[j] *= __builtin_amdgcn_rcpf(d[j] > 1.0f ? d[j] : 1.0f); }
                    else {
#pragma unroll
                        for (int j = 0; j < 8; ++j) f[j] *= (1.0f / 255.0f); }
                    f32x4 v0 = acc[ai][bj][m][0], v1 = acc[ai][bj][m][1];
                    v0[0] *= f[0]; v0[1] *= f[1]; v0[2] *= f[2]; v0[3] *= f[3]; v1[0] *= f[4]; v1[1] *= f[5]; v1[2] *= f[6]; v1[3] *= f[7];
                    if (b < 3) { acc[ai][bj][m][0] = v0; acc[ai][bj][m][1] = v1; }
                    else *(u32x4*)(MB + (size_t)row * 1024 + col) = pack8(v0, v1); }
            asm volatile("" ::: "memory");
        }
    }
};
struct BranchOrder {
    int G, c;
    __device__ __forceinline__ bool next(int i, Unit& u) const { const int tl = (i >> 2) * G + c; if (tl >= 512) return false;   const int b = i & 3; u.pm = b * 130 + (tl >> 2); u.pn = b * 4 + (tl & 3); u.slot = 0; return true; }
    __device__ __forceinline__ void a_ready(const Unit&) const {}
    __device__ __forceinline__ void done(const Unit&) const {}
};
struct EpiPlain {
    static constexpr bool PERM = true, AFTER_DRAIN = false, HAS_INIT = false;
    KParams kp;
    __device__ __forceinline__ void operator()(const f32x4 (&acc)[2][2][4][2], const Unit& u, int wr, int wc, int fr, int fq) const {
        KParams q = kp; asm volatile("" : "+s"(q)); bf16_t* O = (bf16_t*)(q->ws + WS_PPB); const int ldc = 1024;
#pragma unroll
        for (int ai = 0; ai < 2; ++ai)
#pragma unroll
            for (int m = 0; m < 4; ++m) {
                const int row = u.pm * BM + ai * HALF + wr * 64 + m * 16 + fr;
#pragma unroll
                for (int bj = 0; bj < 2; ++bj) *(u32x4*)(O + (size_t)row * ldc + u.pn * BM + bj * HALF + wc * 32 + 8 * fq) = pack8(acc[ai][bj][m][0], acc[ai][bj][m][1]);
            }
    }
};
template <class Epi, class Sched, bool ALIGN_EPI = false, bool SP2 = false>
__device__ __forceinline__ void gemm_phase(PG8_LAS unsigned char* lds, const Gemm g, const Sched& S, const Epi& E) {
    int tid = threadIdx.x; asm volatile("" : "+v"(tid));
    const int wid = __builtin_amdgcn_readfirstlane(tid >> 6), lane = tid & 63, wr = wid >> 2, wc = wid & 3, fr = lane & 15, fq = lane >> 4;
    int K = g.K; asm volatile("" : "+s"(K)); const int nt = K / BK;
    unsigned voffA[2], voffB[2];
#pragma unroll
    for (int i = 0; i < 2; ++i) { int R, C; stage_rc(tid * 16 + i * 8192, R, C); const int Rb = Epi::PERM ? ((R & ~31) + perm32(R & 31)) : R;
        voffA[i] = (unsigned)(R * K + C) * 2u; voffB[i] = (unsigned)(Rb * K + C) * 2u; }
    const size_t kstep = (size_t)(BK * 2);
    const size_t hstep = (size_t)HALF * K * 2;
    const size_t tstep = 2 * hstep;
    const unsigned ldsw = (unsigned)wid * 1024u;
    const int aoff = lds_byte(wr * 64 + fr, fq * 8), boff = lds_byte(wc * 32 + fr, fq * 8);
#define PG8_SA(b, h) (((b) * 2 + (h)) * HTB)
#define PG8_SB(b, h) ((4 + (b) * 2 + (h)) * HTB)
#define PG8_STAGE(bufoff, gbase, voff) do { _Pragma("unroll") for (int _i = 0; _i < 2; ++_i) \
        __builtin_amdgcn_global_load_lds((const unsigned*)((const char*)(gbase) + (voff)[_i]), (PG8_LAS unsigned*)(lds + (bufoff) + ldsw + _i * 8192), 16, 0, 0); } while (0)
#define PG8_LDA(dst, b, h) do { _Pragma("unroll") for (int m = 0; m < 4; ++m) _Pragma("unroll") for (int k = 0; k < 2; ++k) dst[m][k] = *(const PG8_LAS bf16x8*)(lds + PG8_SA(b, h) + aoff + m * 2048 + k * 1024); } while (0)
#define PG8_LDB(dst, b, h) do { _Pragma("unroll") for (int n = 0; n < 2; ++n) _Pragma("unroll") for (int k = 0; k < 2; ++k) dst[n][k] = *(const PG8_LAS bf16x8*)(lds + PG8_SB(b, h) + boff + n * 2048 + k * 1024); } while (0)
#define PG8_MMA(ai, bj, At, Bt) do { __builtin_amdgcn_s_setprio(1); _Pragma("unroll") for (int m = 0; m < 4; ++m) _Pragma("unroll") for (int n = 0; n < 2; ++n) _Pragma("unroll") for (int k = 0; k < 2; ++k) \
        acc[ai][bj][m][n] = __builtin_amdgcn_mfma_f32_16x16x32_bf16(Bt[n][k], At[m][k], acc[ai][bj][m][n], 0, 0, 0); __builtin_amdgcn_s_setprio(0); } while (0)
#define PG8_WAIT_V(n) asm volatile("s_waitcnt vmcnt(" #n ")" ::: "memory")
#define PG8_WAIT_L(n) asm volatile("s_waitcnt lgkmcnt(" #n ")" ::: "memory")
#define PG8_BAR __builtin_amdgcn_s_barrier()
#define PG8_SCHED __builtin_amdgcn_sched_barrier(0)
    Unit cur, nxt; int ui = 0;
    if (!S.next(0, cur)) return;
    f32x4 acc[2][2][4][2];
    if constexpr (Epi::HAS_INIT) E.init(acc, cur, wr, wc, fr, fq);
    else {
#pragma unroll
    for (int a = 0; a < 2; ++a)
#pragma unroll
        for (int b = 0; b < 2; ++b)
#pragma unroll
            for (int m = 0; m < 4; ++m)
#pragma unroll
                for (int n = 0; n < 2; ++n) acc[a][b][m][n] = (f32x4){0.f, 0.f, 0.f, 0.f};
    }
    bf16x8 At[4][2], B0[2][2], B1[2][2];
    const char* cA = (const char*)g.A + (size_t)cur.pm * tstep; const char* cB = (const char*)g.Bt + (size_t)cur.pn * tstep;
    S.a_ready(cur);
    if constexpr (SP2) {
        PG8_STAGE(PG8_SB(0, 0), cB, voffB); PG8_STAGE(PG8_SB(0, 1), cB + hstep, voffB); PG8_STAGE(PG8_SA(0, 0), cA, voffA); PG8_STAGE(PG8_SA(0, 1), cA + hstep, voffA);
        if (wr == 1) PG8_BAR;
        PG8_WAIT_V(2); PG8_BAR;
        PG8_STAGE(PG8_SB(1, 0), cB + kstep, voffB); PG8_STAGE(PG8_SA(1, 0), cA + kstep, voffA); PG8_STAGE(PG8_SB(1, 1), cB + hstep + kstep, voffB);
        PG8_WAIT_V(6); PG8_BAR;
    } else {
        PG8_STAGE(PG8_SB(0, 0), cB, voffB); PG8_STAGE(PG8_SA(0, 0), cA, voffA); PG8_STAGE(PG8_SB(0, 1), cB + hstep, voffB); PG8_STAGE(PG8_SA(0, 1), cA + hstep, voffA);
        if (wr == 1) PG8_BAR;
        PG8_WAIT_V(4); PG8_BAR;
        PG8_STAGE(PG8_SB(1, 0), cB + kstep, voffB); PG8_STAGE(PG8_SA(1, 0), cA + kstep, voffA); PG8_STAGE(PG8_SB(1, 1), cB + hstep + kstep, voffB);
        PG8_WAIT_V(6); PG8_BAR;
    }
    for (;;) {
        const bool has_next = S.next(ui + 1, nxt);
        const char* nA = has_next ? (const char*)g.A + (size_t)nxt.pm * tstep : cA; const char* nB = has_next ? (const char*)g.Bt + (size_t)nxt.pn * tstep : cB;
        for (int t = 0; t < nt; t += 2) {
            const bool last = (t == nt - 2);
            const char* a1 = cA + (size_t)(t + 1) * kstep;
            const char* a2 = last ? nA : cA + (size_t)(t + 2) * kstep; const char* b2 = last ? nB : cB + (size_t)(t + 2) * kstep;
            const char* a3 = a2 + kstep; const char* b3 = b2 + kstep;
            if (last && has_next) S.a_ready(nxt);
            if constexpr (SP2) {
            PG8_LDB(B0, 0, 0); PG8_LDB(B1, 0, 1); PG8_SCHED; PG8_LDA(At, 0, 0); PG8_STAGE(PG8_SA(1, 1), a1 + hstep, voffA);
            PG8_WAIT_V(8); PG8_WAIT_L(0); PG8_BAR; PG8_MMA(0, 0, At, B0); PG8_MMA(0, 1, At, B1); PG8_BAR; PG8_SCHED;
            PG8_LDA(At, 0, 1); PG8_STAGE(PG8_SB(0, 0), b2, voffB); PG8_STAGE(PG8_SB(0, 1), b2 + hstep, voffB); PG8_STAGE(PG8_SA(0, 0), a2, voffA);
            PG8_WAIT_V(8); PG8_WAIT_L(0); PG8_BAR; PG8_MMA(1, 0, At, B0); PG8_MMA(1, 1, At, B1); PG8_BAR; PG8_SCHED;
            PG8_LDB(B0, 1, 0); PG8_LDB(B1, 1, 1); PG8_SCHED; PG8_LDA(At, 1, 0); PG8_STAGE(PG8_SA(0, 1), a2 + hstep, voffA);
            PG8_WAIT_V(8); PG8_WAIT_L(0); PG8_BAR; PG8_MMA(0, 0, At, B0); PG8_MMA(0, 1, At, B1); PG8_BAR; PG8_SCHED;
            PG8_LDA(At, 1, 1); PG8_STAGE(PG8_SB(1, 0), b3, voffB); PG8_STAGE(PG8_SB(1, 1), b3 + hstep, voffB); PG8_STAGE(PG8_SA(1, 0), a3, voffA);
            PG8_WAIT_V(8); PG8_WAIT_L(0); PG8_BAR; PG8_MMA(1, 0, At, B0); PG8_MMA(1, 1, At, B1); PG8_BAR; PG8_SCHED;
            } else {
            PG8_LDB(B0, 0, 0); PG8_SCHED; PG8_LDA(At, 0, 0); PG8_STAGE(PG8_SA(1, 1), a1 + hstep, voffA);
            PG8_WAIT_L(8); PG8_BAR; PG8_WAIT_L(0); PG8_MMA(0, 0, At, B0); PG8_BAR; PG8_SCHED;
            PG8_LDB(B1, 0, 1); PG8_STAGE(PG8_SB(0, 0), b2, voffB);
            PG8_BAR; PG8_WAIT_L(0); PG8_MMA(0, 1, At, B1); PG8_BAR;
            PG8_LDA(At, 0, 1); PG8_STAGE(PG8_SA(0, 0), a2, voffA);
            PG8_BAR; PG8_WAIT_L(0); PG8_MMA(1, 0, At, B0); PG8_BAR; PG8_SCHED;
            PG8_STAGE(PG8_SB(0, 1), b2 + hstep, voffB);
            PG8_WAIT_V(6); PG8_BAR; PG8_MMA(1, 1, At, B1); PG8_BAR;
            PG8_LDB(B0, 1, 0); PG8_SCHED; PG8_LDA(At, 1, 0); PG8_STAGE(PG8_SA(0, 1), a2 + hstep, voffA);
            PG8_WAIT_L(8); PG8_BAR; PG8_WAIT_L(0); PG8_MMA(0, 0, At, B0); PG8_BAR; PG8_SCHED;
            PG8_LDB(B1, 1, 1); PG8_STAGE(PG8_SB(1, 0), b3, voffB);
            PG8_BAR; PG8_WAIT_L(0); PG8_MMA(0, 1, At, B1); PG8_BAR;
            PG8_LDA(At, 1, 1); PG8_STAGE(PG8_SA(1, 0), a3, voffA);
            PG8_BAR; PG8_WAIT_L(0); PG8_MMA(1, 0, At, B0); PG8_BAR; PG8_SCHED;
            PG8_STAGE(PG8_SB(1, 1), b3 + hstep, voffB);
            PG8_WAIT_V(6); PG8_BAR; PG8_MMA(1, 1, At, B1); PG8_BAR;
            }
        }
        if constexpr (ALIGN_EPI) { if (wr == 0) PG8_BAR; }
        if constexpr (!Epi::AFTER_DRAIN) { E(acc, cur, wr, wc, fr, fq); S.done(cur); }
        if (!has_next) break;
        if constexpr (Epi::HAS_INIT) E.init(acc, nxt, wr, wc, fr, fq);
        else {
#pragma unroll
        for (int a = 0; a < 2; ++a)
#pragma unroll
            for (int b = 0; b < 2; ++b)
#pragma unroll
                for (int m = 0; m < 4; ++m)
#pragma unroll
                    for (int n = 0; n < 2; ++n) acc[a][b][m][n] = (f32x4){0.f, 0.f, 0.f, 0.f};
        }
        cur = nxt; cA = nA; cB = nB; ++ui;
        if constexpr (ALIGN_EPI) { if (wr == 1) PG8_BAR; }
    }
    PG8_WAIT_V(0);
    if constexpr (!ALIGN_EPI) { if (wr == 0) PG8_BAR; }
    PG8_BAR;
    if constexpr (Epi::AFTER_DRAIN) { E.fused(acc, cur, wr, wc, fr, fq, lds, wid, lane); S.done(cur); }
#undef PG8_SA
#undef PG8_SB
#undef PG8_STAGE
#undef PG8_LDA
#undef PG8_LDB
#undef PG8_MMA
#undef PG8_WAIT_V
#undef PG8_WAIT_L
#undef PG8_BAR
#undef PG8_SCHED
}
}
typedef unsigned v4u __attribute__((ext_vector_type(4)));
typedef float f32x4 __attribute__((ext_vector_type(4)));
typedef short bf16x8 __attribute__((ext_vector_type(8)));
typedef GAS unsigned gu32;
typedef GAS unsigned long long gu64;
#define RLX_AGENT __ATOMIC_RELAXED, __HIP_MEMORY_SCOPE_AGENT
#define LDS_WAIT() asm volatile("s_waitcnt lgkmcnt(0)" ::: "memory")
#define VM_WAIT() asm volatile("s_waitcnt vmcnt(0)" ::: "memory")
__device__ __forceinline__ unsigned long long rt() { return __builtin_amdgcn_s_memrealtime(); }
__device__ __forceinline__ unsigned f2bf(float f) { unsigned u = __builtin_bit_cast(unsigned, f); return (u + 0x7fffu + ((u >> 16) & 1u)) >> 16; }
__device__ __forceinline__ unsigned pk2(float lo, float hi) { return f2bf(lo) | (f2bf(hi) << 16); }

#define XB_TMO      128
#define XB_XCNT(j)  (256  + 64 * (j))
#define XB_XSUB(j)  (1280 + 64 * (j))
#define XB_XGEN(j)  (2304 + 64 * (j))
#define XB_TOP      3328
#define XB_TOPGEN   3392
#define XCD_BAR_WORDS 3456
#define XB_SPIN_CAP (1u << 18)

__device__ __forceinline__ unsigned xb_ld(unsigned* p)              { return __hip_atomic_load(p, __ATOMIC_RELAXED, __HIP_MEMORY_SCOPE_AGENT); }
__device__ __forceinline__ unsigned xb_add(unsigned* p, unsigned v) { return __hip_atomic_fetch_add(p, v, __ATOMIC_RELAXED, __HIP_MEMORY_SCOPE_AGENT); }
__device__ __forceinline__ unsigned xb_xcc_id() { return (unsigned)__builtin_amdgcn_s_getreg((3 << 11) | 20) & 0xFu; }
#define XB_SPIN(cond, bar) do { unsigned _sp = 0; while (cond) { __builtin_amdgcn_s_sleep(1); \
    if ((++_sp & 255u) == 0u) { if (xb_ld(&(bar)[XB_TMO])) break; if (_sp > XB_SPIN_CAP) { atomicAdd(&(bar)[XB_TMO], 1u); break; } } } } while (0)

struct XcdBarrier {
    unsigned* bar; unsigned x;
    volatile LAS unsigned* st;
};

__device__ __forceinline__ XcdBarrier xcd_barrier_post(unsigned* bar, volatile LAS unsigned* st) {
    XcdBarrier b; b.bar = bar; b.x = xb_xcc_id(); b.st = st;
    if (threadIdx.x == 0) (void)xb_add(&bar[XB_XCNT(b.x)], 1u);
    return b;
}
__device__ __forceinline__ void xcd_barrier_complete(unsigned* bar, unsigned x, unsigned& nloc, unsigned& nx) {
    const unsigned G = gridDim.x * gridDim.y * gridDim.z;
    unsigned sum, cnt, mine, sp = 0u;
    for (;;) {
        sum = 0u; cnt = 0u; mine = 0u;
#pragma unroll
        for (unsigned j = 0; j < 16; ++j) { const unsigned c = xb_ld(&bar[XB_XCNT(j)]); sum += c; cnt += (c > 0u) ? 1u : 0u; mine = (j == x) ? c : mine; }
        if (sum == G) break;
        __builtin_amdgcn_s_sleep(1);
        if ((++sp & 255u) == 0u) { if (xb_ld(&bar[XB_TMO])) break; if (sp > XB_SPIN_CAP) { atomicAdd(&bar[XB_TMO], 1u); break; } }
    }
    nloc = mine > 0u ? mine : 1u; nx = cnt > 0u ? cnt : 1u;
}

__device__ __forceinline__ void xcd_barrier(const XcdBarrier& b) {
    asm volatile("s_waitcnt vmcnt(0)" ::: "memory");
    __syncthreads();
    if (threadIdx.x == 0) {
        unsigned* bar = b.bar;
        __builtin_amdgcn_s_waitcnt(0);
        unsigned nloc = b.st[0], nx = b.st[1];
        if (nloc == 0u) { xcd_barrier_complete(bar, b.x, nloc, nx); b.st[0] = nloc; b.st[1] = nx; }
        const unsigned old = xb_add(&bar[XB_XSUB(b.x)], 1u);
        const unsigned gen = old / nloc;
        if (old + 1u == (gen + 1u) * nloc) {
            __builtin_amdgcn_fence(__ATOMIC_RELEASE, "agent");
            asm volatile("s_waitcnt vmcnt(0)" ::: "memory");
            const unsigned og = xb_add(&bar[XB_TOP], 1u);
            const unsigned tg = og / nx;
            if (og + 1u == (tg + 1u) * nx) xb_add(&bar[XB_TOPGEN], 1u);
            else XB_SPIN(xb_ld(&bar[XB_TOPGEN]) == tg, bar);
            __builtin_amdgcn_fence(__ATOMIC_ACQUIRE, "agent");
            xb_add(&bar[XB_XGEN(b.x)], 1u);
            asm volatile("s_waitcnt vmcnt(0)" ::: "memory");
        } else {
            XB_SPIN(xb_ld(&bar[XB_XGEN(b.x)]) == gen, bar);
            __builtin_amdgcn_fence(__ATOMIC_ACQUIRE, "agent");
            asm volatile("s_waitcnt vmcnt(0)" ::: "memory");
        }
    }
    __syncthreads();
}
__device__ __forceinline__ float wave_sum(float v) {
#pragma unroll
    for (int o = 1; o < 64; o <<= 1) v += __shfl_xor(v, o);
    return v;
}
__device__ __forceinline__ int crow(int r, int hi) { return (r & 3) + 8 * (r >> 2) + 4 * hi; }
__device__ __forceinline__ s16x4 vtr(const LAS unsigned char* p) { return __builtin_bit_cast(s16x4, __builtin_amdgcn_ds_read_tr16_b64_v4i16((LAS v4i16_t*)p)); }
__device__ __forceinline__ unsigned cvtpk(float lo, float hi) { return pg8::cvt_pk_bf16(lo, hi); }
__device__ __forceinline__ float bflo(unsigned w) { return __uint_as_float(w << 16); }
__device__ __forceinline__ float bfhi(unsigned w) { return __uint_as_float(w & 0xffff0000u); }
__device__ __forceinline__ float bf1(bf16 h) { return __uint_as_float((unsigned)h << 16); }

struct TrItem { const float* src; const float* gain; bf16* dst; int ldsrc, nvalid, K; };
__device__ __forceinline__ void tr_load(const TrItem& t, float (&tv)[32], int lane) {
    const bool ok = (lane & 31) < t.nvalid;
#pragma unroll
    for (int i = 0; i < 32; ++i) { const int kk = 2 * i + (lane >> 5); tv[i] = ok ? t.src[(size_t)kk * t.ldsrc + (lane & 31)] : 0.f; }
    if (t.gain) {
#pragma unroll
        for (int i = 0; i < 32; ++i) tv[i] *= t.gain[2 * i + (lane >> 5)]; }
}
__device__ __forceinline__ void tr_store(const TrItem& t, const float (&tv)[32], LAS float* scr, int lane) {
#pragma unroll
    for (int i = 0; i < 32; ++i) scr[(2 * i + (lane >> 5)) * 33 + (lane & 31)] = tv[i];
    LDS_WAIT(); asm volatile("" ::: "memory");
    const int c = lane & 7;
#pragma unroll
    for (int j = 0; j < 4; ++j) { const int n = (lane >> 3) + 8 * j; const LAS float* s = scr + (8 * c) * 33 + n;
        v4u o; o.x = cvtpk(s[0 * 33], s[1 * 33]); o.y = cvtpk(s[2 * 33], s[3 * 33]); o.z = cvtpk(s[4 * 33], s[5 * 33]); o.w = cvtpk(s[6 * 33], s[7 * 33]);
        *(GAS v4u*)(t.dst + (size_t)n * t.K + 8 * c) = o; }
    LDS_WAIT(); asm volatile("" ::: "memory");
}
__device__ __forceinline__ TrItem tr_make(const float* W, int ldsrc, int col0, int nvalid, const float* gain, int K, bf16* dest, int n0, int kb) {
    TrItem t; t.src = W + (size_t)(64 * kb) * ldsrc + col0; t.gain = gain ? gain + 64 * kb : nullptr; t.dst = dest + (size_t)n0 * K + 64 * kb; t.ldsrc = ldsrc; t.nvalid = nvalid; t.K = K; return t;
}
__device__ __forceinline__ int win_src_col(int n0, int& nvalid) {
    const int t = n0 >> 8, j0 = n0 & 255; nvalid = 32;
    if (t < 2) return 256 * t + j0;
    if (t < 6) { const int base = t < 4 ? 512 : 1024, wc = (j0 & 127) >> 5, bj = j0 >> 7; return base + (4 * (t & 1) + wc) * 64 + 32 * bj; }
    if (t < 8) return 1536 + 256 * (t - 6) + j0;
    if (t < 10) return 2048 + 256 * (t - 8) + j0;
    if (t < 12) return 2560 + 256 * (t - 10) + j0;
    if (t == 12) return 3072 + j0;
    if (t == 13) return 3328 + j0;
    if (t < 16) return 3584 + 256 * (t - 14) + j0;
    if (t < 18) return 4112 + 256 * (t - 16) + j0;
    if (t < 34) return 4624 + 256 * (t - 18) + j0;
    nvalid = (j0 == 0) ? 16 : 0; return 4096;
}
__device__ __forceinline__ void prologue(LAS unsigned char* lds, int gw, int NGW, int wave, int lane) {
    asm volatile("" : "+v"(lane));
    LAS float* scr = (LAS float*)(lds + wave * 16384);
    constexpr int I13 = 16 * 176, I2 = 44 * 32, IIN = 16 * 280, IBR = 3 * 8 * 32, IOUT = 16 * 32, IPG = 16 * 32, IPP = 4 * 32, IL = 2 * I13 + 2 * I2 + IIN + IBR + IOUT + IPG + IPP;
    auto decode = [&](int it) -> TrItem {
        KParams P = params_ptr(); const int L = it / IL; int r = it - L * IL; unsigned char* wl = P->ws + WS_W + (size_t)L * LW;
        if (r < 2 * I13) { const int which = r / I13; r -= which * I13; const int kb = r / 176, nb = r % 176, n0 = 32 * nb, tile = n0 >> 8, j0 = n0 & 255;
            const float* w1 = P->in[which ? I_F2W1 : I_F1W1] + (size_t)L * DM * DFF; const float* w3 = P->in[which ? I_F2W3 : I_F1W3] + (size_t)L * DM * DFF; const float* gn = P->in[which ? I_N2 : I_N1] + L * DM;
            return tr_make(j0 < 128 ? w1 : w3, DFF, 128 * tile + (j0 & 127), 32, gn, DM, (bf16*)(wl + (which ? OW13B : OW13A)), n0, kb); }
        r -= 2 * I13;
        if (r < 2 * I2) { const int which = r / I2; r -= which * I2; const int kb = r / 32, nb = r % 32;
            return tr_make(P->in[which ? I_F2W2 : I_F1W2] + (size_t)L * DFF * DM, DM, 32 * nb, 32, nullptr, DFF, (bf16*)(wl + (which ? OW2B : OW2A)), 32 * nb, kb); }
        r -= 2 * I2;
        if (r < IIN) { const int kb = r / 280, nb = r % 280; int nv; const int sc = win_src_col(32 * nb, nv);
            return tr_make(P->in[I_WIN] + (size_t)L * DM * 8720, 8720, sc, nv, P->in[I_NM] + L * DM, DM, (bf16*)(wl + OWIN), 32 * nb, kb); }
        r -= IIN;
        if (r < IBR) { const int b = 1 + r / 256; r &= 255; const int kb = r / 32, nb = r % 32;
            return tr_make(P->in[I_WBR] + ((size_t)L * 4 + b) * 512 * 1024, 1024, 32 * nb, 32, nullptr, 512, (bf16*)(wl + OWBR) + (size_t)b * 1024 * 512, 32 * nb, kb); }
        r -= IBR;
        if (r < IOUT) { const int kb = r / 32, nb = r % 32; return tr_make(P->in[I_WOUT] + (size_t)L * DM * DM, DM, 32 * nb, 32, nullptr, DM, (bf16*)(wl + OWOUT), 32 * nb, kb); }
        r -= IOUT;
        if (r < IPG) { const int kb = r / 32, nb = r % 32; return tr_make(P->in[I_WPG] + (size_t)L * DM * DM, DM, 32 * nb, 32, P->in[I_NPL] + L * DM, DM, (bf16*)(wl + OWPG), 32 * nb, kb); }
        r -= IPG;
        { const int kb = r / 32, nb = r % 32; return tr_make(P->in[I_WPP] + (size_t)L * 256 * DM, DM, 32 * nb, 32, nullptr, 256, (bf16*)(wl + OWPP), 32 * nb, kb); }
    };
    for (int it = gw; it < NL * IL; it += 4 * NGW) {
        const bool h1 = it + NGW < NL * IL, h2 = it + 2 * NGW < NL * IL, h3 = it + 3 * NGW < NL * IL;
        const TrItem ta = decode(it), tb = decode(h1 ? it + NGW : it), tc = decode(h2 ? it + 2 * NGW : it), td = decode(h3 ? it + 3 * NGW : it);
        float va[32], vb[32], vc[32], vd[32];
        tr_load(ta, va, lane); if (h1) tr_load(tb, vb, lane); if (h2) tr_load(tc, vc, lane); if (h3) tr_load(td, vd, lane);
        tr_store(ta, va, scr, lane); if (h1) tr_store(tb, vb, scr, lane); if (h2) tr_store(tc, vc, scr, lane); if (h3) tr_store(td, vd, scr, lane);
    }
    for (int it = gw; it < NL * 64 * 16; it += NGW) {
        KParams P = params_ptr(); unsigned char* ws = P->ws; const int L = it / (64 * 16); const int r = it - L * 64 * 16; const int k0 = (r >> 4) * 8, n = (r & 15) * 64 + lane, g = k0 >> 7;
        const float* pw = P->in[I_POOLW] + ((size_t)L * 512 + k0) * 128; const float* sc = P->in[I_POOLS] + L * 512 + g * 128; const float* wb = P->in[I_WBR] + ((size_t)L * 4) * 512 * 1024 + (size_t)(g * 128) * 1024 + n;
#pragma unroll
        for (int i = 0; i < 16; ++i) { const int e = i * 64 + lane; scr[e] = pw[e] * sc[e & 127]; }
        LDS_WAIT(); asm volatile("" ::: "memory");
        float a[8];
#pragma unroll
        for (int j = 0; j < 8; ++j) a[j] = 0.f;
        for (int d0 = 0; d0 < 128; d0 += 32) {
            float wv[32];
#pragma unroll
            for (int d = 0; d < 32; ++d) wv[d] = wb[(size_t)(d0 + d) * 1024];
#pragma unroll
            for (int d = 0; d < 32; ++d)
#pragma unroll
                for (int j = 0; j < 8; ++j) a[j] += scr[j * 128 + d0 + d] * wv[d];
        }
        v4u o; o.x = cvtpk(a[0], a[1]); o.y = cvtpk(a[2], a[3]); o.z = cvtpk(a[4], a[5]); o.w = cvtpk(a[6], a[7]);
        *(GAS v4u*)((bf16*)(ws + WS_W + (size_t)L * LW + OWBR) + (size_t)n * 512 + k0) = o;
        LDS_WAIT(); asm volatile("" ::: "memory");
    }
    for (int it = gw * 64 + lane; it < NL * 4 * 128 * 128; it += NGW * 64) {
        KParams P = params_ptr(); unsigned char* ws = P->ws; const int L = it >> 16, r = it & 65535, i = (r >> 7) & 127, j = r & 127;
        const float v = ((j >> 6) <= (i >> 6)) ? P->in[I_GWS][it] : 0.f;
        ((bf16*)(ws + WS_W + (size_t)L * LW + OWM))[r] = (bf16)(cvtpk(v, 0.f) & 0xffffu);
    }
    for (int m0 = gw * 4; m0 < M; m0 += NGW * 4) {
        KParams P = params_ptr(); unsigned char* ws = P->ws;
        f32x4 v[4][4];
#pragma unroll
        for (int r = 0; r < 4; ++r) { const int m = m0 + r; const float* src = m < MP ? P->in[I_XP] + (size_t)m * DM : P->in[I_XS] + (size_t)(m - MP) * DM;
#pragma unroll
            for (int j = 0; j < 4; ++j) v[r][j] = ((const GAS f32x4*)src)[lane + 64 * j]; }
#pragma unroll
        for (int r = 0; r < 4; ++r) { const int m = m0 + r; float s = 0.f;
#pragma unroll
            for (int j = 0; j < 4; ++j) s += (v[r][j].x * v[r][j].x + v[r][j].y * v[r][j].y) + (v[r][j].z * v[r][j].z + v[r][j].w * v[r][j].w);
            s = wave_sum(s);
            GAS u32x2* bo = (GAS u32x2*)((bf16*)(ws + WS_XB0) + (size_t)m * DM) + lane; GAS u32x2* lo = (GAS u32x2*)((bf16*)(ws + WS_XL) + (size_t)m * DM) + lane;
#pragma unroll
            for (int j = 0; j < 4; ++j) { u32x2 w; w.x = cvtpk(v[r][j].x, v[r][j].y); w.y = cvtpk(v[r][j].z, v[r][j].w); bo[64 * j] = w;
                if (USE_XL) { u32x2 l; l.x = cvtpk(v[r][j].x - bflo(w.x), v[r][j].y - bfhi(w.x)); l.y = cvtpk(v[r][j].z - bflo(w.y), v[r][j].w - bfhi(w.y)); lo[64 * j] = l; } }
            if (lane < 16) ((float*)(ws + WS_SSQ0))[(size_t)m * 16 + lane] = lane == 0 ? s : 0.f; }
    }
    for (int it0 = gw * 8; it0 < NL * M; it0 += NGW * 8) {
        KParams P = params_ptr(); unsigned char* ws = P->ws; f32x4 v[8];
#pragma unroll
        for (int j = 0; j < 8; ++j) { const int it = it0 + j, L = it / M, m = it - L * M;
            const float* src = m < MP ? P->in[I_PP] + ((size_t)L * MP + m) * 256 : P->in[I_PS] + ((size_t)L * MS + (m - MP)) * 256; v[j] = ((const GAS f32x4*)src)[lane]; }
#pragma unroll
        for (int j = 0; j < 8; ++j) { u32x2 w; w.x = cvtpk(v[j].x, v[j].y); w.y = cvtpk(v[j].z, v[j].w); ((GAS u32x2*)((bf16*)(ws + WS_PB) + (size_t)(it0 + j) * 256))[lane] = w; }
    }
}

template <int W> __device__ __forceinline__ void pool_rows(KParams P, int L, int rblk, int g, int lane) {
    const bf16* xpb = (const bf16*)(P->ws + WS_XPB); bf16* D = (bf16*)(P->ws + WS_AB);
    const int row0 = rblk * 32; const bool prompt = row0 < MP;
    int rowbase, t0; const float* hist = nullptr; float* pout; int pfirst;
    if (prompt) { const int b = row0 >> 12; rowbase = b << 12; t0 = row0 & 4095; pout = P->out + O_POOLP + ((size_t)L * 8 + b) * 15 * 512; pfirst = 4081; }
    else { const int b = (row0 - MP) >> 5; rowbase = MP + (b << 5); t0 = 0; hist = P->in[I_SPOOL] + ((size_t)L * 16 + b) * 15 * 512; pout = P->out + O_POOLS + ((size_t)L * 16 + b) * 15 * 512; pfirst = 17; }
    const int tb = t0 + 8 * (lane >> 4), c0 = g * 128 + (lane & 15) * 8;
    v4u x[W + 7];
#pragma unroll
    for (int i = 0; i < W + 7; ++i) { const int t = tb - (W - 1) + i; x[i] = *(const GAS v4u*)(xpb + (size_t)(rowbase + (t > 0 ? t : 0)) * 512 + c0); }
    if (prompt) {
#pragma unroll
        for (int i = 0; i < W - 1; ++i) { const int t = tb - (W - 1) + i; if (t < 0) x[i] = (v4u){0u, 0u, 0u, 0u}; }
    } else {
        v4u hx[W - 1];
#pragma unroll
        for (int i = 0; i < W - 1; ++i) { const int t = tb - (W - 1) + i; int hr = 15 + t; hr = hr < 0 ? 0 : (hr > 14 ? 14 : hr); const float* h = hist + (size_t)hr * 512 + c0;
            hx[i] = pg8::pack8(*(const f32x4*)h, *(const f32x4*)(h + 4)); }
#pragma unroll
        for (int i = 0; i < W - 1; ++i) { const int t = tb - (W - 1) + i; if (t < 0) x[i] = hx[i]; }
    }
    f32x4 s0 = (f32x4){0.f, 0.f, 0.f, 0.f}, s1 = s0;
#pragma unroll
    for (int i = 0; i < W - 1; ++i) { s0 = s0 + (f32x4){bflo(x[i].x), bfhi(x[i].x), bflo(x[i].y), bfhi(x[i].y)}; s1 = s1 + (f32x4){bflo(x[i].z), bfhi(x[i].z), bflo(x[i].w), bfhi(x[i].w)}; }
#pragma unroll
    for (int j = 0; j < 8; ++j) { const int t = tb + j; const v4u xn = x[j + W - 1], xo = x[j];
        const f32x4 a = (f32x4){bflo(xn.x), bfhi(xn.x), bflo(xn.y), bfhi(xn.y)}, b = (f32x4){bflo(xn.z), bfhi(xn.z), bflo(xn.w), bfhi(xn.w)};
        s0 = s0 + a; s1 = s1 + b;
        const int cnt = prompt ? (t + 1 < W ? t + 1 : W) : W; const float inv = 1.0f / (float)cnt;
        *(GAS v4u*)(D + (size_t)(rowbase + t) * 512 + c0) = pg8::pack8(s0 * inv - a, s1 * inv - b);
        if (t >= pfirst) { float* po = pout + (size_t)(t - pfirst) * 512 + c0; *(f32x4*)po = a; *(f32x4*)(po + 4) = b; }
        s0 = s0 - (f32x4){bflo(xo.x), bfhi(xo.x), bflo(xo.y), bfhi(xo.y)}; s1 = s1 - (f32x4){bflo(xo.z), bfhi(xo.z), bflo(xo.w), bfhi(xo.w)}; }
}
__device__ __forceinline__ void pool_unit(int L, int unit, int lane) {
    KParams P = params_ptr(); asm volatile("" : "+v"(lane));
    const int g = unit & 3, rblk = unit >> 2;
    if (g == 0) pool_rows<2>(P, L, rblk, 0, lane); else if (g == 1) pool_rows<4>(P, L, rblk, 1, lane); else if (g == 2) pool_rows<8>(P, L, rblk, 2, lane); else pool_rows<16>(P, L, rblk, 3, lane);
}

template <bool SAMPLE> __device__ __forceinline__ void sb_unit(LAS unsigned char* wl, int lane, int L, int unit) {
    KParams P = params_ptr(); asm volatile("" : "+v"(lane));
    const bf16* Qb = (const bf16*)(P->ws + WS_QB); const bf16* Kb = (const bf16*)(P->ws + WS_KB); const bf16* Vb = (const bf16*)(P->ws + WS_VB); bf16* Y = (bf16*)(P->ws + WS_AB) + (size_t)M * 512;
    int newrow0, nnew, npast, qidx0, h; const float* ck = nullptr; const float* cv = nullptr;
    if (!SAMPLE) { const int b = unit >> 10, r = unit & 1023; h = r >> 7; qidx0 = (r & 127) * 32; newrow0 = b << 12; nnew = 4096; npast = 0; }
    else { const int r = unit - 8192, b = r >> 3; h = r & 7; qidx0 = 0; newrow0 = MP + (b << 5); nnew = 32; npast = 4096;
        ck = P->in[I_CK] + ((size_t)L * 16 + b) * 4096 * 512; cv = P->in[I_CV] + ((size_t)L * 16 + b) * 4096 * 512; }
    const int r32 = lane & 31, hi = lane >> 5; const int qrow0 = newrow0 + qidx0;
    pg8::bf16x8 qf[4];
    { const bf16* qp = Qb + (size_t)(qrow0 + r32) * 512 + h * 64 + hi * 8;
#pragma unroll
      for (int d0 = 0; d0 < 4; ++d0) qf[d0] = *(const GAS pg8::bf16x8*)(qp + d0 * 16); }
    f32x16 o0, o1;
#pragma unroll
    for (int r = 0; r < 16; ++r) { o0[r] = 0.f; o1[r] = 0.f; }
    float R2 = 0.f;
    const int qpos0 = npast + qidx0, jd = qpos0 >> 6;
    v4u kv[8], vv[8];
    auto issue_new = [&](int jj) {
#pragma unroll
        for (int i = 0; i < 8; ++i) { const int r = (lane >> 3) + 8 * i; int idx = 64 * jj - npast + r; idx = idx < nnew ? idx : nnew - 1;
            const size_t off = (size_t)(newrow0 + idx) * 512 + h * 64 + (lane & 7) * 8; kv[i] = *(const GAS v4u*)(Kb + off); vv[i] = *(const GAS v4u*)(Vb + off); }
    };
    if (!SAMPLE) issue_new(jd);
    for (int j = jd; j >= 0; --j) {
        if (__all(R2 >= SB_CUT)) break;
        const int p0 = 64 * j; const bool isnew = !SAMPLE || p0 >= npast;
        if (isnew) {
            if (SAMPLE) issue_new(j);
#pragma unroll
            for (int i = 0; i < 8; ++i) { const int r = (lane >> 3) + 8 * i;
                *(LAS v4u*)(wl + r * 128 + (((lane & 7) ^ (r & 7)) * 16)) = kv[i]; *(LAS v4u*)(wl + 8192 + r * 128 + (lane & 7) * 16) = vv[i]; }
            if (!SAMPLE && j > 0) issue_new(j - 1);
        } else {
#pragma unroll
            for (int hf = 0; hf < 2; ++hf) {
                f32x4 kk[8], vf[8];
#pragma unroll
                for (int i = 0; i < 8; ++i) { const int r = (lane >> 4) + 4 * (8 * hf + i); const size_t off = ((size_t)(p0 + r) * 8 + h) * 64 + (lane & 15) * 4; kk[i] = *(const GAS f32x4*)(ck + off); vf[i] = *(const GAS f32x4*)(cv + off); }
#pragma unroll
                for (int i = 0; i < 8; ++i) { const int r = (lane >> 4) + 4 * (8 * hf + i); u32x2 a, b; a.x = cvtpk(kk[i].x, kk[i].y); a.y = cvtpk(kk[i].z, kk[i].w); b.x = cvtpk(vf[i].x, vf[i].y); b.y = cvtpk(vf[i].z, vf[i].w);
                    *(LAS u32x2*)(wl + r * 128 + ((((lane & 15) >> 1) ^ (r & 7)) * 16) + (lane & 1) * 8) = a; *(LAS u32x2*)(wl + 8192 + r * 128 + (lane & 15) * 8) = b; }
            }
        }
        asm volatile("" ::: "memory");
        f32x16 p[2];
#pragma unroll
        for (int kh = 0; kh < 2; ++kh) {
#pragma unroll
            for (int r = 0; r < 16; ++r) p[kh][r] = 0.f;
#pragma unroll
            for (int d0 = 0; d0 < 4; ++d0) { const int row = 32 * kh + r32; const pg8::bf16x8 kf = *(const LAS pg8::bf16x8*)(wl + row * 128 + (((2 * d0 + hi) ^ (row & 7)) * 16));
                p[kh] = __builtin_amdgcn_mfma_f32_32x32x16_bf16(kf, qf[d0], p[kh], 0, 0, 0); }
        }
        const float f = __builtin_amdgcn_exp2f(-R2);
        const bool diag = (j == jd);
#pragma unroll
        for (int kh = 0; kh < 2; ++kh)
#pragma unroll
            for (int r = 0; r < 16; ++r) { float s = p[kh][r]; s = s < 60.f ? s : 60.f; float u = __builtin_amdgcn_exp2f(s);
                if (diag) { const bool valid = (p0 + 32 * kh + crow(r, hi)) < (qpos0 + r32); u = valid ? u : 0.f; }
                p[kh][r] = u; }
        float gp[16];
#pragma unroll
        for (int kh = 0; kh < 2; ++kh)
#pragma unroll
            for (int a = 0; a < 4; ++a) { const float g = ((1.0f + p[kh][4 * a]) * (1.0f + p[kh][4 * a + 1])) * ((1.0f + p[kh][4 * a + 2]) * (1.0f + p[kh][4 * a + 3])); const float og = __shfl_xor(g, 32);
                gp[8 * kh + 2 * a] = hi ? og : g; gp[8 * kh + 2 * a + 1] = hi ? g : og; }
        float E[16]; E[15] = 1.0f;
#pragma unroll
        for (int G = 14; G >= 0; --G) E[G] = E[G + 1] * gp[G + 1];
        const float T = E[0] * gp[0];
#pragma unroll
        for (int kh = 0; kh < 2; ++kh)
#pragma unroll
            for (int a = 0; a < 4; ++a) { const float e = hi ? E[8 * kh + 2 * a + 1] : E[8 * kh + 2 * a];
                const float D3 = e * (1.0f + p[kh][4 * a + 3]), D2 = D3 * (1.0f + p[kh][4 * a + 2]), D1 = D2 * (1.0f + p[kh][4 * a + 1]), D0 = D1 * (1.0f + p[kh][4 * a]);
                p[kh][4 * a + 3] = p[kh][4 * a + 3] * __builtin_amdgcn_rcpf(D3) * f; p[kh][4 * a + 2] = p[kh][4 * a + 2] * __builtin_amdgcn_rcpf(D2) * f;
                p[kh][4 * a + 1] = p[kh][4 * a + 1] * __builtin_amdgcn_rcpf(D1) * f; p[kh][4 * a] = p[kh][4 * a] * __builtin_amdgcn_rcpf(D0) * f; }
        R2 += __builtin_amdgcn_logf(T);
#pragma unroll
        for (int s = 0; s < 4; ++s) {
            const int kh = s >> 1, rb = 8 * (s & 1);
            v4u pw; pw.x = cvtpk(p[kh][rb], p[kh][rb + 1]); pw.y = cvtpk(p[kh][rb + 2], p[kh][rb + 3]); pw.z = cvtpk(p[kh][rb + 4], p[kh][rb + 5]); pw.w = cvtpk(p[kh][rb + 6], p[kh][rb + 7]);
            const pg8::bf16x8 pf = __builtin_bit_cast(pg8::bf16x8, pw);
            const LAS unsigned char* vbase = wl + 8192 + (16 * s + 4 * hi + ((lane & 15) >> 2)) * 128 + ((lane >> 4) & 1) * 32 + (lane & 3) * 8;
#pragma unroll
            for (int dh = 0; dh < 2; ++dh) { const s16x4 lo = vtr(vbase + dh * 64), h4 = vtr(vbase + dh * 64 + 8 * 128);
                const pg8::bf16x8 vf = (pg8::bf16x8){lo[0], lo[1], lo[2], lo[3], h4[0], h4[1], h4[2], h4[3]};
                if (dh == 0) o0 = __builtin_amdgcn_mfma_f32_32x32x16_bf16(pf, vf, o0, 0, 0, 0); else o1 = __builtin_amdgcn_mfma_f32_32x32x16_bf16(pf, vf, o1, 0, 0, 0); }
        }
        asm volatile("" ::: "memory");
    }
    bf16* yp = Y + (size_t)qrow0 * 512 + h * 64 + r32;
#pragma unroll
    for (int r = 0; r < 16; ++r) { bf16* q = yp + (size_t)crow(r, hi) * 512; q[0] = (bf16)(cvtpk(o0[r], 0.f) & 0xffffu); q[32] = (bf16)(cvtpk(o1[r], 0.f) & 0xffffu); }
}

__device__ __forceinline__ void gmlp_unit(LAS unsigned char* wl, int lane, int L, int unit) {
    KParams P = params_ptr(); asm volatile("" : "+v"(lane));
    const bf16* gub = (const bf16*)(P->ws + WS_GUB); const bf16* gvb = (const bf16*)(P->ws + WS_GVB); bf16* Y = (bf16*)(P->ws + WS_AB) + (size_t)2 * M * 512;
    int row0, ntok, g, cb;
    if (unit < 4096) { const int ch = unit >> 4; g = (unit >> 2) & 3; cb = unit & 3; row0 = ch * 128; ntok = 128; }
    else { const int r = unit - 4096, b = r >> 4; g = (r >> 2) & 3; cb = r & 3; row0 = MP + b * 32; ntok = 32; }
    const bf16* wm = (const bf16*)(P->ws + WS_W + (size_t)L * LW + OWM) + (size_t)g * 128 * 128; const float* bs = P->in[I_GB] + ((size_t)L * 4 + g) * 128;
    const int r32 = lane & 31, hi = lane >> 5; const int colb = g * 128 + cb * 32;
    for (int i = 0; i < ntok / 16; ++i) { const int r = (lane >> 2) + 16 * i; *(LAS v4u*)(wl + r * 80 + (lane & 3) * 16) = *(const GAS v4u*)(gvb + (size_t)(row0 + r) * 512 + colb + (lane & 3) * 8); }
    asm volatile("" ::: "memory");
    const int nib = ntok / 32;
    for (int ib = 0; ib < nib; ++ib) {
        f32x16 acc;
#pragma unroll
        for (int r = 0; r < 16; ++r) acc[r] = 0.f;
        const int ns = ntok == 32 ? 2 : (ib < 2 ? 4 : 8);
        pg8::bf16x8 af[8]; bf16 guv[16]; float bsv[16];
#pragma unroll
        for (int s = 0; s < 8; ++s) if (s < ns) af[s] = *(const GAS pg8::bf16x8*)(wm + (size_t)(32 * ib + r32) * 128 + 16 * s + 8 * hi);
#pragma unroll
        for (int r = 0; r < 16; ++r) { const int i = 32 * ib + crow(r, hi); guv[r] = gub[(size_t)(row0 + i) * 512 + colb + r32]; bsv[r] = bs[i]; }
#pragma unroll
        for (int s = 0; s < 8; ++s) if (s < ns) {
            const LAS unsigned char* bb = wl + (16 * s + 8 * hi + ((lane & 15) >> 2)) * 80 + ((lane >> 4) & 1) * 32 + (lane & 3) * 8;
            const s16x4 lo = vtr(bb), h4 = vtr(bb + 4 * 80);
            const pg8::bf16x8 bfr = (pg8::bf16x8){lo[0], lo[1], lo[2], lo[3], h4[0], h4[1], h4[2], h4[3]};
            acc = __builtin_amdgcn_mfma_f32_32x32x16_bf16(af[s], bfr, acc, 0, 0, 0);
        }
#pragma unroll
        for (int r = 0; r < 16; ++r) { const int i = 32 * ib + crow(r, hi); const size_t off = (size_t)(row0 + i) * 512 + colb + r32;
            Y[off] = (bf16)(cvtpk(bf1(guv[r]) * (acc[r] + bsv[r]), 0.f) & 0xffffu); }
    }
    asm volatile("" ::: "memory");
}

__device__ __forceinline__ void gla_ids(int cid, int& row0, int& ntok, int& h) {
    if (cid < 2048) { const int sq = cid >> 6, c = cid & 63; h = sq & 3; row0 = (sq >> 2) * 4096 + c * 64; ntok = 64; }
    else { const int sq = cid - 2048; h = sq & 3; row0 = MP + (sq >> 2) * 32; ntok = 32; }
}
struct GlaInA { v4u la; v4u q, k, v0, v1; };
__device__ __forceinline__ GlaInA gla_a_issue(KParams P, int L, int cid, int tid) {
    int row0, ntok, h; gla_ids(cid, row0, ntok, h);
    const int t = tid >> 3, q8 = tid & 7; const bool live = t < ntok; GlaInA r;
    const bf16* lab = (const bf16*)(P->ws + WS_LAB); const bf16* lqb = (const bf16*)(P->ws + WS_LQB); const bf16* lkb = (const bf16*)(P->ws + WS_LKB); const bf16* lvb = (const bf16*)(P->ws + WS_LVB);
    const v4u z = (v4u){0u, 0u, 0u, 0u}; r.la = z; r.q = z; r.k = z; r.v0 = z; r.v1 = z;
    { const int ar = 32 * ((tid >> 6) & 1) + (tid & 31); if (ar < ntok) r.la = *(const GAS v4u*)(lab + (size_t)(row0 + ar) * 256 + 8 * ((tid >> 5) & 1)); }
    if (live) { r.q = *(const GAS v4u*)(lqb + (size_t)(row0 + t) * 256 + h * 64 + 8 * q8); r.k = *(const GAS v4u*)(lkb + (size_t)(row0 + t) * 256 + h * 64 + 8 * q8);
                r.v0 = *(const GAS v4u*)(lvb + (size_t)(row0 + t) * 512 + h * 128 + 16 * q8); r.v1 = *(const GAS v4u*)(lvb + (size_t)(row0 + t) * 512 + h * 128 + 16 * q8 + 8); }
    return r;
}
__device__ __forceinline__ void gla_pass_a_loop(LAS unsigned char* lds, int L, int vcu, int G, int tid) {
    asm volatile("" : "+v"(tid)); const int lane = tid & 63, wave = __builtin_amdgcn_readfirstlane(tid >> 6);
    LAS float* LA = (LAS float*)lds;
    LAS float* WA = LA + 64 * 17;
    LAS float* BA = WA + 16 * 64;
    LAS float* SEG = BA + 64;
    LAS float* LAMS = SEG + 8 * 64;
    LAS float* Gt = LAMS + 64;
    LAS unsigned char* KT = (LAS unsigned char*)(Gt + 64 * 65);
    LAS unsigned char* VT = KT + 64 * 144;
    int seg = vcu; if (seg >= NSEG) return; int ci = 0;
    int c = seg < 256 ? seg * 8 : 2048 + (seg - 256);
    const int t = tid >> 3, q8 = tid & 7, r32 = lane & 31, hi = lane >> 5;
    f32x16 Srun; float Lrun = 1.0f;
#pragma unroll
    for (int r = 0; r < 16; ++r) Srun[r] = 0.f;
    GlaInA in = gla_a_issue(params_ptr(), L, c, tid);
    int seg1 = seg, ci1 = 1; if (ci1 >= (seg < 256 ? 8 : 1)) { seg1 = seg + G; ci1 = 0; }
    bool has1 = seg1 < NSEG; int c1 = has1 ? (seg1 < 256 ? seg1 * 8 + ci1 : 2048 + (seg1 - 256)) : c;
    GlaInA in2 = in; if (has1) in2 = gla_a_issue(params_ptr(), L, c1, tid);
    v4u bhi = (v4u){0u, 0u, 0u, 0u}, blo = bhi; float bcol = 0.f;
    auto step = [&](GlaInA& in) -> bool {
        KParams P = params_ptr(); const int nch = seg < 256 ? 8 : 1;
        int row0, ntok, h; gla_ids(c, row0, ntok, h); const bool live = t < ntok;
        if (ci == 0) {
            const float* wa = P->in[I_WA2] + ((size_t)L * 16 + 8 * hi) * 256 + h * 64 + 32 * ((wave >> 1) & 1) + r32; float w[8];
#pragma unroll
            for (int i = 0; i < 8; ++i) w[i] = wa[(size_t)i * 256];
            bcol = P->in[I_BA][L * 256 + h * 64 + 32 * ((wave >> 1) & 1) + r32];
            bhi.x = cvtpk(w[0], w[1]); bhi.y = cvtpk(w[2], w[3]); bhi.z = cvtpk(w[4], w[5]); bhi.w = cvtpk(w[6], w[7]);
            blo.x = cvtpk(w[0] - bflo(bhi.x), w[1] - bfhi(bhi.x)); blo.y = cvtpk(w[2] - bflo(bhi.y), w[3] - bfhi(bhi.y)); blo.z = cvtpk(w[4] - bflo(bhi.z), w[5] - bfhi(bhi.z)); blo.w = cvtpk(w[6] - bflo(bhi.w), w[7] - bfhi(bhi.w)); }
        *(LAS v4u*)(VT + t * 272 + q8 * 32) = in.v0; *(LAS v4u*)(VT + t * 272 + q8 * 32 + 16) = in.v1;
        const v4u qraw = in.q, kraw = in.k; const pg8::bf16x8 afr = __builtin_bit_cast(pg8::bf16x8, in.la);
        int seg2 = seg1, ci2 = ci1 + 1; if (ci2 >= (seg1 < 256 ? 8 : 1)) { seg2 = seg1 + G; ci2 = 0; }
        const bool has2 = has1 && seg2 < NSEG; const int c2 = has2 ? (seg2 < 256 ? seg2 * 8 + ci2 : 2048 + (seg2 - 256)) : c1;
        if (has2) in = gla_a_issue(P, L, c2, tid);
        { f32x16 xg;
#pragma unroll
          for (int r = 0; r < 16; ++r) xg[r] = bcol;
          xg = __builtin_amdgcn_mfma_f32_32x32x16_bf16(afr, __builtin_bit_cast(pg8::bf16x8, bhi), xg, 0, 0, 0);
          xg = __builtin_amdgcn_mfma_f32_32x32x16_bf16(afr, __builtin_bit_cast(pg8::bf16x8, blo), xg, 0, 0, 0);
          const int tb_ = wave & 1, kb_ = (wave >> 1) & 1, half = wave >> 2;
#pragma unroll
          for (int r8 = 0; r8 < 8; ++r8) { const float x = half ? xg[8 + r8] : xg[r8]; const int tt = 32 * tb_ + crow(r8, hi) + 16 * half;
              const float ax = __builtin_fabsf(x); const float l2 = 1.4426950408889634f * (x < 0.f ? x : 0.f) - __builtin_amdgcn_logf(1.0f + __builtin_amdgcn_exp2f(-1.4426950408889634f * ax));
              Gt[tt * 65 + 32 * kb_ + r32] = tt < ntok ? l2 * (1.0f / 16.0f) : 0.f; } }
        __syncthreads();
        { float g[8], sg[7];
#pragma unroll
          for (int s = 0; s < 8; ++s) g[s] = Gt[(8 * wave + s) * 65 + lane];
#pragma unroll
          for (int s = 1; s < 8; ++s) g[s] += g[s - 1];
          SEG[wave * 64 + lane] = g[7];
          __syncthreads();
#pragma unroll
          for (int w = 0; w < 7; ++w) sg[w] = SEG[w * 64 + lane];
          float off = 0.f;
#pragma unroll
          for (int w = 0; w < 7; ++w) off += (w < wave) ? sg[w] : 0.f;
#pragma unroll
          for (int s = 0; s < 8; ++s) Gt[(8 * wave + s) * 65 + lane] = g[s] + off; }
        __syncthreads();
        { const float qin[8] = {bflo(qraw.x), bfhi(qraw.x), bflo(qraw.y), bfhi(qraw.y), bflo(qraw.z), bfhi(qraw.z), bflo(qraw.w), bfhi(qraw.w)};
          const float kin[8] = {bflo(kraw.x), bfhi(kraw.x), bflo(kraw.y), bfhi(kraw.y), bflo(kraw.z), bfhi(kraw.z), bflo(kraw.w), bfhi(kraw.w)};
          float qo[8], ko[8];
          float bb[8];
#pragma unroll
          for (int kk = 0; kk < 8; ++kk) bb[kk] = Gt[t * 65 + 8 * q8 + kk];
#pragma unroll
          for (int kk = 0; kk < 8; ++kk) { float b2 = bb[kk]; b2 = b2 > -120.f ? b2 : -120.f; qo[kk] = qin[kk] * __builtin_amdgcn_exp2f(b2) * 0.125f; ko[kk] = kin[kk] * __builtin_amdgcn_exp2f(-b2); }
          v4u qw, kw; qw.x = cvtpk(qo[0], qo[1]); qw.y = cvtpk(qo[2], qo[3]); qw.z = cvtpk(qo[4], qo[5]); qw.w = cvtpk(qo[6], qo[7]); kw.x = cvtpk(ko[0], ko[1]); kw.y = cvtpk(ko[2], ko[3]); kw.z = cvtpk(ko[4], ko[5]); kw.w = cvtpk(ko[6], ko[7]);
          *(LAS v4u*)(KT + t * 144 + q8 * 16) = kw;
          if (live) { *(GAS v4u*)((bf16*)(P->ws + WS_QT) + (size_t)(row0 + t) * 256 + h * 64 + 8 * q8) = qw; *(GAS v4u*)((bf16*)(P->ws + WS_KT) + (size_t)(row0 + t) * 256 + h * 64 + 8 * q8) = kw; } }
        if (tid < 64) { float b2 = Gt[63 * 65 + tid]; b2 = b2 > -120.f ? b2 : -120.f; const float lamv = __builtin_amdgcn_exp2f(b2); LAMS[tid] = lamv;
            if (ci == 0) Lrun = 1.0f;
            ((float*)(P->ws + WS_LAM))[(size_t)c * 64 + tid] = lamv;
            Lrun *= lamv;
            if (ci == nch - 1) ((float*)(P->ws + WS_SC) + (size_t)NSEG * 8192)[(size_t)seg * 64 + tid] = Lrun; }
        __syncthreads();
        { const int kb = wave & 1, vb = wave >> 1;
          f32x16 acc;
#pragma unroll
          for (int r = 0; r < 16; ++r) acc[r] = 0.f;
          const LAS unsigned char* ka = KT + (8 * hi + ((lane & 15) >> 2)) * 144 + (32 * kb + 16 * ((lane >> 4) & 1) + 4 * (lane & 3)) * 2;
          const LAS unsigned char* va = VT + (8 * hi + ((lane & 15) >> 2)) * 272 + (32 * vb + 16 * ((lane >> 4) & 1) + 4 * (lane & 3)) * 2;
#pragma unroll
          for (int s4 = 0; s4 < 4; ++s4) { const s16x4 a0 = vtr(ka + s4 * 16 * 144), a1 = vtr(ka + s4 * 16 * 144 + 4 * 144), b0 = vtr(va + s4 * 16 * 272), b1 = vtr(va + s4 * 16 * 272 + 4 * 272);
              const pg8::bf16x8 af = (pg8::bf16x8){a0[0], a0[1], a0[2], a0[3], a1[0], a1[1], a1[2], a1[3]}, bfr = (pg8::bf16x8){b0[0], b0[1], b0[2], b0[3], b1[0], b1[1], b1[2], b1[3]};
              acc = __builtin_amdgcn_mfma_f32_32x32x16_bf16(af, bfr, acc, 0, 0, 0); }
          if (ci == 0) {
#pragma unroll
              for (int r = 0; r < 16; ++r) Srun[r] = 0.f; }
#pragma unroll
          for (int r = 0; r < 16; ++r) Srun[r] = LAMS[32 * kb + crow(r, hi)] * (Srun[r] + acc[r]);
          if (ci == nch - 1) { float* sg = (float*)(P->ws + WS_SC) + (size_t)seg * 8192;
#pragma unroll
              for (int r = 0; r < 16; ++r) sg[(32 * kb + crow(r, hi)) * 128 + 32 * vb + r32] = Srun[r]; } }
        __syncthreads();
        if (!has1) return false;
        seg = seg1; ci = ci1; c = c1; seg1 = seg2; ci1 = ci2; c1 = c2; has1 = has2;
        return true;
    };
    for (;;) { if (!step(in)) break; if (!step(in2)) break; }
}
struct GlaInC { v4u q, k, v0, v1, l0, l1; float lc; };
__device__ __forceinline__ GlaInC gla_c_issue(KParams P, int cid, int tid) {
    int row0, ntok, h; gla_ids(cid, row0, ntok, h);
    const int t = tid >> 3, q8 = tid & 7; const bool live = t < ntok; GlaInC r;
    const v4u z = (v4u){0u, 0u, 0u, 0u}; r.q = z; r.k = z; r.v0 = z; r.v1 = z; r.l0 = z; r.l1 = z;
    if (live) { r.q = *(const GAS v4u*)((const bf16*)(P->ws + WS_QT) + (size_t)(row0 + t) * 256 + h * 64 + 8 * q8); r.k = *(const GAS v4u*)((const bf16*)(P->ws + WS_KT) + (size_t)(row0 + t) * 256 + h * 64 + 8 * q8);
                const bf16* lv = (const bf16*)(P->ws + WS_LVB) + (size_t)(row0 + t) * 512 + h * 128 + 16 * q8; r.v0 = *(const GAS v4u*)lv; r.v1 = *(const GAS v4u*)(lv + 8);
                const bf16* lr = (const bf16*)(P->ws + WS_LRB) + (size_t)(row0 + t) * 512 + h * 128 + 16 * q8; r.l0 = *(const GAS v4u*)lr; r.l1 = *(const GAS v4u*)(lr + 8); }
    r.lc = ((const float*)(P->ws + WS_LAM))[(size_t)cid * 64 + (tid & 63)];
    return r;
}
__device__ __forceinline__ void gla_pass_c_loop(LAS unsigned char* lds, int L, int vcu, int G, int tid) {
    asm volatile("" : "+v"(tid)); const int lane = tid & 63, wave = __builtin_amdgcn_readfirstlane(tid >> 6);
    LAS unsigned char* QT = lds;
    LAS unsigned char* KT = QT + 64 * 144;
    LAS unsigned char* VT = KT + 64 * 144;
    LAS unsigned char* ST = VT + 64 * 272;
    LAS float* O = (LAS float*)(ST + 64 * 272);
    LAS float* LAMS = O + 64 * 128;
    int seg = vcu; if (seg >= NSEG) return; int ci = 0;
    int c = seg < 256 ? seg * 8 : 2048 + (seg - 256);
    const int t = tid >> 3, q8 = tid & 7, r32 = lane & 31, hi = lane >> 5;
    const int so = (32 * (wave & 1) + 4 * hi) * 128 + 32 * (wave >> 1) + r32;
    f32x16 S0;
#pragma unroll
    for (int j = 0; j < 16; ++j) S0[j] = 0.f;
    float gon[16];
    { const float* gp = params_ptr()->in[I_GON] + L * 128 + 16 * q8;
#pragma unroll
      for (int j = 0; j < 4; ++j) { const f32x4 g4 = *(const f32x4*)(gp + 4 * j); gon[4 * j] = g4[0]; gon[4 * j + 1] = g4[1]; gon[4 * j + 2] = g4[2]; gon[4 * j + 3] = g4[3]; } }
    GlaInC in = gla_c_issue(params_ptr(), c, tid);
    int seg1 = seg, ci1 = 1; if (ci1 >= (seg < 256 ? 8 : 1)) { seg1 = seg + G; ci1 = 0; }
    bool has1 = seg1 < NSEG; int c1 = has1 ? (seg1 < 256 ? seg1 * 8 + ci1 : 2048 + (seg1 - 256)) : c;
    GlaInC in2 = in; if (has1) in2 = gla_c_issue(params_ptr(), c1, tid);
    auto step = [&](GlaInC& in) -> bool {
        KParams P = params_ptr(); const int nch = seg < 256 ? 8 : 1;
        const float* SSEG = (const float*)(P->ws + WS_SC); const float* LSEG = SSEG + (size_t)NSEG * 8192;
        if (ci == 0) {
            if (seg >= 256) { const float* sg = P->in[I_SGLA] + ((size_t)L * 64 + (seg - 256)) * 8192 + so;
#pragma unroll
                for (int r = 0; r < 16; ++r) S0[r] = sg[((r & 3) + 8 * (r >> 2)) * 128]; }
            else { const int jn = seg & 7, sb = seg - jn;
#pragma unroll
                for (int j = 0; j < 16; ++j) S0[j] = 0.f;
#pragma unroll 1
                for (int j0 = 0; j0 < jn; j0 += 2) {
                    float sv[2][16], lv[2][16];
#pragma unroll
                    for (int jj = 0; jj < 2; ++jj) if (j0 + jj < jn) { const float* sp = SSEG + (size_t)(sb + j0 + jj) * 8192 + so; const float* lp = LSEG + (size_t)(sb + j0 + jj) * 64 + 32 * (wave & 1) + 4 * hi;
#pragma unroll
                        for (int r = 0; r < 16; ++r) { sv[jj][r] = sp[((r & 3) + 8 * (r >> 2)) * 128]; lv[jj][r] = lp[(r & 3) + 8 * (r >> 2)]; } }
#pragma unroll
                    for (int jj = 0; jj < 2; ++jj) if (j0 + jj < jn) {
#pragma unroll
                        for (int r = 0; r < 16; ++r) S0[r] = lv[jj][r] * S0[r] + sv[jj][r]; }
                }
            }
        }
        int row0, ntok, h; gla_ids(c, row0, ntok, h); const bool live = t < ntok;
        *(LAS v4u*)(QT + t * 144 + q8 * 16) = in.q; *(LAS v4u*)(KT + t * 144 + q8 * 16) = in.k;
        *(LAS v4u*)(VT + t * 272 + q8 * 32) = in.v0; *(LAS v4u*)(VT + t * 272 + q8 * 32 + 16) = in.v1;
#pragma unroll
        for (int r = 0; r < 16; ++r) *(LAS unsigned short*)(ST + (32 * (wave & 1) + crow(r, hi)) * 272 + (32 * (wave >> 1) + r32) * 2) = (unsigned short)(cvtpk(S0[r], 0.f) & 0xffffu);
        if (tid < 64) LAMS[tid] = in.lc;
        const v4u l0 = in.l0, l1 = in.l1;
        int seg2 = seg1, ci2 = ci1 + 1; if (ci2 >= (seg1 < 256 ? 8 : 1)) { seg2 = seg1 + G; ci2 = 0; }
        const bool has2 = has1 && seg2 < NSEG; const int c2 = has2 ? (seg2 < 256 ? seg2 * 8 + ci2 : 2048 + (seg2 - 256)) : c1;
        if (has2) in = gla_c_issue(P, c2, tid);
        __syncthreads();
        { const int tb = wave & 1, vb = wave >> 1;
          pg8::bf16x8 qf[4];
#pragma unroll
          for (int k4 = 0; k4 < 4; ++k4) qf[k4] = *(const LAS pg8::bf16x8*)(QT + (32 * tb + r32) * 144 + (16 * k4 + 8 * hi) * 2);
          f32x16 o;
#pragma unroll
          for (int r = 0; r < 16; ++r) o[r] = 0.f;
          const LAS unsigned char* sa = ST + (8 * hi + ((lane & 15) >> 2)) * 272 + (32 * vb + 16 * ((lane >> 4) & 1) + 4 * (lane & 3)) * 2;
#pragma unroll
          for (int k4 = 0; k4 < 4; ++k4) { const s16x4 b0 = vtr(sa + k4 * 16 * 272), b1 = vtr(sa + k4 * 16 * 272 + 4 * 272);
              o = __builtin_amdgcn_mfma_f32_32x32x16_bf16(qf[k4], (pg8::bf16x8){b0[0], b0[1], b0[2], b0[3], b1[0], b1[1], b1[2], b1[3]}, o, 0, 0, 0); }
#pragma unroll
          for (int sb = 0; sb < 2; ++sb) if (sb <= tb) {
              f32x16 at;
#pragma unroll
              for (int r = 0; r < 16; ++r) at[r] = 0.f;
#pragma unroll
              for (int k4 = 0; k4 < 4; ++k4) at = __builtin_amdgcn_mfma_f32_32x32x16_bf16(*(const LAS pg8::bf16x8*)(KT + (32 * sb + r32) * 144 + (16 * k4 + 8 * hi) * 2), qf[k4], at, 0, 0, 0);
              if (sb == tb) {
#pragma unroll
                  for (int r = 0; r < 16; ++r) at[r] = (crow(r, hi) <= r32) ? at[r] : 0.f; }
              const LAS unsigned char* va = VT + (32 * sb + 4 * hi + ((lane & 15) >> 2)) * 272 + (32 * vb + 16 * ((lane >> 4) & 1) + 4 * (lane & 3)) * 2;
#pragma unroll
              for (int s2 = 0; s2 < 2; ++s2) { v4u pw; pw.x = cvtpk(at[8 * s2], at[8 * s2 + 1]); pw.y = cvtpk(at[8 * s2 + 2], at[8 * s2 + 3]); pw.z = cvtpk(at[8 * s2 + 4], at[8 * s2 + 5]); pw.w = cvtpk(at[8 * s2 + 6], at[8 * s2 + 7]);
                  const s16x4 b0 = vtr(va + s2 * 16 * 272), b1 = vtr(va + s2 * 16 * 272 + 8 * 272);
                  o = __builtin_amdgcn_mfma_f32_32x32x16_bf16(__builtin_bit_cast(pg8::bf16x8, pw), (pg8::bf16x8){b0[0], b0[1], b0[2], b0[3], b1[0], b1[1], b1[2], b1[3]}, o, 0, 0, 0); }
          }
#pragma unroll
          for (int r = 0; r < 16; ++r) O[(32 * tb + crow(r, hi)) * 128 + 32 * vb + r32] = o[r];
          { f32x16 acc;
#pragma unroll
            for (int r = 0; r < 16; ++r) acc[r] = 0.f;
            const LAS unsigned char* ka = KT + (8 * hi + ((lane & 15) >> 2)) * 144 + (32 * tb + 16 * ((lane >> 4) & 1) + 4 * (lane & 3)) * 2;
            const LAS unsigned char* vd = VT + (8 * hi + ((lane & 15) >> 2)) * 272 + (32 * vb + 16 * ((lane >> 4) & 1) + 4 * (lane & 3)) * 2;
#pragma unroll
            for (int s4 = 0; s4 < 4; ++s4) { const s16x4 a0 = vtr(ka + s4 * 16 * 144), a1 = vtr(ka + s4 * 16 * 144 + 4 * 144), b0 = vtr(vd + s4 * 16 * 272), b1 = vtr(vd + s4 * 16 * 272 + 4 * 272);
                const pg8::bf16x8 af = (pg8::bf16x8){a0[0], a0[1], a0[2], a0[3], a1[0], a1[1], a1[2], a1[3]}, bfr = (pg8::bf16x8){b0[0], b0[1], b0[2], b0[3], b1[0], b1[1], b1[2], b1[3]};
                acc = __builtin_amdgcn_mfma_f32_32x32x16_bf16(af, bfr, acc, 0, 0, 0); }
#pragma unroll
            for (int r = 0; r < 16; ++r) S0[r] = LAMS[32 * tb + crow(r, hi)] * (S0[r] + acc[r]); }
          if (ci == nch - 1 && (seg >= 256 || (seg & 7) == 7)) {
              float* op = (seg >= 256 ? P->out + O_GLAS + ((size_t)L * 64 + (seg - 256)) * 8192 : P->out + O_GLAP + ((size_t)L * 32 + (seg >> 3)) * 8192) + so;
#pragma unroll
              for (int r = 0; r < 16; ++r) op[((r & 3) + 8 * (r >> 2)) * 128] = S0[r]; } }
        __syncthreads();
        { float v[16]; float ss = 0.f;
#pragma unroll
          for (int j = 0; j < 16; ++j) { v[j] = O[t * 128 + 16 * q8 + j]; ss += v[j] * v[j]; }
          ss += __shfl_xor(ss, 1); ss += __shfl_xor(ss, 2); ss += __shfl_xor(ss, 4);
          const float rs = __builtin_amdgcn_rsqf(ss * (1.0f / 128.0f) + 1e-6f);
          if (live) {
              const float lr[16] = {bflo(l0.x), bfhi(l0.x), bflo(l0.y), bfhi(l0.y), bflo(l0.z), bfhi(l0.z), bflo(l0.w), bfhi(l0.w), bflo(l1.x), bfhi(l1.x), bflo(l1.y), bfhi(l1.y), bflo(l1.z), bfhi(l1.z), bflo(l1.w), bfhi(l1.w)};
              float y[16];
#pragma unroll
              for (int j = 0; j < 16; ++j) y[j] = v[j] * rs * gon[j] * lr[j];
              bf16* yo = (bf16*)(P->ws + WS_AB) + (size_t)3 * M * 512 + (size_t)(row0 + t) * 512 + h * 128 + 16 * q8;
              v4u w0, w1; w0.x = cvtpk(y[0], y[1]); w0.y = cvtpk(y[2], y[3]); w0.z = cvtpk(y[4], y[5]); w0.w = cvtpk(y[6], y[7]); w1.x = cvtpk(y[8], y[9]); w1.y = cvtpk(y[10], y[11]); w1.z = cvtpk(y[12], y[13]); w1.w = cvtpk(y[14], y[15]);
              *(GAS v4u*)yo = w0; *(GAS v4u*)(yo + 8) = w1; } }
        if (!has1) return false;
        seg = seg1; ci = ci1; c = c1; seg1 = seg2; ci1 = ci2; c1 = c2; has1 = has2;
        return true;
    };
    for (;;) { if (!step(in)) break; if (!step(in2)) break; }
}

template <int U> __device__ __forceinline__ void sg_batch(f32x16& c0, f32x16& c1, const GAS pg8::bf16x8* ap, const GAS pg8::bf16x8* b0, const GAS pg8::bf16x8* b1, int s) {
    pg8::bf16x8 a[U], w0[U], w1[U];
#pragma unroll
    for (int i = 0; i < U; ++i) { a[i] = ap[2 * (s + i)]; w0[i] = b0[2 * (s + i)]; w1[i] = b1[2 * (s + i)]; }
#pragma unroll
    for (int i = 0; i < U; ++i) { c0 = __builtin_amdgcn_mfma_f32_32x32x16_bf16(w0[i], a[i], c0, 0, 0, 0); c1 = __builtin_amdgcn_mfma_f32_32x32x16_bf16(w1[i], a[i], c1, 0, 0, 0); }
}
template <int B1OFF = 32> __device__ __forceinline__ void sg_accum(f32x16& c0, f32x16& c1, const bf16* A, int lda, const bf16* Bt, int ldb, int row0, int col0, int kbeg, int nsteps, int lane) {
    const int r32 = lane & 31, hi = lane >> 5;
    const GAS pg8::bf16x8* ap = (const GAS pg8::bf16x8*)(A + (size_t)(row0 + r32) * lda + kbeg + 8 * hi);
    const GAS pg8::bf16x8* b0 = (const GAS pg8::bf16x8*)(Bt + (size_t)(col0 + r32) * ldb + kbeg + 8 * hi);
    const GAS pg8::bf16x8* b1 = (const GAS pg8::bf16x8*)(Bt + (size_t)(col0 + B1OFF + r32) * ldb + kbeg + 8 * hi);
    asm volatile("" : "+s"(nsteps));
    int s = 0;
#pragma unroll 1
    for (; s + 8 <= nsteps; s += 8) sg_batch<8>(c0, c1, ap, b0, b1, s);
    if (nsteps & 4) { sg_batch<4>(c0, c1, ap, b0, b1, s); s += 4; }
    if (nsteps & 2) sg_batch<2>(c0, c1, ap, b0, b1, s);
}
__device__ __forceinline__ void sg_zero(f32x16& c) {
#pragma unroll
    for (int r = 0; r < 16; ++r) c[r] = 0.f;
}
__device__ __forceinline__ void sample_up_tiles(int L, int xc, int second, int gw, int NGW, int lane) {
    asm volatile("" : "+v"(lane)); const int r32 = lane & 31, hi = lane >> 5;
    for (int t = gw; t < 16 * 88; t += NGW) {
        KParams P = params_ptr(); unsigned char* ws = P->ws; const bf16* Bt = (const bf16*)(ws + WS_W + (size_t)L * LW + (second ? OW13B : OW13A));
        const int row0 = MP + 32 * (t / 88), hc = 32 * (t % 88), brow = (hc >> 7) * 256 + (hc & 127);
        f32x16 c0, c1; sg_zero(c0); sg_zero(c1);
        sg_accum<128>(c0, c1, (const bf16*)(ws + (xc ? WS_XB1 : WS_XB0)), DM, Bt, DM, row0, brow, 0, 64, lane);
        const int row = row0 + r32; const float rs = pg8::row_rstd((const float*)(ws + WS_SSQ0), row);
        bf16* hp = (bf16*)(ws + WS_HB) + (size_t)row * DFF + hc + 4 * hi;
#pragma unroll
        for (int a = 0; a < 4; ++a) { float h[4];
#pragma unroll
            for (int i = 0; i < 4; ++i) h[i] = pg8::silu_f(c0[4 * a + i] * rs) * (c1[4 * a + i] * rs);
            u32x2 w; w.x = cvtpk(h[0], h[1]); w.y = cvtpk(h[2], h[3]); *(GAS u32x2*)(hp + 8 * a) = w; }
    }
}
template <int MODE> __device__ __forceinline__ void sample_tiles(LAS unsigned char* lds, int L, int xc, int second, float alpha, int sq_out, int vcu, int G, int tid, int fin = 0) {
    asm volatile("" : "+v"(tid)); const int lane = tid & 63, wave = __builtin_amdgcn_readfirstlane(tid >> 6), r32 = lane & 31, hi = lane >> 5;
    LAS float* part = (LAS float*)lds;
    LAS float* part2 = part + 16384; asm volatile("" : "+v"(part2));
    for (int t = vcu; t < 256; t += G) {
        KParams P = params_ptr(); unsigned char* ws = P->ws; unsigned char* wl = ws + WS_W + (size_t)L * LW;
        const int row0 = MP + 32 * (t >> 4), tc = t & 15, col0 = 64 * tc;
        f32x16 c0, c1, d0, d1; sg_zero(c0); sg_zero(c1); sg_zero(d0); sg_zero(d1);
        if (MODE == 0) {
            if (sq_out == 1) sg_accum(c0, c1, (const bf16*)(ws + WS_HB), DFF, (const bf16*)(wl + (second ? OW2B : OW2A)), DFF, row0, col0, wave * 352, 22, lane);
            else sg_accum(c0, c1, (const bf16*)(ws + WS_MB), DM, (const bf16*)(wl + OWOUT), DM, row0, col0, wave * 128, 8, lane);
        } else if (MODE == 1) {
            sg_accum(c0, c1, (const bf16*)(ws + (xc ? WS_XB1 : WS_XB0)), DM, (const bf16*)(wl + OWPG), DM, row0, col0, wave * 128, 8, lane);
            sg_accum(d0, d1, (const bf16*)(ws + WS_PB) + (size_t)L * M * 256, 256, (const bf16*)(wl + OWPP), 256, row0, col0, wave * 32, 2, lane);
        } else {
            const unsigned char* gbp = ws + WS_GB + (size_t)(row0 + r32) * 4096 + col0 + 4 * hi;
            for (int b = 0; b < 4; ++b) {
                sg_zero(d0); sg_zero(d1);
                sg_accum(d0, d1, (const bf16*)(ws + WS_AB) + (size_t)b * M * 512, 512, (const bf16*)(wl + OWBR) + (size_t)b * 1024 * 512, 512, row0, col0, wave * 64, 4, lane);
#pragma unroll
                for (int a = 0; a < 4; ++a) { const unsigned g0 = *(const GAS unsigned*)(gbp + b * 1024 + 8 * a), g1 = *(const GAS unsigned*)(gbp + b * 1024 + 32 + 8 * a);
#pragma unroll
                    for (int i = 0; i < 4; ++i) { float f0 = (float)((g0 >> (8 * i)) & 255u), f1 = (float)((g1 >> (8 * i)) & 255u); f0 = (f0 > 1.0f ? f0 : 1.0f) * (1.0f / 255.0f); f1 = (f1 > 1.0f ? f1 : 1.0f) * (1.0f / 255.0f);
                        c0[4 * a + i] += f0 * d0[4 * a + i]; c1[4 * a + i] += f1 * d1[4 * a + i]; } }
            }
        }
#pragma unroll
        for (int r = 0; r < 16; ++r) { part[((wave * 32 + r) * 64) + lane] = c0[r]; part[((wave * 32 + 16 + r) * 64) + lane] = c1[r]; }
        if (MODE == 1) {
#pragma unroll
            for (int r = 0; r < 16; ++r) { part2[((wave * 32 + r) * 64) + lane] = d0[r]; part2[((wave * 32 + 16 + r) * 64) + lane] = d1[r]; }
        }
        __syncthreads();
        if (wave == 0) {
#pragma unroll 1
            for (int w = 1; w < 8; ++w) {
                const LAS float* pw_ = part + w * 2048 + lane;
#pragma unroll
                for (int r = 0; r < 16; ++r) { c0[r] += pw_[r * 64]; c1[r] += pw_[(16 + r) * 64]; }
                if (MODE == 1) { const LAS float* pd_ = part2 + w * 2048 + lane;
#pragma unroll
                    for (int r = 0; r < 16; ++r) { d0[r] += pd_[r * 64]; d1[r] += pd_[(16 + r) * 64]; } }
            }
            const int row = row0 + r32; const size_t rb = (size_t)row * 1024 + col0 + 4 * hi;
            if (MODE == 2) {
                bf16* mb = (bf16*)(ws + WS_MB) + rb;
#pragma unroll
                for (int a = 0; a < 4; ++a) { u32x2 w0, w1; w0.x = cvtpk(c0[4 * a], c0[4 * a + 1]); w0.y = cvtpk(c0[4 * a + 2], c0[4 * a + 3]); w1.x = cvtpk(c1[4 * a], c1[4 * a + 1]); w1.y = cvtpk(c1[4 * a + 2], c1[4 * a + 3]);
                    *(GAS u32x2*)(mb + 8 * a) = w0; *(GAS u32x2*)(mb + 32 + 8 * a) = w1; }
            } else {
                float* X = P->out + O_X + rb; bf16* XB = (bf16*)(ws + ((MODE == 1 ? (xc ^ 1) : xc) ? WS_XB1 : WS_XB0)) + rb; const bf16* XI = (const bf16*)(ws + (xc ? WS_XB1 : WS_XB0)) + rb; bf16* XL = (bf16*)(ws + WS_XL) + rb;
                float rs = 0.f; if (MODE == 1) rs = pg8::row_rstd((const float*)(ws + (sq_out ? WS_SSQ0 : WS_SSQ1)), row);
                float ss = 0.f;
#pragma unroll
                for (int j = 0; j < 2; ++j)
#pragma unroll
                    for (int a = 0; a < 4; ++a) { f32x4 v; const u32x2 h2 = *(const GAS u32x2*)(XI + 32 * j + 8 * a); u32x2 l2 = (u32x2){0u, 0u}; if (USE_XL) l2 = *(const GAS u32x2*)(XL + 32 * j + 8 * a);
                        f32x4 xo = (f32x4){bflo(h2.x) + bflo(l2.x), bfhi(h2.x) + bfhi(l2.x), bflo(h2.y) + bflo(l2.y), bfhi(h2.y) + bfhi(l2.y)};
#pragma unroll
                        for (int i = 0; i < 4; ++i) { const float cv = j ? c1[4 * a + i] : c0[4 * a + i]; if (MODE == 1) { const float dv = j ? d1[4 * a + i] : d0[4 * a + i]; v[i] = pg8::sigm(cv * rs) * dv * ((PROBE_DUP & 8192) ? alpha : 1.0f); } else v[i] = cv * alpha; }
                        xo = xo + v; if (fin) *(GAS f32x4*)(X + 32 * j + 8 * a) = xo; u32x2 w; w.x = cvtpk(xo[0], xo[1]); w.y = cvtpk(xo[2], xo[3]); *(GAS u32x2*)(XB + 32 * j + 8 * a) = w;
                        if (USE_XL) { u32x2 l; l.x = cvtpk(xo[0] - bflo(w.x), xo[1] - bfhi(w.x)); l.y = cvtpk(xo[2] - bflo(w.y), xo[3] - bfhi(w.y)); *(GAS u32x2*)(XL + 32 * j + 8 * a) = l; }
                        ss += (xo[0] * xo[0] + xo[1] * xo[1]) + (xo[2] * xo[2] + xo[3] * xo[3]); }
                ss += __shfl_xor(ss, 32);
                if (hi == 0) ((float*)(ws + (sq_out ? WS_SSQ1 : WS_SSQ0)))[(size_t)row * 16 + tc] = ss;
            }
        }
        __syncthreads();
    }
}

struct WaveQ { unsigned* heads; int n, s, tries; };
__device__ __forceinline__ int q_pull(WaveQ& q, int lane) {
    for (;;) {
        unsigned v = 0u; if (lane == 0) v = __hip_atomic_fetch_add(q.heads + 64 * q.s, 1u, __ATOMIC_RELAXED, __HIP_MEMORY_SCOPE_AGENT);
        const int u = (int)__builtin_amdgcn_readfirstlane(v) * 8 + q.s;
        if (u < q.n) return u;
        if (++q.tries >= 8) return q.n;
        q.s = (q.s + 1) & 7;
    }
}
__global__ void __launch_bounds__(NWAVES * 64, 2) hybrid_fwd(Params Pargs) {
    extern __shared__ __attribute__((aligned(16))) unsigned char lds_raw[];
    LAS unsigned char* lds = (LAS unsigned char*)lds_raw;
    const int tid = threadIdx.x, lane = tid & 63, wave = __builtin_amdgcn_readfirstlane(tid >> 6);
    const int G = gridDim.x, bx = blockIdx.x;
    const int vcu = (G % 8 == 0) ? (bx % 8) * (G / 8) + bx / 8 : bx;
    const int gw = vcu * NWAVES + wave, NGW = G * NWAVES;
    for (int u = tid; u < (LDS_BYTES - RING_BYTES) / 4; u += NWAVES * 64) ((LAS unsigned*)(lds + RING_BYTES))[u] = 0u;
    __syncthreads();
    (void)xcd_barrier_post((unsigned*)(params_ptr()->ws + WS_CTL) + CW_BAR, (volatile LAS unsigned*)(lds + MISC_OFF) + 8);
#define GRID_BAR() do { XcdBarrier b_; b_.bar = (unsigned*)(params_ptr()->ws + WS_CTL) + CW_BAR; b_.x = xb_xcc_id(); b_.st = (volatile LAS unsigned*)(lds + MISC_OFF) + 8; xcd_barrier(b_); } while (0)

    prologue(lds, gw, NGW, wave, lane);
    GRID_BAR();
#if PROBE_DUP & 16
    prologue(lds, gw, NGW, wave, lane);
    GRID_BAR();
#endif

    for (int hl = 0; hl < 2 * NL; ++hl) {
        const int L = hl >> 1, second = hl & 1, xc = L & 1;
        for (int rep_ = 0; rep_ < ((PROBE_DUP & 1) ? 2 : 1); ++rep_) {
        { KParams P = params_ptr(); unsigned char* ws = P->ws; unsigned char* wl = ws + WS_W + (size_t)L * LW;
          pg8::Gemm g{(const bf16*)(ws + (xc ? WS_XB1 : WS_XB0)), (const bf16*)(wl + (second ? OW13B : OW13A)), MP, 5632, DM}; pg8::RstdOrder S; S.init(MP, 5632, G, bx, WGM_UP); S.kp = P; S.sq = 0; S.rl = (LAS float*)(lds + RSTD_OFF); S.nd = 0; S.started = false;
          pg8::EpiSwiGLU E{P, (const LAS float*)(lds + RSTD_OFF)};
          pg8::gemm_phase<pg8::EpiSwiGLU, pg8::RstdOrder, true, true>(lds, g, S, E); }
        sample_up_tiles(L, xc, second, gw, NGW, lane);
        GRID_BAR();
        }
        for (int rep_ = 0; rep_ < ((PROBE_DUP & 2048) ? 2 : 1); ++rep_) {
        { KParams P = params_ptr(); unsigned char* ws = P->ws; unsigned char* wl = ws + WS_W + (size_t)L * LW;
          pg8::Gemm g{(const bf16*)(ws + WS_HB), (const bf16*)(wl + (second ? OW2B : OW2A)), MP, DM, DFF}; pg8::StaticOrder S; S.init(MP, DM, G, bx, WGM_X);
          pg8::EpiX<false> E{P, xc, xc, 1, (PROBE_DUP & 2048) ? 0.25f : 0.5f, nullptr, 0};
          pg8::gemm_phase<pg8::EpiX<false>, pg8::StaticOrder, true, true>(lds, g, S, E); }
        sample_tiles<0>(lds, L, xc, second, (PROBE_DUP & 2048) ? 0.25f : 0.5f, 1, vcu, G, tid);
        GRID_BAR();
        }
        if (!second) {
            for (int rep_ = 0; rep_ < ((PROBE_DUP & 2) ? 2 : 1); ++rep_) {
            { KParams P = params_ptr(); unsigned char* ws = P->ws; unsigned char* wl = ws + WS_W + (size_t)L * LW;
              pg8::Gemm g{(const bf16*)(ws + (xc ? WS_XB1 : WS_XB0)), (const bf16*)(wl + OWIN), M, NIN, DM}; pg8::RstdOrder S; S.init(M, NIN, G, bx, WGM_IN); S.kp = P; S.sq = 1; S.rl = (LAS float*)(lds + RSTD_OFF); S.nd = 0; S.started = false;
              pg8::EpiIn E{P, L, (const LAS float*)(lds + RSTD_OFF)};
              pg8::gemm_phase<pg8::EpiIn, pg8::RstdOrder, true, true>(lds, g, S, E); }
            GRID_BAR();
            }
            for (int rep_ = 0; rep_ < ((PROBE_DUP & 4) ? 2 : 1); ++rep_) {
#if PROBE_DUP & 262144
            { const unsigned long long t0_ = wall_clock64(); while (wall_clock64() - t0_ < 25000ull) __builtin_amdgcn_s_sleep(64); }
#endif
            for (int rq_ = 0; rq_ < ((PROBE_DUP & 32) ? 2 : 1); ++rq_) gla_pass_a_loop(lds, L, vcu, G, tid);
            for (int rq_ = 0; rq_ < ((PROBE_DUP & (64 | 256)) ? 2 : 1); ++rq_)
            { const int qn_ = (rq_ && (PROBE_DUP & 64)) ? 128 + 8192 : 128 + 8192 + M / 8 + 4096 + 256;
              WaveQ q{(unsigned*)(params_ptr()->ws + WS_CTL) + CW_Q + 512 * (2 * L) + 8192 * rq_, qn_, (int)(xb_xcc_id() & 7u), 0};
              int u = q_pull(q, lane);
              while (u < qn_) { const int un = q_pull(q, lane);
                  if (u < 128) sb_unit<true>(lds + wave * 16384, lane, L, 8192 + u);
                  else { const int k = u - 128;
                      if (k < 6 * 2048) { const int g6 = k / 6, r6 = k - 6 * g6; if (r6 < 4) sb_unit<false>(lds + wave * 16384, lane, L, 4 * g6 + r6); else pool_unit(L, 2 * g6 + (r6 - 4), lane); }
                      else { const int k2 = k - 6 * 2048;
                          if (k2 < 4096 + 256) gmlp_unit(lds + wave * 16384, lane, L, k2); else pool_unit(L, 4096 + (k2 - (4096 + 256)), lane); } }
                  u = un; } }
            GRID_BAR();
            for (int rq_ = 0; rq_ < ((PROBE_DUP & 512) ? 2 : 1); ++rq_) gla_pass_c_loop(lds, L, vcu, G, tid);
            GRID_BAR();
            }
            for (int rep_ = 0; rep_ < ((PROBE_DUP & 8) ? 2 : 1); ++rep_) {
            { KParams P = params_ptr(); unsigned char* ws = P->ws; unsigned char* wl = ws + WS_W + (size_t)L * LW;
              pg8::Gemm g{(const bf16*)(ws + WS_AB), (const bf16*)(wl + OWBR), 4 * M, 4 * DM, 512}; pg8::BranchOrder S{G, vcu};
              pg8::EpiBranch E{P};
              pg8::gemm_phase<pg8::EpiBranch, pg8::BranchOrder, true, true>(lds, g, S, E); }
            sample_tiles<2>(lds, L, xc, 0, 1.0f, 0, vcu, G, tid);
            GRID_BAR();
            }
            for (int rep_ = 0; rep_ < ((PROBE_DUP & 4096) ? 2 : 1); ++rep_) {
            { KParams P = params_ptr(); unsigned char* ws = P->ws; unsigned char* wl = ws + WS_W + (size_t)L * LW;
              pg8::Gemm g{(const bf16*)(ws + WS_MB), (const bf16*)(wl + OWOUT), MP, DM, DM}; pg8::StaticOrder S; S.init(MP, DM, G, bx, WGM_X);
              pg8::EpiX<false> E{P, xc, xc, 0, (PROBE_DUP & 4096) ? 0.5f : 1.0f, nullptr, 0};
              pg8::gemm_phase<pg8::EpiX<false>, pg8::StaticOrder, true, true>(lds, g, S, E); }
            sample_tiles<0>(lds, L, xc, 0, (PROBE_DUP & 4096) ? 0.5f : 1.0f, 0, vcu, G, tid);
            { KParams P = params_ptr(); unsigned char* ws = P->ws; unsigned char* wl = ws + WS_W + (size_t)L * LW;
              pg8::Gemm g{(const bf16*)(ws + WS_PB) + (size_t)L * M * 256, (const bf16*)(wl + OWPP), MP, DM, 256}; pg8::StaticOrder S; S.init(MP, DM, G, bx, WGM_X);
              pg8::EpiPlain E{P};
              pg8::gemm_phase<pg8::EpiPlain, pg8::StaticOrder, true, true>(lds, g, S, E); }
            GRID_BAR();
            }
        } else {
            for (int rep_ = 0; rep_ < ((PROBE_DUP & 8192) ? 2 : 1); ++rep_) {
            { KParams P = params_ptr(); unsigned char* ws = P->ws; unsigned char* wl = ws + WS_W + (size_t)L * LW;
              pg8::Gemm g{(const bf16*)(ws + (xc ? WS_XB1 : WS_XB0)), (const bf16*)(wl + OWPG), MP, DM, DM}; pg8::RstdOrder S; S.init(MP, DM, G, bx, WGM_X); S.kp = P; S.sq = 1; S.rl = (LAS float*)(lds + RSTD_OFF); S.nd = 0; S.started = false;
              pg8::EpiX<true> E{P, xc, xc ^ 1, 0, (PROBE_DUP & 8192) ? 0.5f : 1.0f, (const LAS float*)(lds + RSTD_OFF), hl == 2 * NL - 1};
              pg8::gemm_phase<pg8::EpiX<true>, pg8::RstdOrder, true, true>(lds, g, S, E); }
            sample_tiles<1>(lds, L, xc, 0, (PROBE_DUP & 8192) ? 0.5f : 1.0f, 0, vcu, G, tid, hl == 2 * NL - 1);
            GRID_BAR();
            }
        }
    }
#undef GRID_BAR
}

extern "C" void kernel_launch(void* const* d_in, const int* in_sizes, int n_in, void* d_out, int out_size, void* d_ws, size_t ws_size, hipStream_t stream) {
    static int grid = 0;
    if (grid == 0) {
        if (n_in != 32 || (size_t)out_size != O_END || ws_size < WS_END) { fprintf(stderr, "kernel_launch: unexpected shapes: n_in %d out %d ws %zu (want 32, %zu, >= %zu)\n", n_in, out_size, ws_size, (size_t)O_END, (size_t)WS_END); grid = -1; return; }
        int dev = 0, cus = 0, per_cu = 0;
        if (hipGetDevice(&dev) != hipSuccess || hipDeviceGetAttribute(&cus, hipDeviceAttributeMultiprocessorCount, dev) != hipSuccess) { grid = -1; return; }
        if (hipFuncSetAttribute((const void*)hybrid_fwd, hipFuncAttributeMaxDynamicSharedMemorySize, LDS_BYTES) != hipSuccess) { fprintf(stderr, "kernel_launch: hipFuncSetAttribute failed\n"); grid = -1; return; }
        if (hipOccupancyMaxActiveBlocksPerMultiprocessor(&per_cu, (const void*)hybrid_fwd, NWAVES * 64, LDS_BYTES) != hipSuccess || per_cu < 1) fprintf(stderr, "kernel_launch: occupancy query reports %d\n", per_cu);
        (void)hipGetLastError();
        grid = cus;
    }
    if (grid < 0) return;
    if (hipMemsetAsync((char*)d_ws + WS_CTL, 0, CTL_ZERO_BYTES, stream) != hipSuccess) return;
    Params p{};
    for (int i = 0; i < 32; ++i) p.in[i] = (const float*)d_in[i];
    p.out = (float*)d_out; p.ws = (unsigned char*)d_ws;
    hipLaunchKernelGGL(hybrid_fwd, dim3(grid), dim3(NWAVES * 64), LDS_BYTES, stream, p);
    const hipError_t le = hipPeekAtLastError();
    if (le != hipSuccess) fprintf(stderr, "kernel_launch: launch failed: %s\n", hipGetErrorName(le));
}
```
